# Optimizing an MI355X kernel written in HIP

```python
import math
import jax, jax.numpy as jnp
from jax import lax
import numpy as np

D_MODEL = 1024
BATCH = 8
SEQ = 2048
DEPTH = 1
DEC_BATCH = 128
DEC_SEQ = 1
PAST_LEN = 16384
PAGE_SIZE = 128

N_MEM = 256
RWKV_HEAD = 64
RWKV_HEADS = D_MODEL // RWKV_HEAD
RWKV_WIDTH = RWKV_HEADS * RWKV_HEAD
DECAY_LORA = 64
AAA_LORA = 64
GATE_LORA = 128
RWKV_PROJ = 3 * RWKV_WIDTH + DECAY_LORA + AAA_LORA + GATE_LORA
GN_EPS = 64e-5
LRU_WIDTH = D_MODEL
LRU_BLOCKS = 16
LRU_BLOCK = LRU_WIDTH // LRU_BLOCKS
CONV_WIDTH = 4
LRU_C = 8.0
N_BRANCH = 2
PROJ_WIDTH = RWKV_PROJ + 2 * LRU_WIDTH + N_BRANCH * D_MODEL
XA_HEADS = 4
XA_HEAD = D_MODEL // XA_HEADS
D_FF = 2816
DN_ALPHA = (2.0 * DEPTH) ** 0.25
DN_BETA = (8.0 * DEPTH) ** -0.25
LN_EPS = 1e-5

kernel_name = "hybrid_rwkv7_rglru_gated_decoder_step"

F32 = jnp.float32


def _layer_norm(x, g, b):
    xf = x.astype(F32)
    mu = jnp.mean(xf, axis=-1, keepdims=True)
    var = jnp.mean(jnp.square(xf - mu), axis=-1, keepdims=True)
    return ((xf - mu) * lax.rsqrt(var + LN_EPS) * g.astype(F32) + b.astype(F32)).astype(x.dtype)


def _swiglu(h, wi, wo):
    u = h @ wi
    gate, up = u[..., :D_FF], u[..., D_FF:]
    return (jax.nn.silu(gate) * up) @ wo


def _rwkv_scan(S0, r, w, k, v, kk, a):
    def step(S, inp):
        r_t, w_t, k_t, v_t, kk_t, a_t = inp
        sa = jnp.einsum('bhvk,bhk->bhv', S, -kk_t)
        S = S * w_t[:, :, None, :] + sa[..., None] * (kk_t * a_t)[:, :, None, :] + v_t[..., None] * k_t[:, :, None, :]
        y = jnp.einsum('bhvk,bhk->bhv', S, r_t)
        return S, y
    xs = tuple(jnp.moveaxis(t, 1, 0) for t in (r, w, k, v, kk, a))
    S, ys = lax.scan(step, S0, xs)
    return S, jnp.moveaxis(ys, 0, 1)


def _lin_combine(c1, c2):
    a1, b1 = c1
    a2, b2 = c2
    return a1 * a2, a2 * b1 + b2


def _mixer(h, S0, shift0, h0, buf0, P):
    B, T, _ = h.shape
    H, N = RWKV_HEADS, RWKV_HEAD
    proj = h @ P['w_in']
    p_rwkv = proj[..., :RWKV_PROJ]
    p_lru = proj[..., RWKV_PROJ:RWKV_PROJ + LRU_WIDTH]
    p_gelu = proj[..., RWKV_PROJ + LRU_WIDTH:RWKV_PROJ + 2 * LRU_WIDTH]
    p_gate = proj[..., RWKV_PROJ + 2 * LRU_WIDTH:]

    prev = jnp.concatenate([shift0[:, None].astype(p_rwkv.dtype), p_rwkv[:, :-1]], axis=1)
    xs = p_rwkv + (prev - p_rwkv) * P['shift_mu']
    W = RWKV_WIDTH
    r = xs[..., :W]
    k = xs[..., W:2 * W]
    v = xs[..., 2 * W:3 * W]
    xw = xs[..., 3 * W:3 * W + DECAY_LORA]
    xa = xs[..., 3 * W + DECAY_LORA:3 * W + DECAY_LORA + AAA_LORA]
    xg = xs[..., 3 * W + DECAY_LORA + AAA_LORA:]
    wlog = -jax.nn.softplus(-(P['decay_w0'] + jnp.tanh(xw) @ P['decay_w2']).astype(F32)) - 0.5
    decay = jnp.exp(-jnp.exp(wlog))
    a = jax.nn.sigmoid((P['aaa_a0'] + xa @ P['aaa_a2']).astype(F32))
    g = jax.nn.sigmoid(xg) @ P['gate_g2']
    rf, kf, vf = r.astype(F32), k.astype(F32), v.astype(F32)
    kk = (kf * P['k_k'].astype(F32)).reshape(B, T, H, N)
    kk = kk / jnp.maximum(jnp.sqrt(jnp.sum(kk * kk, axis=-1, keepdims=True)), 1e-12)
    kf = kf * (1.0 + (a - 1.0) * P['k_a'].astype(F32))
    hd = lambda t: t.reshape(B, T, H, N)
    rh, kh, vh = hd(rf), hd(kf), hd(vf)
    S_new, y = _rwkv_scan(S0.astype(F32), rh, hd(decay), kh, vh, kk, hd(a))
    ym = jnp.mean(y, axis=-1, keepdims=True)
    yv = jnp.mean(jnp.square(y - ym), axis=-1, keepdims=True)
    yn = ((y - ym) * lax.rsqrt(yv + GN_EPS)).reshape(B, T, W) * P['gn_g'].astype(F32) + P['gn_b'].astype(F32)
    bonus = (jnp.sum(rh * kh * P['r_k'].astype(F32), axis=-1, keepdims=True) * vh).reshape(B, T, W)
    rwkv_out = ((yn + bonus) * g.astype(F32)).astype(h.dtype)

    conv_in = jnp.concatenate([buf0.astype(p_lru.dtype), p_lru], axis=1)
    xc = P['conv_b'] + sum(P['conv_w'][j] * conv_in[:, j:j + T] for j in range(CONV_WIDTH))
    new_buf = conv_in[:, -(CONV_WIDTH - 1):]
    xcb = xc.reshape(B, T, LRU_BLOCKS, LRU_BLOCK)
    gr = jax.nn.sigmoid((jnp.einsum('btnc,ncd->btnd', xcb, P['lru_wr']).reshape(B, T, LRU_WIDTH) + P['lru_br']).astype(F32))
    gi = jax.nn.sigmoid((jnp.einsum('btnc,ncd->btnd', xcb, P['lru_wi']).reshape(B, T, LRU_WIDTH) + P['lru_bi']).astype(F32))
    log_a = -LRU_C * gr * jax.nn.softplus(-P['lru_lambda'].astype(F32))
    a_t = jnp.exp(log_a)
    b_t = jnp.sqrt(-jnp.expm1(2.0 * log_a)) * gi * xc.astype(F32)
    b_t = b_t.at[:, 0].add(a_t[:, 0] * h0.astype(F32))
    _, hs = lax.associative_scan(_lin_combine, (a_t, b_t), axis=1)
    lru_out = (hs * jax.nn.gelu(p_gelu.astype(F32))).astype(h.dtype)

    gates = jax.nn.sigmoid(p_gate).reshape(B, T, N_BRANCH, D_MODEL)
    merged = gates[:, :, 0] * rwkv_out + gates[:, :, 1] * lru_out
    out = merged @ P['w_mix_out']
    return out, S_new.astype(h.dtype), p_rwkv[:, -1], hs[:, -1].astype(h.dtype), new_buf


def _xattn(h, mk, mv, wq, wo):
    B, T, _ = h.shape
    q = (h @ wq).reshape(B, T, XA_HEADS, XA_HEAD)
    s = jnp.einsum('bthd,bmhd->bhtm', q, mk).astype(F32) * (XA_HEAD ** -0.5)
    p = jax.nn.softmax(s, axis=-1).astype(h.dtype)
    o = jnp.einsum('bhtm,bmhd->bthd', p, mv).reshape(B, T, D_MODEL)
    return o @ wo


def _layer(h, mk, mv, S0, shift0, h0, buf0, P):
    h = _layer_norm(DN_ALPHA * h + 0.5 * _swiglu(h, P['ffn1_wi'], P['ffn1_wo']), P['ln_g'][0], P['ln_b'][0])
    mix, S_new, shift_new, h_new, buf_new = _mixer(h, S0, shift0, h0, buf0, P)
    h = _layer_norm(DN_ALPHA * h + mix, P['ln_g'][1], P['ln_b'][1])
    h = _layer_norm(DN_ALPHA * h + _xattn(h, mk, mv, P['xa_wq'], P['xa_wo']), P['ln_g'][2], P['ln_b'][2])
    h = _layer_norm(DN_ALPHA * h + 0.5 * _swiglu(h, P['ffn2_wi'], P['ffn2_wo']), P['ln_g'][3], P['ln_b'][3])
    return h, S_new, shift_new, h_new, buf_new


def setup_inputs(seed: int = 0) -> dict:
    key = jax.random.key(seed)
    ks = iter(jax.random.split(key, 64))
    nrm = lambda shape, scale: jax.random.normal(next(ks), shape, F32) * scale
    uni = lambda shape, lo, hi: jax.random.uniform(next(ks), shape, F32, minval=lo, maxval=hi)
    L, D, W = DEPTH, D_MODEL, RWKV_WIDTH
    inv = lambda n: float(n) ** -0.5
    lam_s = uni((L, LRU_WIDTH), 0.9, 0.999) ** (1.0 / LRU_C)
    return {
        'x_prompt': nrm((BATCH, SEQ, D), 1.0),
        'x_sample': nrm((DEC_BATCH, DEC_SEQ, D), 1.0),
        'mem_prompt': nrm((BATCH, N_MEM, D), 1.0),
        'cache_mem_k': nrm((L, DEC_BATCH, N_MEM, XA_HEADS, XA_HEAD), 1.0),
        'cache_mem_v': nrm((L, DEC_BATCH, N_MEM, XA_HEADS, XA_HEAD), 1.0),
        'state_rwkv': nrm((L, DEC_BATCH, RWKV_HEADS, RWKV_HEAD, RWKV_HEAD), 0.5),
        'state_rwkv_shift': nrm((L, DEC_BATCH, RWKV_PROJ), 1.0),
        'state_lru': nrm((L, DEC_BATCH, LRU_WIDTH), 0.5),
        'state_conv': nrm((L, DEC_BATCH, CONV_WIDTH - 1, LRU_WIDTH), 1.0),
        'ln_g': 1.0 + nrm((L, 4, D), 0.02),
        'ln_b': nrm((L, 4, D), 0.02),
        'ffn1_wi': nrm((L, D, 2 * D_FF), inv(D)),
        'ffn1_wo': nrm((L, D_FF, D), inv(D_FF) * DN_BETA),
        'ffn2_wi': nrm((L, D, 2 * D_FF), inv(D)),
        'ffn2_wo': nrm((L, D_FF, D), inv(D_FF) * DN_BETA),
        'w_in': nrm((L, D, PROJ_WIDTH), inv(D)),
        'shift_mu': uni((L, RWKV_PROJ), 0.0, 1.0),
        'decay_w0': uni((L, W), -6.0, -1.0),
        'decay_w2': nrm((L, DECAY_LORA, W), 0.1 * inv(DECAY_LORA)),
        'aaa_a0': nrm((L, W), 0.1),
        'aaa_a2': nrm((L, AAA_LORA, W), 0.1 * inv(AAA_LORA)),
        'gate_g2': nrm((L, GATE_LORA, W), inv(GATE_LORA)),
        'k_k': 0.85 + nrm((L, W), 0.02),
        'k_a': 1.0 + nrm((L, W), 0.02),
        'r_k': nrm((L, RWKV_HEADS, RWKV_HEAD), 0.1),
        'gn_g': 1.0 + nrm((L, W), 0.02),
        'gn_b': nrm((L, W), 0.02),
        'conv_w': nrm((L, CONV_WIDTH, LRU_WIDTH), inv(CONV_WIDTH)),
        'conv_b': nrm((L, LRU_WIDTH), 0.02),
        'lru_wr': nrm((L, LRU_BLOCKS, LRU_BLOCK, LRU_BLOCK), inv(LRU_BLOCK)),
        'lru_br': nrm((L, LRU_WIDTH), 0.02),
        'lru_wi': nrm((L, LRU_BLOCKS, LRU_BLOCK, LRU_BLOCK), inv(LRU_BLOCK)),
        'lru_bi': nrm((L, LRU_WIDTH), 0.02),
        'lru_lambda': jnp.log(lam_s) - jnp.log1p(-lam_s),
        'w_mix_out': nrm((L, D, D), inv(D) * DN_BETA),
        'xa_wq': nrm((L, D, D), inv(D)),
        'xa_wk': nrm((L, D, D), inv(D)),
        'xa_wv': nrm((L, D, D), inv(D)),
        'xa_wo': nrm((L, D, D), inv(D) * DN_BETA),
    }


def reference(x_prompt, x_sample, mem_prompt, cache_mem_k, cache_mem_v, state_rwkv, state_rwkv_shift,
              state_lru, state_conv, ln_g, ln_b, ffn1_wi, ffn1_wo, ffn2_wi, ffn2_wo, w_in, shift_mu,
              decay_w0, decay_w2, aaa_a0, aaa_a2, gate_g2, k_k, k_a, r_k, gn_g, gn_b, conv_w, conv_b,
              lru_wr, lru_br, lru_wi, lru_bi, lru_lambda, w_mix_out, xa_wq, xa_wk, xa_wv, xa_wo):
    dt = x_prompt.dtype
    hp, hs = x_prompt, x_sample
    p_mk, p_mv, p_S, p_sh, p_h, p_cv = [], [], [], [], [], []
    s_S, s_sh, s_h, s_cv = [], [], [], []
    for l in range(DEPTH):
        P = dict(ln_g=ln_g[l], ln_b=ln_b[l], ffn1_wi=ffn1_wi[l], ffn1_wo=ffn1_wo[l], ffn2_wi=ffn2_wi[l],
                 ffn2_wo=ffn2_wo[l], w_in=w_in[l], shift_mu=shift_mu[l], decay_w0=decay_w0[l],
                 decay_w2=decay_w2[l], aaa_a0=aaa_a0[l], aaa_a2=aaa_a2[l], gate_g2=gate_g2[l], k_k=k_k[l],
                 k_a=k_a[l], r_k=r_k[l], gn_g=gn_g[l], gn_b=gn_b[l], conv_w=conv_w[l], conv_b=conv_b[l],
                 lru_wr=lru_wr[l], lru_br=lru_br[l], lru_wi=lru_wi[l], lru_bi=lru_bi[l],
                 lru_lambda=lru_lambda[l], w_mix_out=w_mix_out[l], xa_wq=xa_wq[l], xa_wo=xa_wo[l])
        mk = (mem_prompt @ xa_wk[l]).reshape(BATCH, N_MEM, XA_HEADS, XA_HEAD)
        mv = (mem_prompt @ xa_wv[l]).reshape(BATCH, N_MEM, XA_HEADS, XA_HEAD)
        hp, S1, sh1, h1, b1 = _layer(
            hp, mk, mv,
            jnp.zeros((BATCH, RWKV_HEADS, RWKV_HEAD, RWKV_HEAD), F32),
            jnp.zeros((BATCH, RWKV_PROJ), dt),
            jnp.zeros((BATCH, LRU_WIDTH), F32),
            jnp.zeros((BATCH, CONV_WIDTH - 1, LRU_WIDTH), dt), P)
        p_mk.append(mk); p_mv.append(mv); p_S.append(S1); p_sh.append(sh1); p_h.append(h1); p_cv.append(b1)
        hs, S2, sh2, h2, b2 = _layer(hs, cache_mem_k[l], cache_mem_v[l], state_rwkv[l], state_rwkv_shift[l],
                                     state_lru[l], state_conv[l], P)
        s_S.append(S2); s_sh.append(sh2); s_h.append(h2); s_cv.append(b2)
    return (hp, hs,
            jnp.stack(p_mk), jnp.stack(p_mv), jnp.stack(p_S), jnp.stack(p_sh), jnp.stack(p_h), jnp.stack(p_cv),
            jnp.stack(s_S), jnp.stack(s_sh), jnp.stack(s_h), jnp.stack(s_cv))
```

```cpp
#include <hip/hip_runtime.h>
#include <hip/hip_cooperative_groups.h>
#include <cstdio>
#include <cstdint>
namespace cg = cooperative_groups;

#define LAS __attribute__((address_space(3)))
typedef unsigned short bf16_t;
typedef short bf16x8 __attribute__((ext_vector_type(8)));
typedef float f32x4 __attribute__((ext_vector_type(4)));
typedef float f32x2 __attribute__((ext_vector_type(2)));
typedef unsigned u32x4 __attribute__((ext_vector_type(4)));
typedef unsigned u32x2 __attribute__((ext_vector_type(2)));

constexpr int D = 1024, T = 2048, NB = 8, MP = NB * T, NS = 128, MT = MP + NS, FF = 2816, RP = 3328, PW = 7424;
constexpr int NWAVES = 8, NTHR = 512;
constexpr float DN_ALPHA = 1.189207115002721f;
constexpr float LN_EPS = 1e-5f, GN_EPS = 64e-5f;

constexpr size_t MiB = 1u << 20;
constexpr size_t WS_WI = 1 * MiB, WS_WO = 12 * MiB, WS_WIN = 19 * MiB, WS_WMIX = 34 * MiB, WS_WQ = 36 * MiB, WS_WOX = 38 * MiB, WS_WKV = 40 * MiB,
                 WS_LORAT = 44 * MiB, WS_LRUT = 46 * MiB, WS_MEMB = 47 * MiB, WS_KB = 51 * MiB, WS_VT = 55 * MiB, WS_HB = 60 * MiB, WS_PRE = 93 * MiB,
                 WS_PR = 158 * MiB, WS_PL = 263 * MiB, WS_GG = 296 * MiB, WS_SG0 = 329 * MiB, WS_GI = 362 * MiB, WS_WD = 395 * MiB, WS_AA = 428 * MiB,
                 WS_G = 461 * MiB, WS_L = 494 * MiB, WS_END = 503 * MiB;
static_assert(WS_G - WS_AA == WS_AA - WS_WD, "WD/AA/G spacing");
static_assert((size_t)MT * RP * 2 <= 105 * MiB && (size_t)MT * D * 2 <= 33 * MiB && (size_t)MT * D * 4 <= 65 * MiB && (size_t)MT * 256 * 2 <= 9 * MiB, "ws map");
constexpr size_t O_YP = 0, O_YS = 16777216, O_PMK = 16908288, O_PMV = 19005440, O_PRWKV = 21102592, O_PSHIFT = 21626880, O_PLRU = 21653504,
                 O_PCONV = 21661696, O_SRWKV = 21686272, O_SSHIFT = 30074880, O_SLRU = 30500864, O_SCONV = 30631936, O_TOTAL = 31025152;

constexpr int LDS_BYTES = 139264;

__device__ __forceinline__ unsigned cvt_pk_bf16(float lo, float hi) { unsigned r; asm volatile("v_cvt_pk_bf16_f32 %0, %1, %2" : "=v"(r) : "v"(lo), "v"(hi)); return r; }
__device__ __forceinline__ bf16_t f2bf(float f) { return (bf16_t)(cvt_pk_bf16(f, 0.f) & 0xffffu); }
__device__ __forceinline__ float bf2f(bf16_t h) { return __uint_as_float(((unsigned)h) << 16); }
__device__ __forceinline__ f32x4 unpack4(u32x2 u) { return (f32x4){__uint_as_float(u.x << 16), __uint_as_float(u.x & 0xffff0000u), __uint_as_float(u.y << 16), __uint_as_float(u.y & 0xffff0000u)}; }
__device__ __forceinline__ u32x2 pack4(f32x4 v) { u32x2 r; r.x = cvt_pk_bf16(v.x, v.y); r.y = cvt_pk_bf16(v.z, v.w); return r; }
__device__ __forceinline__ float sigm(float x) { return 1.0f / (1.0f + __expf(-x)); }
__device__ __forceinline__ float silu(float x) { return x * sigm(x); }
__device__ __forceinline__ float tanh_(float x) { float e = __expf(2.0f * x); return 1.0f - 2.0f / (e + 1.0f); }
__device__ __forceinline__ float gelu_t(float x) { float u = 0.7978845608028654f * (x + 0.044715f * x * x * x); return 0.5f * x * (1.0f + tanh_(u)); }
__device__ __forceinline__ float softplus_(float x) { return x > 20.f ? x : log1pf(expf(x)); }
__device__ __forceinline__ float decay_e(float pre) { return 0.6065306597126334f * sigm(pre); }
template <int CTRL> __device__ __forceinline__ float dppf(float x) { return __builtin_bit_cast(float, __builtin_amdgcn_update_dpp(0, __builtin_bit_cast(int, x), CTRL, 0xf, 0xf, true)); }
__device__ __forceinline__ float red16(float x) {
    x += dppf<0xB1>(x); x += dppf<0x4E>(x); x += dppf<0x141>(x); x += dppf<0x140>(x); return x;
}
__device__ __forceinline__ int opaque(int x) { asm volatile("" : "+v"(x)); return x; }
__device__ __forceinline__ float dot4(f32x4 a, f32x4 b) { return (a.x * b.x + a.y * b.y) + (a.z * b.z + a.w * b.w); }
__device__ __forceinline__ float wave_sum(float v) {
#pragma unroll
    for (int o = 1; o < 64; o <<= 1) v += __shfl_xor(v, o);
    return v;
}
__device__ __forceinline__ float wave_max(float v) {
#pragma unroll
    for (int o = 1; o < 64; o <<= 1) v = fmaxf(v, __shfl_xor(v, o));
    return v;
}

namespace pg8 {
constexpr int BM = 256, BK = 64, HALF = 128, HTB = HALF * BK * 2, STAGE_BYTES = 8 * HTB, NXCD = 8, WGM = 8;
__host__ __device__ __forceinline__ int lds_byte(int r, int c) { const int st = (r >> 4) * 2 + (c >> 5), rr = r & 15, cc = c & 31, ob = rr * 64 + cc * 2; return st * 1024 + (ob ^ (((ob >> 9) & 1) << 5)); }
__host__ __device__ __forceinline__ void stage_rc(int b, int& R, int& C) { const int st = b / 1024, sb = b % 1024, swz = sb ^ (((sb >> 9) & 1) << 5); R = (st >> 1) * 16 + swz / 64; C = (st & 1) * 32 + (swz % 64) / 2; }
__host__ __device__ __forceinline__ int perm32(int rho) { const int n = rho >> 4, i = rho & 15; return 8 * (i >> 2) + 4 * n + (i & 3); }

struct Unit { int pm, pn; };
struct Gemm { const bf16_t* A; const bf16_t* Bt; int lda, ldb, K; };

struct Sched {
    int nM, nN, nwg, G, c, mode;
    long lda, ldb;
    __device__ void init(int nM_, int nN_, int G_, int c_, int mode_, int lda_, int ldb_) { nM = nM_; nN = nN_; nwg = nM * nN; G = G_; c = c_; mode = mode_; lda = lda_; ldb = ldb_; }
    __device__ bool next(int i, Unit& u) const {
        const int L = i * G + c; if (L >= nwg) return false;
        int wgid = L; { const int q = nwg / NXCD, r = nwg % NXCD, xcd = wgid % NXCD, off = wgid / NXCD; wgid = (xcd < r ? xcd * (q + 1) : r * (q + 1) + (xcd - r) * q) + off; }
        const int nig = WGM * nN, gid = wgid / nig, fm = gid * WGM, gsz = (nM - fm) < WGM ? (nM - fm) : WGM;
        u.pm = fm + ((wgid % nig) % gsz); u.pn = (wgid % nig) / gsz; return true;
    }
    __device__ __forceinline__ long aoff(const Unit& u) const {
        long o = (long)u.pm * 256 * lda;
        if (mode == 1) o += 256 * (u.pn >> 1); else if (mode >= 2) o += u.pn * 256;
        return o;
    }
    __device__ __forceinline__ long boff(const Unit& u) const {
        if (mode == 2) return (long)(u.pm >> 3) * 256 * ldb + u.pn * 256;
        if (mode == 3) return (long)u.pn * 256 * ldb + (u.pm >> 3) * 256;
        return (long)u.pn * 256 * ldb;
    }
};

template <class Epi>
__device__ __forceinline__ void gemm_phase(LAS unsigned char* lds, const Gemm g, const Sched& S, const Epi& E) {
    const int tid = opaque(threadIdx.x), wid = __builtin_amdgcn_readfirstlane(tid >> 6), lane = tid & 63, wr = wid >> 2, wc = wid & 3, fr = lane & 15, fq = lane >> 4;
    const int K = g.K, nt = K / BK;
    unsigned voffA[2], voffB[2];
#pragma unroll
    for (int i = 0; i < 2; ++i) { int R, C; stage_rc(tid * 16 + i * 8192, R, C); const int Rb = Epi::PERM ? ((R & ~31) + perm32(R & 31)) : R;
        voffA[i] = (unsigned)(R * g.lda + C) * 2u; voffB[i] = (unsigned)(Rb * g.ldb + C) * 2u; }
    const size_t kstep = (size_t)(BK * 2);
    const size_t hstepA = (size_t)HALF * g.lda * 2, hstepB = (size_t)HALF * g.ldb * 2;
    const unsigned ldsw = (unsigned)wid * 1024u;
    const int aoff = lds_byte(wr * 64 + fr, fq * 8), boff = lds_byte(wc * 32 + fr, fq * 8);
#define PG8_SA(b, h) (((b) * 2 + (h)) * HTB)
#define PG8_SB(b, h) ((4 + (b) * 2 + (h)) * HTB)
#define PG8_STAGE(bufoff, gbase, voff) do { _Pragma("unroll") for (int _i = 0; _i < 2; ++_i) \
        __builtin_amdgcn_global_load_lds((const unsigned*)((const char*)(gbase) + (voff)[_i]), (LAS unsigned*)(lds + (bufoff) + ldsw + _i * 8192), 16, 0, 0); } while (0)
#define PG8_LDA(dst, b, h) do { _Pragma("unroll") for (int m = 0; m < 4; ++m) _Pragma("unroll") for (int k = 0; k < 2; ++k) dst[m][k] = *(const LAS bf16x8*)(lds + PG8_SA(b, h) + aoff + m * 2048 + k * 1024); } while (0)
#define PG8_LDB(dst, b, h) do { _Pragma("unroll") for (int n = 0; n < 2; ++n) _Pragma("unroll") for (int k = 0; k < 2; ++k) dst[n][k] = *(const LAS bf16x8*)(lds + PG8_SB(b, h) + boff + n * 2048 + k * 1024); } while (0)
#define PG8_MMA(ai, bj, At, Bt) do { __builtin_amdgcn_s_setprio(1); _Pragma("unroll") for (int m = 0; m < 4; ++m) _Pragma("unroll") for (int n = 0; n < 2; ++n) _Pragma("unroll") for (int k = 0; k < 2; ++k) \
        acc[ai][bj][m][n] = __builtin_amdgcn_mfma_f32_16x16x32_bf16(Bt[n][k], At[m][k], acc[ai][bj][m][n], 0, 0, 0); __builtin_amdgcn_s_setprio(0); } while (0)
#define PG8_WAIT_V(n) asm volatile("s_waitcnt vmcnt(" #n ")" ::: "memory")
#define PG8_WAIT_L(n) asm volatile("s_waitcnt lgkmcnt(" #n ")" ::: "memory")
#define PG8_BAR __builtin_amdgcn_s_barrier()
#define PG8_SCHED __builtin_amdgcn_sched_barrier(0)
    Unit cur, nxt; int ui = 0;
    if (!S.next(0, cur)) return;
    f32x4 acc[2][2][4][2];
#pragma unroll
    for (int a = 0; a < 2; ++a)
#pragma unroll
        for (int b = 0; b < 2; ++b)
#pragma unroll
            for (int m = 0; m < 4; ++m)
#pragma unroll
                for (int n = 0; n < 2; ++n) acc[a][b][m][n] = (f32x4){0.f, 0.f, 0.f, 0.f};
    bf16x8 At[4][2], B0[2][2], B1[2][2];
    const char* cA = (const char*)g.A + (size_t)S.aoff(cur) * 2; const char* cB = (const char*)g.Bt + (size_t)S.boff(cur) * 2;
    PG8_STAGE(PG8_SB(0, 0), cB, voffB); PG8_STAGE(PG8_SB(0, 1), cB + hstepB, voffB); PG8_STAGE(PG8_SA(0, 0), cA, voffA); PG8_STAGE(PG8_SA(0, 1), cA + hstepA, voffA);
    if (wr == 1) PG8_BAR;
    PG8_WAIT_V(2); PG8_BAR;
    PG8_STAGE(PG8_SB(1, 0), cB + kstep, voffB); PG8_STAGE(PG8_SA(1, 0), cA + kstep, voffA); PG8_STAGE(PG8_SB(1, 1), cB + hstepB + kstep, voffB);
    PG8_WAIT_V(6); PG8_BAR;
    for (;;) {
        const bool has_next = S.next(ui + 1, nxt);
        const char* nA = has_next ? (const char*)g.A + (size_t)S.aoff(nxt) * 2 : cA; const char* nB = has_next ? (const char*)g.Bt + (size_t)S.boff(nxt) * 2 : cB;
        _Pragma("nounroll")
        for (int t = 0; t < nt; t += 2) {
            const bool last = (t == nt - 2);
            const char* a1 = cA + (size_t)(t + 1) * kstep;
            const char* a2 = last ? nA : cA + (size_t)(t + 2) * kstep; const char* b2 = last ? nB : cB + (size_t)(t + 2) * kstep;
            const char* a3 = a2 + kstep; const char* b3 = b2 + kstep;
            PG8_LDB(B0, 0, 0); PG8_LDB(B1, 0, 1); PG8_SCHED; PG8_LDA(At, 0, 0); PG8_STAGE(PG8_SA(1, 1), a1 + hstepA, voffA);
            PG8_WAIT_V(8); PG8_WAIT_L(0); PG8_BAR; PG8_MMA(0, 0, At, B0); PG8_MMA(0, 1, At, B1); PG8_BAR; PG8_SCHED;
            PG8_LDA(At, 0, 1); PG8_STAGE(PG8_SB(0, 0), b2, voffB); PG8_STAGE(PG8_SB(0, 1), b2 + hstepB, voffB); PG8_STAGE(PG8_SA(0, 0), a2, voffA);
            PG8_WAIT_V(8); PG8_WAIT_L(0); PG8_BAR; PG8_MMA(1, 0, At, B0); PG8_MMA(1, 1, At, B1); PG8_BAR; PG8_SCHED;
            PG8_LDB(B0, 1, 0); PG8_LDB(B1, 1, 1); PG8_SCHED; PG8_LDA(At, 1, 0); PG8_STAGE(PG8_SA(0, 1), a2 + hstepA, voffA);
            PG8_WAIT_V(8); PG8_WAIT_L(0); PG8_BAR; PG8_MMA(0, 0, At, B0); PG8_MMA(0, 1, At, B1); PG8_BAR; PG8_SCHED;
            PG8_LDA(At, 1, 1); PG8_STAGE(PG8_SB(1, 0), b3, voffB); PG8_STAGE(PG8_SB(1, 1), b3 + hstepB, voffB); PG8_STAGE(PG8_SA(1, 0), a3, voffA);
            PG8_WAIT_V(8); PG8_WAIT_L(0); PG8_BAR; PG8_MMA(1, 0, At, B0); PG8_MMA(1, 1, At, B1); PG8_BAR; PG8_SCHED;
        }
        if (wr == 0) PG8_BAR;
        if constexpr (!Epi::AFTER_DRAIN) { E(acc, cur, wr, wc, fr, fq); }
        if (!has_next) break;
#pragma unroll
        for (int a = 0; a < 2; ++a)
#pragma unroll
            for (int b = 0; b < 2; ++b)
#pragma unroll
                for (int m = 0; m < 4; ++m)
#pragma unroll
                    for (int n = 0; n < 2; ++n) acc[a][b][m][n] = (f32x4){0.f, 0.f, 0.f, 0.f};
        cur = nxt; cA = nA; cB = nB; ++ui;
        if (wr == 1) PG8_BAR;
    }
    PG8_WAIT_V(0);
    PG8_BAR;
    if constexpr (Epi::AFTER_DRAIN) { E.fused(acc, cur, wr, wc, fr, fq, lds, wid, lane); }
#undef PG8_SA
#undef PG8_SB
#undef PG8_STAGE
#undef PG8_LDA
#undef PG8_LDB
#undef PG8_MMA
#undef PG8_WAIT_V
#undef PG8_WAIT_L
#undef PG8_BAR
#undef PG8_SCHED
}

#define EPI_ROWS(ai, m) (u.pm * BM + (ai) * HALF + wr * 64 + (m) * 16 + fr)
typedef const f32x4 (&AccRef)[2][2][4][2];

struct EpiSwiglu {
    static constexpr bool PERM = true, AFTER_DRAIN = false;
    bf16_t* O;
    __device__ __forceinline__ void operator()(AccRef acc, const Unit& u, int wr, int wc, int fr, int fq) const {
        const int col0 = u.pn * 128 + wc * 32 + 8 * fq;
#pragma unroll
        for (int ai = 0; ai < 2; ++ai)
#pragma unroll
            for (int m = 0; m < 4; ++m) {
                const f32x4 g0 = acc[ai][0][m][0], g1 = acc[ai][0][m][1], u0 = acc[ai][1][m][0], u1 = acc[ai][1][m][1];
                u32x4 w;
                w.x = cvt_pk_bf16(silu(g0[0]) * u0[0], silu(g0[1]) * u0[1]); w.y = cvt_pk_bf16(silu(g0[2]) * u0[2], silu(g0[3]) * u0[3]);
                w.z = cvt_pk_bf16(silu(g1[0]) * u1[0], silu(g1[1]) * u1[1]); w.w = cvt_pk_bf16(silu(g1[2]) * u1[2], silu(g1[3]) * u1[3]);
                *(u32x4*)(O + (size_t)EPI_ROWS(ai, m) * FF + col0) = w;
            }
    }
};
struct EpiBf16 {
    static constexpr bool PERM = true, AFTER_DRAIN = false;
    bf16_t* O; int ldc; float scale;
    __device__ __forceinline__ void operator()(AccRef acc, const Unit& u, int wr, int wc, int fr, int fq) const {
        const int col0 = u.pn * BM + wc * 32 + 8 * fq;
#pragma unroll
        for (int ai = 0; ai < 2; ++ai)
#pragma unroll
            for (int m = 0; m < 4; ++m) { bf16_t* rowp = O + (size_t)EPI_ROWS(ai, m) * ldc + col0;
#pragma unroll
                for (int bj = 0; bj < 2; ++bj) { const f32x4 v0 = acc[ai][bj][m][0] * scale, v1 = acc[ai][bj][m][1] * scale;
                    u32x4 w; w.x = cvt_pk_bf16(v0[0], v0[1]); w.y = cvt_pk_bf16(v0[2], v0[3]); w.z = cvt_pk_bf16(v1[0], v1[1]); w.w = cvt_pk_bf16(v1[2], v1[3]);
                    *(u32x4*)(rowp + bj * HALF) = w; } }
    }
};
struct EpiProj {
    static constexpr bool PERM = true, AFTER_DRAIN = false;
    bf16_t *PR, *PL, *GG, *SG0;
    __device__ __forceinline__ void operator()(AccRef acc, const Unit& u, int wr, int wc, int fr, int fq) const {
        const int pn = u.pn, cw = wc * 32 + 8 * fq;
        if (pn >= 17 && pn < 25) {
            const int col0 = (pn - 17) * 128 + cw;
#pragma unroll
            for (int ai = 0; ai < 2; ++ai)
#pragma unroll
                for (int m = 0; m < 4; ++m) {
                    const f32x4 g0 = acc[ai][0][m][0], g1 = acc[ai][0][m][1], s0 = acc[ai][1][m][0], s1 = acc[ai][1][m][1];
                    u32x4 w;
                    w.x = cvt_pk_bf16(gelu_t(g0[0]) * sigm(s0[0]), gelu_t(g0[1]) * sigm(s0[1])); w.y = cvt_pk_bf16(gelu_t(g0[2]) * sigm(s0[2]), gelu_t(g0[3]) * sigm(s0[3]));
                    w.z = cvt_pk_bf16(gelu_t(g1[0]) * sigm(s1[0]), gelu_t(g1[1]) * sigm(s1[1])); w.w = cvt_pk_bf16(gelu_t(g1[2]) * sigm(s1[2]), gelu_t(g1[3]) * sigm(s1[3]));
                    *(u32x4*)(GG + (size_t)EPI_ROWS(ai, m) * D + col0) = w;
                }
        } else {
            bf16_t* base; int ldc, colt; bool sg = false;
            if (pn < 13) { base = PR; ldc = RP; colt = pn * 256; } else { ldc = D; sg = pn >= 17; colt = ((pn - 13) & 3) * 256; base = sg ? SG0 : PL; }
#pragma unroll
            for (int ai = 0; ai < 2; ++ai)
#pragma unroll
                for (int m = 0; m < 4; ++m) { bf16_t* rowp = base + (size_t)EPI_ROWS(ai, m) * ldc + colt + cw;
#pragma unroll
                    for (int bj = 0; bj < 2; ++bj) { f32x4 v0 = acc[ai][bj][m][0], v1 = acc[ai][bj][m][1];
                        if (sg) { v0 = (f32x4){sigm(v0[0]), sigm(v0[1]), sigm(v0[2]), sigm(v0[3])}; v1 = (f32x4){sigm(v1[0]), sigm(v1[1]), sigm(v1[2]), sigm(v1[3])}; }
                        u32x4 w; w.x = cvt_pk_bf16(v0[0], v0[1]); w.y = cvt_pk_bf16(v0[2], v0[3]); w.z = cvt_pk_bf16(v1[0], v1[1]); w.w = cvt_pk_bf16(v1[2], v1[3]);
                        *(u32x4*)(rowp + bj * HALF) = w; } }
        }
    }
};
struct EpiResid {
    static constexpr bool PERM = false, AFTER_DRAIN = false;
    const float* base; float* out; float s;
    __device__ __forceinline__ void operator()(AccRef acc, const Unit& u, int wr, int wc, int fr, int fq) const {
        const int col0 = u.pn * BM + wc * 32 + 4 * fq;
#pragma unroll
        for (int ai = 0; ai < 2; ++ai)
#pragma unroll
            for (int m = 0; m < 4; ++m) { const size_t off = (size_t)EPI_ROWS(ai, m) * D + col0;
#pragma unroll
                for (int bj = 0; bj < 2; ++bj)
#pragma unroll
                    for (int n = 0; n < 2; ++n) { const f32x4 b = *(const f32x4*)(base + off + bj * HALF + n * 16);
                        *(f32x4*)(out + off + bj * HALF + n * 16) = b * DN_ALPHA + acc[ai][bj][m][n] * s; } }
    }
};
struct EpiKV {
    static constexpr bool PERM = false, AFTER_DRAIN = false;
    float *ok, *ov; bf16_t* KB;
    __device__ __forceinline__ void operator()(AccRef acc, const Unit& u, int wr, int wc, int fr, int fq) const {
        const bool isk = u.pn < 4; float* o = isk ? ok : ov; const int col0 = (u.pn & 3) * BM + wc * 32 + 4 * fq;
#pragma unroll
        for (int ai = 0; ai < 2; ++ai)
#pragma unroll
            for (int m = 0; m < 4; ++m) { const size_t off = (size_t)EPI_ROWS(ai, m) * D + col0;
#pragma unroll
                for (int bj = 0; bj < 2; ++bj)
#pragma unroll
                    for (int n = 0; n < 2; ++n) { const f32x4 v = acc[ai][bj][m][n]; *(f32x4*)(o + off + bj * HALF + n * 16) = v;
                        if (isk) *(u32x2*)(KB + off + bj * HALF + n * 16) = pack4(v); } }
    }
};
struct EpiLora {
    static constexpr bool PERM = true, AFTER_DRAIN = false;
    bf16_t *WD, *AA, *G; const float *w0, *a0;
    __device__ __forceinline__ void operator()(AccRef acc, const Unit& u, int wr, int wc, int fr, int fq) const {
        const int kind = u.pn >> 2, colt = (u.pn & 3) * 256 + wc * 32 + 8 * fq;
        bf16_t* base = WD + (size_t)kind * ((WS_AA - WS_WD) / 2);
        const float* bias = kind == 0 ? w0 : a0;
#pragma unroll
        for (int bj = 0; bj < 2; ++bj) {
            f32x4 b0 = (f32x4){0.f, 0.f, 0.f, 0.f}, b1 = b0;
            if (kind < 2) { b0 = *(const f32x4*)(bias + colt + bj * HALF); b1 = *(const f32x4*)(bias + colt + bj * HALF + 4); }
#pragma unroll
            for (int ai = 0; ai < 2; ++ai)
#pragma unroll
                for (int m = 0; m < 4; ++m) { f32x4 v0 = acc[ai][bj][m][0] + b0, v1 = acc[ai][bj][m][1] + b1;
                    if (kind == 0) { v0 = (f32x4){decay_e(v0[0]), decay_e(v0[1]), decay_e(v0[2]), decay_e(v0[3])}; v1 = (f32x4){decay_e(v1[0]), decay_e(v1[1]), decay_e(v1[2]), decay_e(v1[3])}; }
                    else if (kind == 1) { v0 = (f32x4){sigm(v0[0]), sigm(v0[1]), sigm(v0[2]), sigm(v0[3])}; v1 = (f32x4){sigm(v1[0]), sigm(v1[1]), sigm(v1[2]), sigm(v1[3])}; }
                    u32x4 w; w.x = cvt_pk_bf16(v0[0], v0[1]); w.y = cvt_pk_bf16(v0[2], v0[3]); w.z = cvt_pk_bf16(v1[0], v1[1]); w.w = cvt_pk_bf16(v1[2], v1[3]);
                    *(u32x4*)(base + (size_t)EPI_ROWS(ai, m) * D + colt + bj * HALF) = w; }
        }
    }
};
struct EpiLru {
    static constexpr bool PERM = true, AFTER_DRAIN = false;
    bf16_t *GR, *GI; const float *br, *bi;
    __device__ __forceinline__ void operator()(AccRef acc, const Unit& u, int wr, int wc, int fr, int fq) const {
        const int col0 = u.pn * 128 + wc * 32 + 8 * fq;
#pragma unroll
        for (int bj = 0; bj < 2; ++bj) {
            const float* bias = bj ? bi : br; bf16_t* base = bj ? GI : GR;
            const f32x4 b0 = *(const f32x4*)(bias + col0), b1 = *(const f32x4*)(bias + col0 + 4);
#pragma unroll
            for (int ai = 0; ai < 2; ++ai)
#pragma unroll
                for (int m = 0; m < 4; ++m) { const f32x4 v0 = acc[ai][bj][m][0] + b0, v1 = acc[ai][bj][m][1] + b1;
                    u32x4 w; w.x = cvt_pk_bf16(sigm(v0[0]), sigm(v0[1])); w.y = cvt_pk_bf16(sigm(v0[2]), sigm(v0[3])); w.z = cvt_pk_bf16(sigm(v1[0]), sigm(v1[1])); w.w = cvt_pk_bf16(sigm(v1[2]), sigm(v1[3]));
                    *(u32x4*)(base + (size_t)EPI_ROWS(ai, m) * D + col0) = w; }
        }
    }
};
struct EpiSoftmax {
    static constexpr bool PERM = true, AFTER_DRAIN = true;
    bf16_t* P;
    __device__ __forceinline__ void fused(f32x4 (&acc)[2][2][4][2], const Unit& u, int wr, int wc, int fr, int fq, LAS unsigned char* lds, int wid, int lane) const {
        LAS float* MX = (LAS float*)lds;
        LAS float* SM = (LAS float*)(lds + 4096);
#pragma unroll
        for (int ai = 0; ai < 2; ++ai)
#pragma unroll
            for (int m = 0; m < 4; ++m) {
                float mx = -3.0e38f;
#pragma unroll
                for (int bj = 0; bj < 2; ++bj)
#pragma unroll
                    for (int n = 0; n < 2; ++n) { const f32x4 x = acc[ai][bj][m][n]; mx = fmaxf(mx, fmaxf(fmaxf(x[0], x[1]), fmaxf(x[2], x[3]))); }
                mx = fmaxf(mx, __shfl_xor(mx, 16)); mx = fmaxf(mx, __shfl_xor(mx, 32));
                if (fq == 0) MX[(ai * HALF + wr * 64 + m * 16 + fr) * 4 + wc] = mx;
            }
        __syncthreads();
#pragma unroll
        for (int ai = 0; ai < 2; ++ai)
#pragma unroll
            for (int m = 0; m < 4; ++m) {
                const int rl = ai * HALF + wr * 64 + m * 16 + fr;
                const f32x4 mm = *(const LAS f32x4*)(MX + rl * 4);
                const float mx = fmaxf(fmaxf(mm[0], mm[1]), fmaxf(mm[2], mm[3]));
                float s = 0.f;
#pragma unroll
                for (int bj = 0; bj < 2; ++bj)
#pragma unroll
                    for (int n = 0; n < 2; ++n) { f32x4 x = acc[ai][bj][m][n];
                        x = (f32x4){__builtin_amdgcn_exp2f(x[0] - mx), __builtin_amdgcn_exp2f(x[1] - mx), __builtin_amdgcn_exp2f(x[2] - mx), __builtin_amdgcn_exp2f(x[3] - mx)};
                        acc[ai][bj][m][n] = x; s += (x[0] + x[1]) + (x[2] + x[3]); }
                s += __shfl_xor(s, 16); s += __shfl_xor(s, 32);
                if (fq == 0) SM[rl * 4 + wc] = s;
            }
        __syncthreads();
        const int col0 = u.pn * BM + wc * 32 + 8 * fq;
#pragma unroll
        for (int ai = 0; ai < 2; ++ai)
#pragma unroll
            for (int m = 0; m < 4; ++m) {
                const int rl = ai * HALF + wr * 64 + m * 16 + fr;
                const f32x4 ss = *(const LAS f32x4*)(SM + rl * 4);
                const float inv = 1.0f / ((ss[0] + ss[1]) + (ss[2] + ss[3]));
                bf16_t* rowp = P + (size_t)(u.pm * BM + rl) * D + col0;
#pragma unroll
                for (int bj = 0; bj < 2; ++bj) { const f32x4 v0 = acc[ai][bj][m][0] * inv, v1 = acc[ai][bj][m][1] * inv;
                    u32x4 w; w.x = cvt_pk_bf16(v0[0], v0[1]); w.y = cvt_pk_bf16(v0[2], v0[3]); w.z = cvt_pk_bf16(v1[0], v1[1]); w.w = cvt_pk_bf16(v1[2], v1[3]);
                    *(u32x4*)(rowp + bj * HALF) = w; }
            }
        __syncthreads();
    }
};
}

template <bool PAIR, class F>
__device__ __forceinline__ void skinny(const bf16_t* A, int lda, const bf16_t* Bt, int ldb, int K, int tile_lo, int tile_hi, int kmode, int gw, int ngw, int lane_, F f) {
    const int lane = opaque(lane_), fr = lane & 15, fq = lane >> 4;
    constexpr int CG = PAIR ? 8 : 16;
    const int nunits = (tile_hi - tile_lo) * CG * 8;
    for (int un = gw; un < nunits; un += ngw) {
        const int rb = un & 7, cgp = (un >> 3) % CG, tile = tile_lo + (un >> 3) / CG;
        const int n0 = tile * 256 + cgp * 16, row = MP + rb * 16 + fr;
        const bf16_t* ap = A + (size_t)row * lda + (kmode ? 256 * (tile >> 1) : 0) + fq * 8;
        const bf16_t* bp = Bt + (size_t)(n0 + fr) * ldb + fq * 8;
        f32x4 acc0 = (f32x4){0.f, 0.f, 0.f, 0.f}, acc1 = acc0;
        for (int k0 = 0; k0 < K; k0 += 256) {
#pragma unroll
            for (int kk = 0; kk < 256; kk += 32) {
                const bf16x8 a = *(const bf16x8*)(ap + k0 + kk), b = *(const bf16x8*)(bp + k0 + kk);
                acc0 = __builtin_amdgcn_mfma_f32_16x16x32_bf16(b, a, acc0, 0, 0, 0);
                if (PAIR) { const bf16x8 b2 = *(const bf16x8*)(bp + (size_t)128 * ldb + k0 + kk); acc1 = __builtin_amdgcn_mfma_f32_16x16x32_bf16(b2, a, acc1, 0, 0, 0); }
            }
        }
        f(row, tile, cgp * 16 + 4 * fq, acc0, acc1);
    }
}

__device__ __forceinline__ int map_row(int mapmode, int n) {
    if (mapmode == 1) { if (n < FF) return 256 * (n / 128) + (n % 128); const int q = n - FF; return 256 * (q / 128) + 128 + (q % 128); }
    if (mapmode == 2) { if (n < 4352) return n; if (n < 5376) { const int q = n - 4352; return 256 * (17 + q / 128) + (q % 128); }
                        if (n < 6400) return 256 * 25 + (n - 5376); const int q = n - 6400; return 256 * (17 + q / 128) + 128 + (q % 128); }
    return n;
}
__device__ __forceinline__ void transpose_item(const float* W, int K, int N, bf16_t* WT, int mapmode, LAS float* scr, int item, int lane) {
    const int nblk = N / 32, kb = item / nblk, nb = item % nblk, k0 = 64 * kb, n0 = 32 * nb;
#pragma unroll 8
    for (int i = 0; i < 32; ++i) { const int kk = 2 * i + (lane >> 5); scr[kk * 33 + (lane & 31)] = W[(size_t)(k0 + kk) * N + n0 + (lane & 31)]; }
    asm volatile("s_waitcnt lgkmcnt(0)" ::: "memory");
    const int c = lane & 7, d0 = map_row(mapmode, n0);
#pragma unroll
    for (int j = 0; j < 4; ++j) { const int n = (lane >> 3) + 8 * j; const LAS float* s = scr + (8 * c) * 33 + n;
        u32x4 o; o.x = cvt_pk_bf16(s[0 * 33], s[1 * 33]); o.y = cvt_pk_bf16(s[2 * 33], s[3 * 33]); o.z = cvt_pk_bf16(s[4 * 33], s[5 * 33]); o.w = cvt_pk_bf16(s[6 * 33], s[7 * 33]);
        *(u32x4*)(WT + (size_t)(d0 + n) * K + k0 + 8 * c) = o; }
    asm volatile("s_waitcnt lgkmcnt(0)" ::: "memory");
}

struct Args { const float* in[39]; float* out; unsigned char* ws; int ph_lo, ph_hi; };

__device__ __forceinline__ void ln_pass(const float* PRE, const float* g, const float* b, float* H, bf16_t* HB, int gw, int ngw, int lane) {
    f32x4 gv[4], bv[4];
#pragma unroll
    for (int j = 0; j < 4; ++j) { gv[j] = *(const f32x4*)(g + 256 * j + 4 * lane); bv[j] = *(const f32x4*)(b + 256 * j + 4 * lane); }
    for (int row = gw; row < MT; row += ngw) {
        const float* p = PRE + (size_t)row * D + 4 * lane;
        f32x4 v[4]; float s = 0.f;
#pragma unroll
        for (int j = 0; j < 4; ++j) { v[j] = *(const f32x4*)(p + 256 * j); s += (v[j].x + v[j].y) + (v[j].z + v[j].w); }
        const float mean = wave_sum(s) * (1.f / D); float s2 = 0.f;
#pragma unroll
        for (int j = 0; j < 4; ++j) { v[j] = v[j] - mean; s2 += (v[j].x * v[j].x + v[j].y * v[j].y) + (v[j].z * v[j].z + v[j].w * v[j].w); }
        const float rstd = 1.0f / sqrtf(wave_sum(s2) * (1.f / D) + LN_EPS);
#pragma unroll
        for (int j = 0; j < 4; ++j) { const f32x4 o = v[j] * rstd * gv[j] + bv[j];
            *(f32x4*)(H + (size_t)row * D + 256 * j + 4 * lane) = o;
            if (HB) *(u32x2*)(HB + (size_t)row * D + 256 * j + 4 * lane) = pack4(o); }
    }
}

#define PH_IDS const int tid = opaque(threadIdx.x), lane = tid & 63, wave = __builtin_amdgcn_readfirstlane(tid >> 6), gw = bx * NWAVES + wave, gt = bx * NTHR + tid; (void)lane; (void)gw; (void)gt; PH_PTRS
#define PH_PTRS \
    unsigned char* ws = args.ws; float* out = args.out; \
    bf16_t *WI = (bf16_t*)(ws + WS_WI), *WO = (bf16_t*)(ws + WS_WO), *WIN = (bf16_t*)(ws + WS_WIN), *WMIX = (bf16_t*)(ws + WS_WMIX), *WQ = (bf16_t*)(ws + WS_WQ), *WOX = (bf16_t*)(ws + WS_WOX), \
           *WKV = (bf16_t*)(ws + WS_WKV), *LORAT = (bf16_t*)(ws + WS_LORAT), *LRUT = (bf16_t*)(ws + WS_LRUT), *MEMB = (bf16_t*)(ws + WS_MEMB), *KB = (bf16_t*)(ws + WS_KB), *VT = (bf16_t*)(ws + WS_VT), \
           *HB = (bf16_t*)(ws + WS_HB), *PR = (bf16_t*)(ws + WS_PR), *PL = (bf16_t*)(ws + WS_PL), *GG = (bf16_t*)(ws + WS_GG), *SG0 = (bf16_t*)(ws + WS_SG0), *GI = (bf16_t*)(ws + WS_GI), \
           *WD = (bf16_t*)(ws + WS_WD), *AA = (bf16_t*)(ws + WS_AA), *GB = (bf16_t*)(ws + WS_G), *LB = (bf16_t*)(ws + WS_L); \
    bf16_t *ACT = PR, *XC = HB, *MB = HB, *GR = PL, *LO = GI, *QB = PL, *PB = GG, *OB = SG0; \
    float *PRE = (float*)(ws + WS_PRE), *Y = PRE, *H = out; \
    (void)WI; (void)WO; (void)WIN; (void)WMIX; (void)WQ; (void)WOX; (void)WKV; (void)LORAT; (void)LRUT; (void)MEMB; (void)KB; (void)VT; (void)HB; (void)PR; (void)PL; (void)GG; (void)SG0; (void)GI; \
    (void)WD; (void)AA; (void)GB; (void)LB; (void)ACT; (void)XC; (void)MB; (void)GR; (void)LO; (void)QB; (void)PB; (void)OB; (void)PRE; (void)Y; (void)H;
#define INP(k) (args.in[k])
#ifndef PHSEL
#define PHSEL(k) true
#endif
template <int ph>
__device__ __forceinline__ void run_phase(const Args& args, LAS unsigned char* lds, const int G, const int bx, const bool fin = true) {
    const int ngw = G * NWAVES, ngt = G * NTHR; (void)ngw; (void)ngt;
    switch (ph) {
    case 0: if (PHSEL(0)) { PH_IDS
        const float *x_prompt = INP(0), *x_sample = INP(1), *mem_prompt = INP(2), *decay_w2 = INP(18), *aaa_a2 = INP(20), *gate_g2 = INP(21), *lru_wr = INP(29), *lru_wi = INP(31);
        LAS float* scr = (LAS float*)(lds + wave * 16384);
        constexpr int I_WI = 16 * (2 * FF / 32), I_WO = (FF / 64) * 32, I_WIN = 16 * (PW / 32), I_SQ = 16 * 32;
        constexpr int NIT = I_WI + I_WO + I_WIN + 5 * I_SQ;
        for (int it = gw; it < NIT; it += ngw) {
            int r = it;
            if (r < I_WI) { transpose_item(INP(11), D, 2 * FF, WI, 1, scr, r, lane); continue; } r -= I_WI;
            if (r < I_WO) { transpose_item(INP(12), FF, D, WO, 0, scr, r, lane); continue; } r -= I_WO;
            if (r < I_WIN) { transpose_item(INP(15), D, PW, WIN, 2, scr, r, lane); continue; } r -= I_WIN;
            if (r < I_SQ) { transpose_item(INP(34), D, D, WMIX, 0, scr, r, lane); continue; } r -= I_SQ;
            if (r < I_SQ) { transpose_item(INP(35), D, D, WQ, 0, scr, r, lane); continue; } r -= I_SQ;
            if (r < I_SQ) { transpose_item(INP(36), D, D, WKV, 0, scr, r, lane); continue; } r -= I_SQ;
            if (r < I_SQ) { transpose_item(INP(37), D, D, WKV + (size_t)D * D, 0, scr, r, lane); continue; } r -= I_SQ;
            transpose_item(INP(38), D, D, WOX, 0, scr, r, lane);
        }
        for (int i = gt; i < 3072 * 256; i += ngt) { const int n = i >> 8, k = i & 255; float v = 0.f;
            if (n < 1024) { if (k < 64) v = decay_w2[k * 1024 + n]; } else if (n < 2048) { if (k >= 64 && k < 128) v = aaa_a2[(k - 64) * 1024 + (n - 1024)]; } else { if (k >= 128) v = gate_g2[(k - 128) * 1024 + (n - 2048)]; }
            LORAT[i] = f2bf(v); }
        for (int i = gt; i < 2048 * 256; i += ngt) { const int n = i >> 8, k = i & 255; const int q = n >> 8, bj = (n >> 7) & 1, j = n & 127;
            const int c = 128 * q + j, nb = c >> 6, d = c & 63; const int cin = 256 * (q >> 1) + k; float v = 0.f;
            if ((cin >> 6) == nb) v = (bj ? lru_wi : lru_wr)[(nb * 64 + (cin & 63)) * 64 + d];
            LRUT[i] = f2bf(v); }
        for (int i = gt; i < MT * D / 4; i += ngt) { const f32x4 v = (i < MP * D / 4) ? ((const f32x4*)x_prompt)[i] : ((const f32x4*)x_sample)[i - MP * D / 4];
            ((f32x4*)H)[i] = v; ((u32x2*)HB)[i] = pack4(v); }
        for (int i = gt; i < NB * 256 * D / 4; i += ngt) ((u32x2*)MEMB)[i] = pack4(((const f32x4*)mem_prompt)[i]);
    } break;

    case 1: case 16: if (PHSEL(1)) { PH_IDS
        { pg8::Gemm g{HB, WI, D, D, D}; pg8::Sched S; S.init(MP / 256, 2 * FF / 256, G, bx, 0, D, D); pg8::EpiSwiglu E{ACT}; pg8::gemm_phase(lds, g, S, E); }
        skinny<true>(HB, D, WI, D, D, 0, 2 * FF / 256, 0, gw, ngw, lane, [&](int row, int tile, int cin, f32x4 a, f32x4 b) {
            f32x4 o = (f32x4){silu(a[0]) * b[0], silu(a[1]) * b[1], silu(a[2]) * b[2], silu(a[3]) * b[3]};
            *(u32x2*)(ACT + (size_t)row * FF + tile * 128 + cin) = pack4(o); });
        if (ph == 1) {
        { pg8::Gemm g{MEMB, WKV, D, D, D}; pg8::Sched S; S.init(8, 8, G, bx, 0, D, D); pg8::EpiKV E{out + O_PMK, out + O_PMV, KB}; pg8::gemm_phase(lds, g, S, E); }
        { pg8::Gemm g{WKV + (size_t)D * D, MEMB, D, D, D}; pg8::Sched S; S.init(4, 8, G, bx, 0, D, D); pg8::EpiBf16 E{VT, NB * 256, 1.0f}; pg8::gemm_phase(lds, g, S, E); }
        }
    } break;
    case 2: case 17: if (PHSEL(2)) { PH_IDS
        { pg8::Gemm g{ACT, WO, FF, FF, FF}; pg8::Sched S; S.init(MP / 256, D / 256, G, bx, 0, FF, FF); pg8::EpiResid E{H, PRE, 0.5f}; pg8::gemm_phase(lds, g, S, E); }
        skinny<false>(ACT, FF, WO, FF, FF, 0, D / 256, 0, gw, ngw, lane, [&](int row, int tile, int cin, f32x4 a, f32x4) {
            const size_t off = (size_t)row * D + tile * 256 + cin; *(f32x4*)(PRE + off) = *(const f32x4*)(H + off) * DN_ALPHA + a * 0.5f; });
    } break;
    case 3: case 10: case 15: case 18: if (PHSEL(3)) { PH_IDS
        const float *ln_g = INP(9), *ln_b = INP(10);
        const int li = ph == 3 ? 0 : (ph == 10 ? 1 : (ph == 15 ? 2 : 3));
        ln_pass(PRE, ln_g + li * D, ln_b + li * D, H, ph == 18 ? (bf16_t*)nullptr : HB, gw, ngw, lane);
    } break;
    case 4: if (PHSEL(4)) { PH_IDS
        { pg8::Gemm g{HB, WIN, D, D, D}; pg8::Sched S; S.init(MP / 256, PW / 256, G, bx, 0, D, D); pg8::EpiProj E{PR, PL, GG, SG0}; pg8::gemm_phase(lds, g, S, E); }
        skinny<false>(HB, D, WIN, D, D, 0, 17, 0, gw, ngw, lane, [&](int row, int tile, int cin, f32x4 a, f32x4) {
            if (tile < 13) *(u32x2*)(PR + (size_t)row * RP + tile * 256 + cin) = pack4(a); else *(u32x2*)(PL + (size_t)row * D + (tile - 13) * 256 + cin) = pack4(a); });
        skinny<false>(HB, D, WIN, D, D, 25, 29, 0, gw, ngw, lane, [&](int row, int tile, int cin, f32x4 a, f32x4) {
            *(u32x2*)(SG0 + (size_t)row * D + (tile - 25) * 256 + cin) = pack4((f32x4){sigm(a[0]), sigm(a[1]), sigm(a[2]), sigm(a[3])}); });
        skinny<true>(HB, D, WIN, D, D, 17, 25, 0, gw, ngw, lane, [&](int row, int tile, int cin, f32x4 a, f32x4 b) {
            *(u32x2*)(GG + (size_t)row * D + (tile - 17) * 128 + cin) = pack4((f32x4){gelu_t(a[0]) * sigm(b[0]), gelu_t(a[1]) * sigm(b[1]), gelu_t(a[2]) * sigm(b[2]), gelu_t(a[3]) * sigm(b[3])}); });
    } break;
    case 5: if (PHSEL(5)) { PH_IDS
        const float *state_shift = INP(6), *state_conv = INP(8), *shift_mu = INP(16), *conv_w = INP(27), *conv_b = INP(28);
        for (int row = gw; row < MT; row += ngw) {
            const bool smp = row >= MP; const int t = row & (T - 1), b = row >> 11, si = row - MP;
            { const int c = 3072 + 4 * lane; const f32x4 p = unpack4(*(const u32x2*)(PR + (size_t)row * RP + c));
              f32x4 pv = (f32x4){0.f, 0.f, 0.f, 0.f};
              if (smp) pv = *(const f32x4*)(state_shift + (size_t)si * RP + c); else if (t > 0) pv = unpack4(*(const u32x2*)(PR + (size_t)(row - 1) * RP + c));
              const f32x4 mu = *(const f32x4*)(shift_mu + c); f32x4 xs = p + (pv - p) * mu;
              if (lane < 16) xs = (f32x4){tanh_(xs[0]), tanh_(xs[1]), tanh_(xs[2]), tanh_(xs[3])}; else if (lane >= 32) xs = (f32x4){sigm(xs[0]), sigm(xs[1]), sigm(xs[2]), sigm(xs[3])};
              *(u32x2*)(LB + (size_t)row * 256 + 4 * lane) = pack4(xs); }
#pragma unroll
            for (int j = 0; j < 4; ++j) { const int c = 256 * j + 4 * lane;
                const f32x4 p3 = unpack4(*(const u32x2*)(PL + (size_t)row * D + c));
                f32x4 p0 = (f32x4){0.f, 0.f, 0.f, 0.f}, p1 = p0, p2 = p0;
                if (smp) { p0 = *(const f32x4*)(state_conv + ((size_t)si * 3 + 0) * D + c); p1 = *(const f32x4*)(state_conv + ((size_t)si * 3 + 1) * D + c); p2 = *(const f32x4*)(state_conv + ((size_t)si * 3 + 2) * D + c); }
                else { if (t >= 3) p0 = unpack4(*(const u32x2*)(PL + (size_t)(row - 3) * D + c)); if (t >= 2) p1 = unpack4(*(const u32x2*)(PL + (size_t)(row - 2) * D + c)); if (t >= 1) p2 = unpack4(*(const u32x2*)(PL + (size_t)(row - 1) * D + c)); }
                const f32x4 xc = *(const f32x4*)(conv_b + c) + *(const f32x4*)(conv_w + c) * p0 + *(const f32x4*)(conv_w + D + c) * p1 + *(const f32x4*)(conv_w + 2 * D + c) * p2 + *(const f32x4*)(conv_w + 3 * D + c) * p3;
                *(u32x2*)(XC + (size_t)row * D + c) = pack4(xc);
                if (smp) { *(f32x4*)(out + O_SCONV + ((size_t)si * 3 + 0) * D + c) = p1; *(f32x4*)(out + O_SCONV + ((size_t)si * 3 + 1) * D + c) = p2; *(f32x4*)(out + O_SCONV + ((size_t)si * 3 + 2) * D + c) = p3; }
                else if (t >= T - 3) *(f32x4*)(out + O_PCONV + ((size_t)b * 3 + (t - (T - 3))) * D + c) = p3; }
            if (smp || t == T - 1) { float* dst = smp ? out + O_SSHIFT + (size_t)si * RP : out + O_PSHIFT + (size_t)b * RP;
                for (int c = 4 * lane; c < RP; c += 256) *(f32x4*)(dst + c) = unpack4(*(const u32x2*)(PR + (size_t)row * RP + c)); }
        }
    } break;
    case 6: if (PHSEL(6)) { PH_IDS
        const float *decay_w0 = INP(17), *aaa_a0 = INP(19), *lru_br = INP(30), *lru_bi = INP(32);
        { pg8::Gemm g{LB, LORAT, 256, 256, 256}; pg8::Sched S; S.init(MP / 256, 12, G, bx, 0, 256, 256); pg8::EpiLora E{WD, AA, GB, decay_w0, aaa_a0}; pg8::gemm_phase(lds, g, S, E); }
        { pg8::Gemm g{XC, LRUT, D, 256, 256}; pg8::Sched S; S.init(MP / 256, 8, G, bx, 1, D, 256); pg8::EpiLru E{GR, GI, lru_br, lru_bi}; pg8::gemm_phase(lds, g, S, E); }
        skinny<false>(LB, 256, LORAT, 256, 256, 0, 12, 0, gw, ngw, lane, [&](int row, int tile, int cin, f32x4 a, f32x4) {
            const int kind = tile >> 2, c = (tile & 3) * 256 + cin; f32x4 o = a;
            if (kind == 0) { const f32x4 bb = *(const f32x4*)(decay_w0 + c); o = (f32x4){decay_e(a[0] + bb[0]), decay_e(a[1] + bb[1]), decay_e(a[2] + bb[2]), decay_e(a[3] + bb[3])}; }
            else if (kind == 1) { const f32x4 bb = *(const f32x4*)(aaa_a0 + c); o = (f32x4){sigm(a[0] + bb[0]), sigm(a[1] + bb[1]), sigm(a[2] + bb[2]), sigm(a[3] + bb[3])}; }
            bf16_t* base = WD + (size_t)kind * ((WS_AA - WS_WD) / 2); *(u32x2*)(base + (size_t)row * D + c) = pack4(o); });
        skinny<true>(XC, D, LRUT, 256, 256, 0, 8, 1, gw, ngw, lane, [&](int row, int tile, int cin, f32x4 a, f32x4 b) {
            const int c = tile * 128 + cin; const f32x4 b0 = *(const f32x4*)(lru_br + c), b1 = *(const f32x4*)(lru_bi + c);
            *(u32x2*)(GR + (size_t)row * D + c) = pack4((f32x4){sigm(a[0] + b0[0]), sigm(a[1] + b0[1]), sigm(a[2] + b0[2]), sigm(a[3] + b0[3])});
            *(u32x2*)(GI + (size_t)row * D + c) = pack4((f32x4){sigm(b[0] + b1[0]), sigm(b[1] + b1[1]), sigm(b[2] + b1[2]), sigm(b[3] + b1[3])}); });
    } break;
    case 7: if (PHSEL(7)) { PH_IDS
        const float *state_rwkv = INP(5), *state_shift = INP(6), *state_lru = INP(7), *shift_mu = INP(16), *k_k = INP(22), *k_a = INP(23), *lru_lambda = INP(33);
        constexpr int TC = 32;
        LAS float* VEC = (LAS float*)lds;
        LAS float* SC = (LAS float*)(lds + 6 * TC * 64 * 4);
        LAS float* YB = (LAS float*)(lds + 6 * TC * 64 * 4 + 1024);
        for (int unit = bx; unit < 256; unit += G) {
            const int b = unit >> 5, h = (unit >> 1) & 15, half = unit & 1;
            const int tt = tid >> 4, cgq = tid & 15, chb = h * 64 + 4 * cgq;
            const f32x4 mu_r = *(const f32x4*)(shift_mu + chb), mu_k = *(const f32x4*)(shift_mu + 1024 + chb), mu_v = *(const f32x4*)(shift_mu + 2048 + chb),
                        kkc = *(const f32x4*)(k_k + chb), kac = *(const f32x4*)(k_a + chb);
            const int rowl = 4 * wave + (lane >> 4), kq = lane & 15, srow = 32 * half + rowl;
            f32x4 S = (f32x4){0.f, 0.f, 0.f, 0.f};
            u32x2 q_r, q_k, q_v, q_rp, q_kp, q_vp, q_e, q_a;
            auto issue = [&](int chunk) {
                const int tg = chunk * TC + tt; const size_t row = (size_t)b * T + tg; const bf16_t* base = PR + row * RP + chb;
                q_r = *(const u32x2*)(base); q_k = *(const u32x2*)(base + 1024); q_v = *(const u32x2*)(base + 2048);
                if (tg > 0) { q_rp = *(const u32x2*)(base - RP); q_kp = *(const u32x2*)(base - RP + 1024); q_vp = *(const u32x2*)(base - RP + 2048); }
                else { q_rp = (u32x2){0u, 0u}; q_kp = q_rp; q_vp = q_rp; }
                q_e = *(const u32x2*)(WD + row * D + chb); q_a = *(const u32x2*)(AA + row * D + chb);
            };
            issue(0);
            for (int chunk = 0; chunk < T / TC; ++chunk) {
                {
                    const f32x4 pr = unpack4(q_r), pk = unpack4(q_k), pv = unpack4(q_v);
                    const f32x4 r = pr + (unpack4(q_rp) - pr) * mu_r, k = pk + (unpack4(q_kp) - pk) * mu_k, v = pv + (unpack4(q_vp) - pv) * mu_v;
                    const f32x4 e = unpack4(q_e), a = unpack4(q_a);
                    const f32x4 w = (f32x4){__expf(-e[0]), __expf(-e[1]), __expf(-e[2]), __expf(-e[3])};
                    f32x4 kk = k * kkc; const float n2 = red16(dot4(kk, kk)); kk = kk * (1.0f / fmaxf(sqrtf(n2), 1e-12f));
                    const f32x4 kp = k * (1.0f + (a - 1.0f) * kac), bv = kk * a, wrv = w * r;
                    const float br = red16(dot4(bv, r)), kr = red16(dot4(kp, r));
                    const int o = tt * 64 + 4 * cgq;
                    *(LAS f32x4*)(VEC + 0 * TC * 64 + o) = -kk; *(LAS f32x4*)(VEC + 1 * TC * 64 + o) = wrv; *(LAS f32x4*)(VEC + 2 * TC * 64 + o) = w;
                    *(LAS f32x4*)(VEC + 3 * TC * 64 + o) = bv; *(LAS f32x4*)(VEC + 4 * TC * 64 + o) = kp; *(LAS f32x4*)(VEC + 5 * TC * 64 + o) = v;
                    if (cgq == 0) *(LAS f32x2*)(SC + 2 * tt) = (f32x2){br, kr};
                }
                __syncthreads();
                if (chunk + 1 < T / TC) issue(chunk + 1);
#pragma unroll 4
                for (int t = 0; t < TC; ++t) {
                    const int o = t * 64 + 4 * kq;
                    const f32x4 nk = *(const LAS f32x4*)(VEC + 0 * TC * 64 + o), wrv = *(const LAS f32x4*)(VEC + 1 * TC * 64 + o), wv = *(const LAS f32x4*)(VEC + 2 * TC * 64 + o),
                                bv = *(const LAS f32x4*)(VEC + 3 * TC * 64 + o), kv = *(const LAS f32x4*)(VEC + 4 * TC * 64 + o);
                    const float vv = VEC[5 * TC * 64 + t * 64 + srow]; const f32x2 sc = *(const LAS f32x2*)(SC + 2 * t);
                    const float sa = red16(dot4(S, nk)), z = red16(dot4(S, wrv));
                    const float y = z + sa * sc.x + vv * sc.y;
                    S = S * wv + bv * sa + kv * vv;
                    if (kq == 0) YB[t * 32 + rowl] = y;
                }
                __syncthreads();
                { const int t2 = tid >> 4, r2 = (tid & 15) * 2;
                  *(f32x2*)(Y + ((size_t)b * T + chunk * TC + t2) * D + h * 64 + 32 * half + r2) = *(const LAS f32x2*)(YB + t2 * 32 + r2); }
            }
            *(f32x4*)(out + O_PRWKV + (((size_t)b * 16 + h) * 64 + srow) * 64 + 4 * kq) = S;
            __syncthreads();
        }
        if (fin) {
            LAS float* V1 = (LAS float*)(lds + wave * 2048);
            const int cgq = lane & 15;
            for (int un = gw; un < NS * 16; un += ngw) {
                const int i = un >> 4, h = un & 15, chb = h * 64 + 4 * cgq; const size_t row = (size_t)MP + i;
                const bf16_t* base = PR + row * RP + chb; const float* sb = state_shift + (size_t)i * RP + chb;
                const f32x4 pr = unpack4(*(const u32x2*)(base)), pk = unpack4(*(const u32x2*)(base + 1024)), pv = unpack4(*(const u32x2*)(base + 2048));
                const f32x4 r = pr + (*(const f32x4*)(sb) - pr) * *(const f32x4*)(shift_mu + chb), k = pk + (*(const f32x4*)(sb + 1024) - pk) * *(const f32x4*)(shift_mu + 1024 + chb),
                            v = pv + (*(const f32x4*)(sb + 2048) - pv) * *(const f32x4*)(shift_mu + 2048 + chb);
                const f32x4 e = unpack4(*(const u32x2*)(WD + row * D + chb)), a = unpack4(*(const u32x2*)(AA + row * D + chb));
                const f32x4 w = (f32x4){__expf(-e[0]), __expf(-e[1]), __expf(-e[2]), __expf(-e[3])};
                f32x4 kk = k * *(const f32x4*)(k_k + chb); const float n2 = red16(dot4(kk, kk)); kk = kk * (1.0f / fmaxf(sqrtf(n2), 1e-12f));
                const f32x4 kp = k * (1.0f + (a - 1.0f) * *(const f32x4*)(k_a + chb)), bv = kk * a, wrv = w * r;
                const float br = red16(dot4(bv, r)), kr = red16(dot4(kp, r));
                if (lane < 16) *(LAS f32x4*)(V1 + 320 + 4 * cgq) = v;
                asm volatile("s_waitcnt lgkmcnt(0)" ::: "memory");
                const f32x4 nk = -kk;
                const size_t sbase = ((size_t)i * 16 + h) * 4096;
#pragma unroll 4
                for (int rg = 0; rg < 16; ++rg) {
                    const int srow = 4 * rg + (lane >> 4);
                    f32x4 S = *(const f32x4*)(state_rwkv + sbase + srow * 64 + 4 * cgq);
                    const float vv = V1[320 + srow];
                    const float sa = red16(dot4(S, nk)), z = red16(dot4(S, wrv));
                    const float y = z + sa * br + vv * kr;
                    S = S * w + bv * sa + kp * vv;
                    *(f32x4*)(out + O_SRWKV + sbase + srow * 64 + 4 * cgq) = S;
                    if (cgq == 0) Y[row * D + h * 64 + srow] = y;
                }
                asm volatile("s_waitcnt lgkmcnt(0)" ::: "memory");
            }
        }
        __syncthreads();
        if (fin) {
            LAS float* sA = (LAS float*)lds; LAS float* sB = (LAS float*)(lds + 2048);
            for (int unit = bx; unit < 256; unit += G) {
                const int b = unit >> 5, ch = (unit & 31) * 32 + (tid & 31), seg = tid >> 5, t0 = seg * 128;
                const float sp = softplus_(-lru_lambda[ch]);
                const size_t base = ((size_t)b * T + t0) * D + ch;
                float Aacc = 1.f, Bacc = 0.f;
#pragma unroll 8
                for (int t = 0; t < 128; ++t) { const size_t o = base + (size_t)t * D;
                    const float gr = bf2f(GR[o]), gi = bf2f(GI[o]), xc = bf2f(XC[o]);
                    const float la = -8.0f * gr * sp, a = __expf(la), bb = sqrtf(fmaxf(-expm1f(2.0f * la), 0.f)) * gi * xc;
                    Aacc *= a; Bacc = a * Bacc + bb; }
                sA[seg * 32 + (tid & 31)] = Aacc; sB[seg * 32 + (tid & 31)] = Bacc;
                __syncthreads();
                float hst = 0.f;
                for (int s = 0; s < seg; ++s) hst = sA[s * 32 + (tid & 31)] * hst + sB[s * 32 + (tid & 31)];
#pragma unroll 8
                for (int t = 0; t < 128; ++t) { const size_t o = base + (size_t)t * D;
                    const float gr = bf2f(GR[o]), gi = bf2f(GI[o]), xc = bf2f(XC[o]), gg = bf2f(GG[o]);
                    const float la = -8.0f * gr * sp, a = __expf(la), bb = sqrtf(fmaxf(-expm1f(2.0f * la), 0.f)) * gi * xc;
                    hst = a * hst + bb; LO[o] = f2bf(hst * gg); }
                if (seg == 15) out[O_PLRU + (size_t)b * D + ch] = hst;
                __syncthreads();
            }
            for (int i = gt; i < NS * D; i += ngt) { const int ch = i & (D - 1); const size_t o = (size_t)MP * D + i;
                const float sp = softplus_(-lru_lambda[ch]);
                const float gr = bf2f(GR[o]), gi = bf2f(GI[o]), xc = bf2f(XC[o]), gg = bf2f(GG[o]);
                const float la = -8.0f * gr * sp, a = __expf(la), bb = sqrtf(fmaxf(-expm1f(2.0f * la), 0.f)) * gi * xc;
                const float hst = a * state_lru[i] + bb; out[O_SLRU + i] = hst; LO[o] = f2bf(hst * gg); }
        }
    } break;
    case 8: if (PHSEL(8)) { PH_IDS
        const float *state_shift = INP(6), *shift_mu = INP(16), *k_a = INP(23), *r_k = INP(24), *gn_g = INP(25), *gn_b = INP(26);
        for (int row = gw; row < MT; row += ngw) {
            const bool smp = row >= MP; const int t = row & (T - 1), si = row - MP;
#pragma unroll
            for (int j = 0; j < 4; ++j) { const int c = 256 * j + 4 * lane;
                const bf16_t* base = PR + (size_t)row * RP + c;
                const f32x4 pr = unpack4(*(const u32x2*)(base)), pk = unpack4(*(const u32x2*)(base + 1024)), pv = unpack4(*(const u32x2*)(base + 2048));
                f32x4 qr = (f32x4){0.f, 0.f, 0.f, 0.f}, qk = qr, qv = qr;
                if (smp) { const float* sb = state_shift + (size_t)si * RP + c; qr = *(const f32x4*)(sb); qk = *(const f32x4*)(sb + 1024); qv = *(const f32x4*)(sb + 2048); }
                else if (t > 0) { qr = unpack4(*(const u32x2*)(base - RP)); qk = unpack4(*(const u32x2*)(base - RP + 1024)); qv = unpack4(*(const u32x2*)(base - RP + 2048)); }
                const f32x4 r = pr + (qr - pr) * *(const f32x4*)(shift_mu + c), k = pk + (qk - pk) * *(const f32x4*)(shift_mu + 1024 + c), v = pv + (qv - pv) * *(const f32x4*)(shift_mu + 2048 + c);
                const f32x4 a = unpack4(*(const u32x2*)(AA + (size_t)row * D + c));
                const f32x4 kp = k * (1.0f + (a - 1.0f) * *(const f32x4*)(k_a + c));
                const float bon = red16(dot4(r * kp, *(const f32x4*)(r_k + c)));
                const f32x4 y = *(const f32x4*)(Y + (size_t)row * D + c);
                const float mean = red16((y.x + y.y) + (y.z + y.w)) * (1.0f / 64.0f);
                const f32x4 dy = y - mean; const float var = red16(dot4(dy, dy)) * (1.0f / 64.0f);
                const f32x4 yn = dy * (1.0f / sqrtf(var + GN_EPS)) * *(const f32x4*)(gn_g + c) + *(const f32x4*)(gn_b + c);
                const f32x4 gg = unpack4(*(const u32x2*)(GB + (size_t)row * D + c)), s0 = unpack4(*(const u32x2*)(SG0 + (size_t)row * D + c)), lo_ = unpack4(*(const u32x2*)(LO + (size_t)row * D + c));
                const f32x4 mg = s0 * ((yn + v * bon) * gg) + lo_;
                *(u32x2*)(MB + (size_t)row * D + c) = pack4(mg); }
        }
        __syncthreads();
        { LAS float* scr = (LAS float*)(lds + wave * 16384);
          constexpr int I_WI = 16 * (2 * FF / 32), I_WO = (FF / 64) * 32;
          for (int it = gw; it < I_WI + I_WO; it += ngw) { if (it < I_WI) transpose_item(INP(13), D, 2 * FF, WI, 1, scr, it, lane); else transpose_item(INP(14), FF, D, WO, 0, scr, it - I_WI, lane); } }
    } break;
    case 9: case 14: if (PHSEL(9)) { PH_IDS
        const bf16_t* Am = ph == 9 ? MB : OB; const bf16_t* Wt = ph == 9 ? WMIX : WOX;
        { pg8::Gemm g{Am, Wt, D, D, D}; pg8::Sched S; S.init(MP / 256, D / 256, G, bx, 0, D, D); pg8::EpiResid E{H, PRE, 1.0f}; pg8::gemm_phase(lds, g, S, E); }
        skinny<false>(Am, D, Wt, D, D, 0, D / 256, 0, gw, ngw, lane, [&](int row, int tile, int cin, f32x4 a, f32x4) {
            const size_t off = (size_t)row * D + tile * 256 + cin; *(f32x4*)(PRE + off) = *(const f32x4*)(H + off) * DN_ALPHA + a; });
    } break;
    case 11: if (PHSEL(11)) { PH_IDS
        const float qs = 0.0625f * 1.4426950408889634f;
        { pg8::Gemm g{HB, WQ, D, D, D}; pg8::Sched S; S.init(MP / 256, D / 256, G, bx, 0, D, D); pg8::EpiBf16 E{QB, D, qs}; pg8::gemm_phase(lds, g, S, E); }
        skinny<false>(HB, D, WQ, D, D, 0, D / 256, 0, gw, ngw, lane, [&](int row, int tile, int cin, f32x4 a, f32x4) { *(u32x2*)(QB + (size_t)row * D + tile * 256 + cin) = pack4(a * qs); });
    } break;
    case 12: if (PHSEL(12)) { PH_IDS
        const float *cache_k = INP(3), *cache_v = INP(4);
        { pg8::Gemm g{QB, KB, D, D, 256}; pg8::Sched S; S.init(MP / 256, 4, G, bx, 2, D, D); pg8::EpiSoftmax E{PB}; pg8::gemm_phase(lds, g, S, E); }
        __syncthreads();
        LAS float* sS = (LAS float*)lds;
        LAS float* sO = (LAS float*)(lds + 4096);
        for (int un = bx; un < NS * 4; un += G) {
            const int i = un >> 2, h = un & 3;
            const f32x4 q = unpack4(*(const u32x2*)(QB + (size_t)(MP + i) * D + h * 256 + 4 * lane));
            const float* kb = cache_k + ((size_t)i * 256 * 4 + h) * 256 + 4 * lane;
            const float* vb = cache_v + ((size_t)i * 256 * 4 + h) * 256 + 4 * lane;
#pragma unroll 8
            for (int mm = 0; mm < 32; ++mm) { const int m = wave * 32 + mm; const f32x4 kx = *(const f32x4*)(kb + (size_t)m * 1024);
                const float s = wave_sum(dot4(q, kx)); if (lane == 0) sS[m] = s; }
            __syncthreads();
            float mx = -3.0e38f;
#pragma unroll
            for (int j = 0; j < 4; ++j) mx = fmaxf(mx, sS[lane + 64 * j]);
            mx = wave_max(mx);
            float sum = 0.f;
#pragma unroll
            for (int j = 0; j < 4; ++j) sum += __builtin_amdgcn_exp2f(sS[lane + 64 * j] - mx);
            sum = wave_sum(sum); const float inv = 1.0f / sum;
            f32x4 o = (f32x4){0.f, 0.f, 0.f, 0.f};
#pragma unroll 8
            for (int mm = 0; mm < 32; ++mm) { const int m = wave * 32 + mm; const f32x4 vx = *(const f32x4*)(vb + (size_t)m * 1024);
                const float p = __builtin_amdgcn_exp2f(sS[m] - mx) * inv; o = o + vx * p; }
            *(LAS f32x4*)(sO + wave * 256 + 4 * lane) = o;
            __syncthreads();
            if (tid < 256) { float acc = 0.f;
#pragma unroll
                for (int w8 = 0; w8 < 8; ++w8) acc += sO[w8 * 256 + tid];
                OB[(size_t)(MP + i) * D + h * 256 + tid] = f2bf(acc); }
            __syncthreads();
        }
    } break;
    case 13: if (PHSEL(13)) { PH_IDS pg8::Gemm g{PB, VT, D, NB * 256, 256}; pg8::Sched S; S.init(MP / 256, 4, G, bx, 3, D, NB * 256); pg8::EpiBf16 E{OB, D, 1.0f}; pg8::gemm_phase(lds, g, S, E); } break;
    default: break;
    }
}

__global__ void __launch_bounds__(NTHR, 2) mega(Args args) {
    extern __shared__ __attribute__((aligned(16))) unsigned char lds_raw[];
    LAS unsigned char* lds = (LAS unsigned char*)lds_raw;
    cg::grid_group grid = cg::this_grid();
    const int G = gridDim.x, bx = blockIdx.x;
    const int lo = args.ph_lo, hi = args.ph_hi;
#ifndef DUPK
#define DUPK -1
#endif
#define GSYNC() do { asm volatile("s_waitcnt vmcnt(0) lgkmcnt(0)" ::: "memory"); __syncthreads(); \
        if (threadIdx.x < 64) asm volatile("buffer_wbl2 sc1\n\ts_waitcnt vmcnt(0)" ::: "memory"); \
        grid.sync(); \
        if (threadIdx.x < 64) asm volatile("buffer_inv sc1\n\ts_waitcnt vmcnt(0)" ::: "memory"); \
        __syncthreads(); } while (0)
#define RUN(k) if (lo <= (k) && (k) < hi) { if ((k) == DUPK) { run_phase<k>(args, lds, G, bx, false); GSYNC(); } run_phase<k>(args, lds, G, bx); if ((k) + 1 < hi) GSYNC(); }
    RUN(0) RUN(1) RUN(2) RUN(3) RUN(4) RUN(5) RUN(6) RUN(7) RUN(8) RUN(9) RUN(10) RUN(11) RUN(12) RUN(13) RUN(14) RUN(15) RUN(16) RUN(17) RUN(18)
#undef RUN
}

#ifndef N_LAUNCH_PER_PHASE
#define N_LAUNCH_PER_PHASE 0
#endif
extern "C" void kernel_launch(void* const* d_in, const int* in_sizes, int n_in, void* d_out, int out_size, void* d_ws, size_t ws_size, hipStream_t stream) {
    static int grid = 0;
    if (grid == 0) {
        if (n_in != 39 || out_size != (int)O_TOTAL || ws_size < WS_END) { fprintf(stderr, "kernel_launch: unexpected shapes (n_in %d out %d ws %zu)\n", n_in, out_size, ws_size); grid = -1; return; }
        int dev = 0, cus = 0, per_cu = 0;
        hipGetDevice(&dev); hipDeviceGetAttribute(&cus, hipDeviceAttributeMultiprocessorCount, dev);
        hipFuncSetAttribute((const void*)mega, hipFuncAttributeMaxDynamicSharedMemorySize, LDS_BYTES);
        hipOccupancyMaxActiveBlocksPerMultiprocessor(&per_cu, (const void*)mega, NTHR, LDS_BYTES);
        if (per_cu < 1) { fprintf(stderr, "kernel_launch: occupancy query says 0 blocks per CU\n"); grid = -1; return; }
        grid = cus;
    }
    if (grid < 0) return;
    Args a{};
    for (int i = 0; i < 39; ++i) a.in[i] = (const float*)d_in[i];
    a.out = (float*)d_out; a.ws = (unsigned char*)d_ws;
#if N_LAUNCH_PER_PHASE
    for (int p = 0; p < 19; ++p) { a.ph_lo = p; a.ph_hi = p + 1; void* kargs[] = {&a};
        hipLaunchCooperativeKernel((const void*)mega, dim3(grid), dim3(NTHR), kargs, LDS_BYTES, stream); }
#else
    a.ph_lo = 0; a.ph_hi = 19; void* kargs[] = {&a};
    hipError_t e = hipLaunchCooperativeKernel((const void*)mega, dim3(grid), dim3(NTHR), kargs, LDS_BYTES, stream);
    if (e != hipSuccess) fprintf(stderr, "cooperative launch failed: %s (grid %d)\n", hipGetErrorString(e), grid);
#endif
}
```

```cpp
#include <hip/hip_runtime.h>
#include <hip/hip_cooperative_groups.h>
#include <cstdio>
#include <cstdint>
namespace cg = cooperative_groups;

#define LAS __attribute__((address_space(3)))
typedef unsigned short bf16_t;
typedef short bf16x8 __attribute__((ext_vector_type(8)));
typedef float f32x4 __attribute__((ext_vector_type(4)));
typedef float f32x2 __attribute__((ext_vector_type(2)));
typedef unsigned u32x4 __attribute__((ext_vector_type(4)));
typedef unsigned u32x2 __attribute__((ext_vector_type(2)));

constexpr int D = 1024, T = 2048, NB = 8, MP = NB * T, NS = 128, MT = MP + NS, FF = 2816, RP = 3328, PW = 7424;
constexpr int NWAVES = 8, NTHR = 512;
constexpr float DN_ALPHA = 1.189207115002721f;
constexpr float LN_EPS = 1e-5f, GN_EPS = 64e-5f;

constexpr size_t MiB = 1u << 20;
constexpr size_t WS_WI = 1 * MiB, WS_WO = 12 * MiB, WS_WIN = 19 * MiB, WS_WMIX = 34 * MiB, WS_WQ = 36 * MiB, WS_WOX = 38 * MiB, WS_WKV = 40 * MiB,
                 WS_LORAT = 44 * MiB, WS_LRUT = 46 * MiB, WS_MEMB = 47 * MiB, WS_KB = 51 * MiB, WS_VT = 55 * MiB, WS_HB = 60 * MiB, WS_PRE = 93 * MiB,
                 WS_PR = 158 * MiB, WS_PL = 263 * MiB, WS_GG = 296 * MiB, WS_SG0 = 329 * MiB, WS_GI = 362 * MiB, WS_WD = 395 * MiB, WS_AA = 428 * MiB,
                 WS_G = 461 * MiB, WS_L = 494 * MiB, WS_END = 503 * MiB;
static_assert(WS_G - WS_AA == WS_AA - WS_WD, "WD/AA/G spacing");
static_assert((size_t)MT * RP * 2 <= 105 * MiB && (size_t)MT * D * 2 <= 33 * MiB && (size_t)MT * D * 4 <= 65 * MiB && (size_t)MT * 256 * 2 <= 9 * MiB, "ws map");
constexpr size_t O_YP = 0, O_YS = 16777216, O_PMK = 16908288, O_PMV = 19005440, O_PRWKV = 21102592, O_PSHIFT = 21626880, O_PLRU = 21653504,
                 O_PCONV = 21661696, O_SRWKV = 21686272, O_SSHIFT = 30074880, O_SLRU = 30500864, O_SCONV = 30631936, O_TOTAL = 31025152;

constexpr int LDS_BYTES = 139264;

typedef __bf16 bf16x2_t __attribute__((ext_vector_type(2)));
__device__ __forceinline__ unsigned cvt_pk_bf16(float lo, float hi) { const f32x2 v = {lo, hi}; return __builtin_bit_cast(unsigned, __builtin_convertvector(v, bf16x2_t)); }
__device__ __forceinline__ bf16_t f2bf(float f) { return (bf16_t)(cvt_pk_bf16(f, 0.f) & 0xffffu); }
__device__ __forceinline__ float bf2f(bf16_t h) { return __uint_as_float(((unsigned)h) << 16); }
__device__ __forceinline__ f32x4 unpack4(u32x2 u) { return (f32x4){__uint_as_float(u.x << 16), __uint_as_float(u.x & 0xffff0000u), __uint_as_float(u.y << 16), __uint_as_float(u.y & 0xffff0000u)}; }
__device__ __forceinline__ u32x2 pack4(f32x4 v) { u32x2 r; r.x = cvt_pk_bf16(v.x, v.y); r.y = cvt_pk_bf16(v.z, v.w); return r; }
__device__ __forceinline__ float sigm(float x) { return 1.0f / (1.0f + __expf(-x)); }
__device__ __forceinline__ float silu(float x) { return x * sigm(x); }
__device__ __forceinline__ float tanh_(float x) { float e = __expf(2.0f * x); return 1.0f - 2.0f / (e + 1.0f); }
__device__ __forceinline__ float gelu_t(float x) { float u = 0.7978845608028654f * (x + 0.044715f * x * x * x); return 0.5f * x * (1.0f + tanh_(u)); }
__device__ __forceinline__ float softplus_(float x) { return x > 20.f ? x : log1pf(expf(x)); }
__device__ __forceinline__ float decay_e(float pre) { return 0.6065306597126334f * sigm(pre); }
template <int CTRL> __device__ __forceinline__ float dppf(float x) { return __builtin_bit_cast(float, __builtin_amdgcn_update_dpp(0, __builtin_bit_cast(int, x), CTRL, 0xf, 0xf, true)); }
__device__ __forceinline__ float red16(float x) {
    x += dppf<0xB1>(x); x += dppf<0x4E>(x); x += dppf<0x141>(x); x += dppf<0x140>(x); return x;
}
__device__ __forceinline__ int opaque(int x) { asm volatile("" : "+v"(x)); return x; }
__device__ __forceinline__ float dot4(f32x4 a, f32x4 b) { return (a.x * b.x + a.y * b.y) + (a.z * b.z + a.w * b.w); }
__device__ __forceinline__ float wave_sum(float v) {
#pragma unroll
    for (int o = 1; o < 64; o <<= 1) v += __shfl_xor(v, o);
    return v;
}
__device__ __forceinline__ float wave_max(float v) {
#pragma unroll
    for (int o = 1; o < 64; o <<= 1) v = fmaxf(v, __shfl_xor(v, o));
    return v;
}

namespace pg8 {
constexpr int BM = 256, BK = 64, HALF = 128, HTB = HALF * BK * 2, STAGE_BYTES = 8 * HTB, NXCD = 8, WGM = 8;
__host__ __device__ __forceinline__ int lds_byte(int r, int c) { const int st = (r >> 4) * 2 + (c >> 5), rr = r & 15, cc = c & 31, ob = rr * 64 + cc * 2; return st * 1024 + (ob ^ (((ob >> 9) & 1) << 5)); }
__host__ __device__ __forceinline__ void stage_rc(int b, int& R, int& C) { const int st = b / 1024, sb = b % 1024, swz = sb ^ (((sb >> 9) & 1) << 5); R = (st >> 1) * 16 + swz / 64; C = (st & 1) * 32 + (swz % 64) / 2; }
__host__ __device__ __forceinline__ int perm32(int rho) { const int n = rho >> 4, i = rho & 15; return 8 * (i >> 2) + 4 * n + (i & 3); }

struct Unit { int pm, pn; };
struct Gemm { const bf16_t* A; const bf16_t* Bt; int lda, ldb, K; };

struct Sched {
    int nM, nN, nwg, G, c, mode;
    long lda, ldb;
    __device__ void init(int nM_, int nN_, int G_, int c_, int mode_, int lda_, int ldb_) { nM = nM_; nN = nN_; nwg = nM * nN; G = G_; c = c_; mode = mode_; lda = lda_; ldb = ldb_; }
    __device__ bool next(int i, Unit& u) const {
        const int L = i * G + c; if (L >= nwg) return false;
        int wgid = L; { const int q = nwg / NXCD, r = nwg % NXCD, xcd = wgid % NXCD, off = wgid / NXCD; wgid = (xcd < r ? xcd * (q + 1) : r * (q + 1) + (xcd - r) * q) + off; }
        const int nig = WGM * nN, gid = wgid / nig, fm = gid * WGM, gsz = (nM - fm) < WGM ? (nM - fm) : WGM;
        u.pm = fm + ((wgid % nig) % gsz); u.pn = (wgid % nig) / gsz; return true;
    }
    __device__ __forceinline__ long aoff(const Unit& u) const {
        long o = (long)u.pm * 256 * lda;
        if (mode == 1) o += 256 * (u.pn >> 1); else if (mode >= 2) o += u.pn * 256;
        return o;
    }
    __device__ __forceinline__ long boff(const Unit& u) const {
        if (mode == 2) return (long)(u.pm >> 3) * 256 * ldb + u.pn * 256;
        if (mode == 3) return (long)u.pn * 256 * ldb + (u.pm >> 3) * 256;
        return (long)u.pn * 256 * ldb;
    }
};

template <class Epi>
__device__ __forceinline__ void gemm_phase(LAS unsigned char* lds, const Gemm g, const Sched& S, const Epi& E) {
    const int tid = opaque(threadIdx.x), wid = __builtin_amdgcn_readfirstlane(tid >> 6), lane = tid & 63, wr = wid >> 2, wc = wid & 3, fr = lane & 15, fq = lane >> 4;
    const int K = g.K, nt = K / BK;
    unsigned voffA[2], voffB[2];
#pragma unroll
    for (int i = 0; i < 2; ++i) { int R, C; stage_rc(tid * 16 + i * 8192, R, C); const int Rb = Epi::PERM ? ((R & ~31) + perm32(R & 31)) : R;
        voffA[i] = (unsigned)(R * g.lda + C) * 2u; voffB[i] = (unsigned)(Rb * g.ldb + C) * 2u; }
    const size_t kstep = (size_t)(BK * 2);
    const size_t hstepA = (size_t)HALF * g.lda * 2, hstepB = (size_t)HALF * g.ldb * 2;
    const unsigned ldsw = (unsigned)wid * 1024u;
    const int aoff = lds_byte(wr * 64 + fr, fq * 8), boff = lds_byte(wc * 32 + fr, fq * 8);
#define PG8_SA(b, h) (((b) * 2 + (h)) * HTB)
#define PG8_SB(b, h) ((4 + (b) * 2 + (h)) * HTB)
#define PG8_STAGE(bufoff, gbase, voff) do { _Pragma("unroll") for (int _i = 0; _i < 2; ++_i) \
        __builtin_amdgcn_global_load_lds((const unsigned*)((const char*)(gbase) + (voff)[_i]), (LAS unsigned*)(lds + (bufoff) + ldsw + _i * 8192), 16, 0, 0); } while (0)
#define PG8_LDA(dst, b, h) do { _Pragma("unroll") for (int m = 0; m < 4; ++m) _Pragma("unroll") for (int k = 0; k < 2; ++k) dst[m][k] = *(const LAS bf16x8*)(lds + PG8_SA(b, h) + aoff + m * 2048 + k * 1024); } while (0)
#define PG8_LDB(dst, b, h) do { _Pragma("unroll") for (int n = 0; n < 2; ++n) _Pragma("unroll") for (int k = 0; k < 2; ++k) dst[n][k] = *(const LAS bf16x8*)(lds + PG8_SB(b, h) + boff + n * 2048 + k * 1024); } while (0)
#define PG8_MMA(ai, bj, At, Bt) do { __builtin_amdgcn_s_setprio(1); _Pragma("unroll") for (int m = 0; m < 4; ++m) _Pragma("unroll") for (int n = 0; n < 2; ++n) _Pragma("unroll") for (int k = 0; k < 2; ++k) \
        acc[ai][bj][m][n] = __builtin_amdgcn_mfma_f32_16x16x32_bf16(Bt[n][k], At[m][k], acc[ai][bj][m][n], 0, 0, 0); __builtin_amdgcn_s_setprio(0); } while (0)
#define PG8_WAIT_V(n) asm volatile("s_waitcnt vmcnt(" #n ")" ::: "memory")
#define PG8_WAIT_L(n) asm volatile("s_waitcnt lgkmcnt(" #n ")" ::: "memory")
#define PG8_BAR __builtin_amdgcn_s_barrier()
#define PG8_SCHED __builtin_amdgcn_sched_barrier(0)
    Unit cur, nxt; int ui = 0;
    if (!S.next(0, cur)) return;
    f32x4 acc[2][2][4][2];
#pragma unroll
    for (int a = 0; a < 2; ++a)
#pragma unroll
        for (int b = 0; b < 2; ++b)
#pragma unroll
            for (int m = 0; m < 4; ++m)
#pragma unroll
                for (int n = 0; n < 2; ++n) acc[a][b][m][n] = (f32x4){0.f, 0.f, 0.f, 0.f};
    bf16x8 At[4][2], B0[2][2], B1[2][2];
    const char* cA = (const char*)g.A + (size_t)S.aoff(cur) * 2; const char* cB = (const char*)g.Bt + (size_t)S.boff(cur) * 2;
    PG8_STAGE(PG8_SB(0, 0), cB, voffB); PG8_STAGE(PG8_SB(0, 1), cB + hstepB, voffB); PG8_STAGE(PG8_SA(0, 0), cA, voffA); PG8_STAGE(PG8_SA(0, 1), cA + hstepA, voffA);
    if (wr == 1) PG8_BAR;
    PG8_WAIT_V(2); PG8_BAR;
    PG8_STAGE(PG8_SB(1, 0), cB + kstep, voffB); PG8_STAGE(PG8_SA(1, 0), cA + kstep, voffA); PG8_STAGE(PG8_SB(1, 1), cB + hstepB + kstep, voffB);
    PG8_WAIT_V(6); PG8_BAR;
    for (;;) {
        const bool has_next = S.next(ui + 1, nxt);
        const char* nA = has_next ? (const char*)g.A + (size_t)S.aoff(nxt) * 2 : cA; const char* nB = has_next ? (const char*)g.Bt + (size_t)S.boff(nxt) * 2 : cB;
        _Pragma("nounroll")
        for (int t = 0; t < nt; t += 2) {
            const bool last = (t == nt - 2);
            const char* a1 = cA + (size_t)(t + 1) * kstep;
            const char* a2 = last ? nA : cA + (size_t)(t + 2) * kstep; const char* b2 = last ? nB : cB + (size_t)(t + 2) * kstep;
            const char* a3 = a2 + kstep; const char* b3 = b2 + kstep;
            PG8_LDB(B0, 0, 0); PG8_LDB(B1, 0, 1); PG8_SCHED; PG8_LDA(At, 0, 0); PG8_STAGE(PG8_SA(1, 1), a1 + hstepA, voffA);
            PG8_WAIT_V(8); PG8_WAIT_L(0); PG8_BAR; PG8_MMA(0, 0, At, B0); PG8_MMA(0, 1, At, B1); PG8_BAR; PG8_SCHED;
            PG8_LDA(At, 0, 1); PG8_STAGE(PG8_SB(0, 0), b2, voffB); PG8_STAGE(PG8_SB(0, 1), b2 + hstepB, voffB); PG8_STAGE(PG8_SA(0, 0), a2, voffA);
            PG8_WAIT_V(8); PG8_WAIT_L(0); PG8_BAR; PG8_MMA(1, 0, At, B0); PG8_MMA(1, 1, At, B1); PG8_BAR; PG8_SCHED;
            PG8_LDB(B0, 1, 0); PG8_LDB(B1, 1, 1); PG8_SCHED; PG8_LDA(At, 1, 0); PG8_STAGE(PG8_SA(0, 1), a2 + hstepA, voffA);
            PG8_WAIT_V(8); PG8_WAIT_L(0); PG8_BAR; PG8_MMA(0, 0, At, B0); PG8_MMA(0, 1, At, B1); PG8_BAR; PG8_SCHED;
            PG8_LDA(At, 1, 1); PG8_STAGE(PG8_SB(1, 0), b3, voffB); PG8_STAGE(PG8_SB(1, 1), b3 + hstepB, voffB); PG8_STAGE(PG8_SA(1, 0), a3, voffA);
            PG8_WAIT_V(8); PG8_WAIT_L(0); PG8_BAR; PG8_MMA(1, 0, At, B0); PG8_MMA(1, 1, At, B1); PG8_BAR; PG8_SCHED;
        }
        if (wr == 0) PG8_BAR;
        if constexpr (!Epi::AFTER_DRAIN) { E(acc, cur, wr, wc, fr, fq); }
        if (!has_next) break;
#pragma unroll
        for (int a = 0; a < 2; ++a)
#pragma unroll
            for (int b = 0; b < 2; ++b)
#pragma unroll
                for (int m = 0; m < 4; ++m)
#pragma unroll
                    for (int n = 0; n < 2; ++n) acc[a][b][m][n] = (f32x4){0.f, 0.f, 0.f, 0.f};
        cur = nxt; cA = nA; cB = nB; ++ui;
        if (wr == 1) PG8_BAR;
    }
    PG8_WAIT_V(0);
    PG8_BAR;
    if constexpr (Epi::AFTER_DRAIN) { E.fused(acc, cur, wr, wc, fr, fq, lds, wid, lane); }
#undef PG8_SA
#undef PG8_SB
#undef PG8_STAGE
#undef PG8_LDA
#undef PG8_LDB
#undef PG8_MMA
#undef PG8_WAIT_V
#undef PG8_WAIT_L
#undef PG8_BAR
#undef PG8_SCHED
}

#define EPI_ROWS(ai, m) (u.pm * BM + (ai) * HALF + wr * 64 + (m) * 16 + fr)
typedef const f32x4 (&AccRef)[2][2][4][2];

struct EpiSwiglu {
    static constexpr bool PERM = true, AFTER_DRAIN = false;
    bf16_t* O;
    __device__ __forceinline__ void operator()(AccRef acc, const Unit& u, int wr, int wc, int fr, int fq) const {
        const int col0 = u.pn * 128 + wc * 32 + 8 * fq;
#pragma unroll
        for (int ai = 0; ai < 2; ++ai)
#pragma unroll
            for (int m = 0; m < 4; ++m) {
                const f32x4 g0 = acc[ai][0][m][0], g1 = acc[ai][0][m][1], u0 = acc[ai][1][m][0], u1 = acc[ai][1][m][1];
                u32x4 w;
                w.x = cvt_pk_bf16(silu(g0[0]) * u0[0], silu(g0[1]) * u0[1]); w.y = cvt_pk_bf16(silu(g0[2]) * u0[2], silu(g0[3]) * u0[3]);
                w.z = cvt_pk_bf16(silu(g1[0]) * u1[0], silu(g1[1]) * u1[1]); w.w = cvt_pk_bf16(silu(g1[2]) * u1[2], silu(g1[3]) * u1[3]);
                *(u32x4*)(O + (size_t)EPI_ROWS(ai, m) * FF + col0) = w;
            }
    }
};
struct EpiBf16 {
    static constexpr bool PERM = true, AFTER_DRAIN = false;
    bf16_t* O; int ldc; float scale;
    __device__ __forceinline__ void operator()(AccRef acc, const Unit& u, int wr, int wc, int fr, int fq) const {
        const int col0 = u.pn * BM + wc * 32 + 8 * fq;
#pragma unroll
        for (int ai = 0; ai < 2; ++ai)
#pragma unroll
            for (int m = 0; m < 4; ++m) { bf16_t* rowp = O + (size_t)EPI_ROWS(ai, m) * ldc + col0;
#pragma unroll
                for (int bj = 0; bj < 2; ++bj) { const f32x4 v0 = acc[ai][bj][m][0] * scale, v1 = acc[ai][bj][m][1] * scale;
                    u32x4 w; w.x = cvt_pk_bf16(v0[0], v0[1]); w.y = cvt_pk_bf16(v0[2], v0[3]); w.z = cvt_pk_bf16(v1[0], v1[1]); w.w = cvt_pk_bf16(v1[2], v1[3]);
                    *(u32x4*)(rowp + bj * HALF) = w; } }
    }
};
struct EpiProj {
    static constexpr bool PERM = true, AFTER_DRAIN = false;
    bf16_t *PR, *PL, *GG, *SG0;
    __device__ __forceinline__ void operator()(AccRef acc, const Unit& u, int wr, int wc, int fr, int fq) const {
        const int pn = u.pn, cw = wc * 32 + 8 * fq;
        if (pn >= 17 && pn < 25) {
            const int col0 = (pn - 17) * 128 + cw;
#pragma unroll
            for (int ai = 0; ai < 2; ++ai)
#pragma unroll
                for (int m = 0; m < 4; ++m) {
                    const f32x4 g0 = acc[ai][0][m][0], g1 = acc[ai][0][m][1], s0 = acc[ai][1][m][0], s1 = acc[ai][1][m][1];
                    u32x4 w;
                    w.x = cvt_pk_bf16(gelu_t(g0[0]) * sigm(s0[0]), gelu_t(g0[1]) * sigm(s0[1])); w.y = cvt_pk_bf16(gelu_t(g0[2]) * sigm(s0[2]), gelu_t(g0[3]) * sigm(s0[3]));
                    w.z = cvt_pk_bf16(gelu_t(g1[0]) * sigm(s1[0]), gelu_t(g1[1]) * sigm(s1[1])); w.w = cvt_pk_bf16(gelu_t(g1[2]) * sigm(s1[2]), gelu_t(g1[3]) * sigm(s1[3]));
                    *(u32x4*)(GG + (size_t)EPI_ROWS(ai, m) * D + col0) = w;
                }
        } else {
            bf16_t* base; int ldc, colt; bool sg = false;
            if (pn < 13) { base = PR; ldc = RP; colt = pn * 256; } else { ldc = D; sg = pn >= 17; colt = ((pn - 13) & 3) * 256; base = sg ? SG0 : PL; }
#pragma unroll
            for (int ai = 0; ai < 2; ++ai)
#pragma unroll
                for (int m = 0; m < 4; ++m) { bf16_t* rowp = base + (size_t)EPI_ROWS(ai, m) * ldc + colt + cw;
#pragma unroll
                    for (int bj = 0; bj < 2; ++bj) { f32x4 v0 = acc[ai][bj][m][0], v1 = acc[ai][bj][m][1];
                        if (sg) { v0 = (f32x4){sigm(v0[0]), sigm(v0[1]), sigm(v0[2]), sigm(v0[3])}; v1 = (f32x4){sigm(v1[0]), sigm(v1[1]), sigm(v1[2]), sigm(v1[3])}; }
                        u32x4 w; w.x = cvt_pk_bf16(v0[0], v0[1]); w.y = cvt_pk_bf16(v0[2], v0[3]); w.z = cvt_pk_bf16(v1[0], v1[1]); w.w = cvt_pk_bf16(v1[2], v1[3]);
                        *(u32x4*)(rowp + bj * HALF) = w; } }
        }
    }
};
struct EpiResid {
    static constexpr bool PERM = false, AFTER_DRAIN = false;
    const float* base; float* out; float s;
    __device__ __forceinline__ void operator()(AccRef acc, const Unit& u, int wr, int wc, int fr, int fq) const {
        const int col0 = u.pn * BM + wc * 32 + 4 * fq;
#pragma unroll
        for (int ai = 0; ai < 2; ++ai)
#pragma unroll
            for (int m = 0; m < 4; ++m) { const size_t off = (size_t)EPI_ROWS(ai, m) * D + col0;
#pragma unroll
                for (int bj = 0; bj < 2; ++bj)
#pragma unroll
                    for (int n = 0; n < 2; ++n) { const f32x4 b = *(const f32x4*)(base + off + bj * HALF + n * 16);
                        *(f32x4*)(out + off + bj * HALF + n * 16) = b * DN_ALPHA + acc[ai][bj][m][n] * s; } }
    }
};
struct EpiKV {
    static constexpr bool PERM = false, AFTER_DRAIN = false;
    float *ok, *ov; bf16_t* KB;
    __device__ __forceinline__ void operator()(AccRef acc, const Unit& u, int wr, int wc, int fr, int fq) const {
        const bool isk = u.pn < 4; float* o = isk ? ok : ov; const int col0 = (u.pn & 3) * BM + wc * 32 + 4 * fq;
#pragma unroll
        for (int ai = 0; ai < 2; ++ai)
#pragma unroll
            for (int m = 0; m < 4; ++m) { const size_t off = (size_t)EPI_ROWS(ai, m) * D + col0;
#pragma unroll
                for (int bj = 0; bj < 2; ++bj)
#pragma unroll
                    for (int n = 0; n < 2; ++n) { const f32x4 v = acc[ai][bj][m][n]; *(f32x4*)(o + off + bj * HALF + n * 16) = v;
                        if (isk) *(u32x2*)(KB + off + bj * HALF + n * 16) = pack4(v); } }
    }
};
struct EpiLora {
    static constexpr bool PERM = true, AFTER_DRAIN = false;
    bf16_t *WD, *AA, *G; const float *w0, *a0;
    __device__ __forceinline__ void operator()(AccRef acc, const Unit& u, int wr, int wc, int fr, int fq) const {
        const int kind = u.pn >> 2, colt = (u.pn & 3) * 256 + wc * 32 + 8 * fq;
        bf16_t* base = WD + (size_t)kind * ((WS_AA - WS_WD) / 2);
        const float* bias = kind == 0 ? w0 : a0;
#pragma unroll
        for (int bj = 0; bj < 2; ++bj) {
            f32x4 b0 = (f32x4){0.f, 0.f, 0.f, 0.f}, b1 = b0;
            if (kind < 2) { b0 = *(const f32x4*)(bias + colt + bj * HALF); b1 = *(const f32x4*)(bias + colt + bj * HALF + 4); }
#pragma unroll
            for (int ai = 0; ai < 2; ++ai)
#pragma unroll
                for (int m = 0; m < 4; ++m) { f32x4 v0 = acc[ai][bj][m][0] + b0, v1 = acc[ai][bj][m][1] + b1;
                    if (kind == 0) { v0 = (f32x4){decay_e(v0[0]), decay_e(v0[1]), decay_e(v0[2]), decay_e(v0[3])}; v1 = (f32x4){decay_e(v1[0]), decay_e(v1[1]), decay_e(v1[2]), decay_e(v1[3])}; }
                    else if (kind == 1) { v0 = (f32x4){sigm(v0[0]), sigm(v0[1]), sigm(v0[2]), sigm(v0[3])}; v1 = (f32x4){sigm(v1[0]), sigm(v1[1]), sigm(v1[2]), sigm(v1[3])}; }
                    u32x4 w; w.x = cvt_pk_bf16(v0[0], v0[1]); w.y = cvt_pk_bf16(v0[2], v0[3]); w.z = cvt_pk_bf16(v1[0], v1[1]); w.w = cvt_pk_bf16(v1[2], v1[3]);
                    *(u32x4*)(base + (size_t)EPI_ROWS(ai, m) * D + colt + bj * HALF) = w; }
        }
    }
};
struct EpiLru {
    static constexpr bool PERM = true, AFTER_DRAIN = false;
    bf16_t *GR, *GI; const float *br, *bi;
    __device__ __forceinline__ void operator()(AccRef acc, const Unit& u, int wr, int wc, int fr, int fq) const {
        const int col0 = u.pn * 128 + wc * 32 + 8 * fq;
#pragma unroll
        for (int bj = 0; bj < 2; ++bj) {
            const float* bias = bj ? bi : br; bf16_t* base = bj ? GI : GR;
            const f32x4 b0 = *(const f32x4*)(bias + col0), b1 = *(const f32x4*)(bias + col0 + 4);
#pragma unroll
            for (int ai = 0; ai < 2; ++ai)
#pragma unroll
                for (int m = 0; m < 4; ++m) { const f32x4 v0 = acc[ai][bj][m][0] + b0, v1 = acc[ai][bj][m][1] + b1;
                    u32x4 w; w.x = cvt_pk_bf16(sigm(v0[0]), sigm(v0[1])); w.y = cvt_pk_bf16(sigm(v0[2]), sigm(v0[3])); w.z = cvt_pk_bf16(sigm(v1[0]), sigm(v1[1])); w.w = cvt_pk_bf16(sigm(v1[2]), sigm(v1[3]));
                    *(u32x4*)(base + (size_t)EPI_ROWS(ai, m) * D + col0) = w; }
        }
    }
};
struct EpiSoftmax {
    static constexpr bool PERM = true, AFTER_DRAIN = true;
    bf16_t* P;
    __device__ __forceinline__ void fused(f32x4 (&acc)[2][2][4][2], const Unit& u, int wr, int wc, int fr, int fq, LAS unsigned char* lds, int wid, int lane) const {
        LAS float* MX = (LAS float*)lds;
        LAS float* SM = (LAS float*)(lds + 4096);
#pragma unroll
        for (int ai = 0; ai < 2; ++ai)
#pragma unroll
            for (int m = 0; m < 4; ++m) {
                float mx = -3.0e38f;
#pragma unroll
                for (int bj = 0; bj < 2; ++bj)
#pragma unroll
                    for (int n = 0; n < 2; ++n) { const f32x4 x = acc[ai][bj][m][n]; mx = fmaxf(mx, fmaxf(fmaxf(x[0], x[1]), fmaxf(x[2], x[3]))); }
                mx = fmaxf(mx, __shfl_xor(mx, 16)); mx = fmaxf(mx, __shfl_xor(mx, 32));
                if (fq == 0) MX[(ai * HALF + wr * 64 + m * 16 + fr) * 4 + wc] = mx;
            }
        __syncthreads();
#pragma unroll
        for (int ai = 0; ai < 2; ++ai)
#pragma unroll
            for (int m = 0; m < 4; ++m) {
                const int rl = ai * HALF + wr * 64 + m * 16 + fr;
                const f32x4 mm = *(const LAS f32x4*)(MX + rl * 4);
                const float mx = fmaxf(fmaxf(mm[0], mm[1]), fmaxf(mm[2], mm[3]));
                float s = 0.f;
#pragma unroll
                for (int bj = 0; bj < 2; ++bj)
#pragma unroll
                    for (int n = 0; n < 2; ++n) { f32x4 x = acc[ai][bj][m][n];
                        x = (f32x4){__builtin_amdgcn_exp2f(x[0] - mx), __builtin_amdgcn_exp2f(x[1] - mx), __builtin_amdgcn_exp2f(x[2] - mx), __builtin_amdgcn_exp2f(x[3] - mx)};
                        acc[ai][bj][m][n] = x; s += (x[0] + x[1]) + (x[2] + x[3]); }
                s += __shfl_xor(s, 16); s += __shfl_xor(s, 32);
                if (fq == 0) SM[rl * 4 + wc] = s;
            }
        __syncthreads();
        const int col0 = u.pn * BM + wc * 32 + 8 * fq;
#pragma unroll
        for (int ai = 0; ai < 2; ++ai)
#pragma unroll
            for (int m = 0; m < 4; ++m) {
                const int rl = ai * HALF + wr * 64 + m * 16 + fr;
                const f32x4 ss = *(const LAS f32x4*)(SM + rl * 4);
                const float inv = 1.0f / ((ss[0] + ss[1]) + (ss[2] + ss[3]));
                bf16_t* rowp = P + (size_t)(u.pm * BM + rl) * D + col0;
#pragma unroll
                for (int bj = 0; bj < 2; ++bj) { const f32x4 v0 = acc[ai][bj][m][0] * inv, v1 = acc[ai][bj][m][1] * inv;
                    u32x4 w; w.x = cvt_pk_bf16(v0[0], v0[1]); w.y = cvt_pk_bf16(v0[2], v0[3]); w.z = cvt_pk_bf16(v1[0], v1[1]); w.w = cvt_pk_bf16(v1[2], v1[3]);
                    *(u32x4*)(rowp + bj * HALF) = w; }
            }
        __syncthreads();
    }
};
}

template <bool PAIR, class F>
__device__ __forceinline__ void skinny(const bf16_t* A, int lda, const bf16_t* Bt, int ldb, int K, int tile_lo, int tile_hi, int kmode, int bx, int G, int tid_, F f) {
    const int tid = opaque(tid_), lane = tid & 63, w = __builtin_amdgcn_readfirstlane(tid >> 6), fr = lane & 15, fq = lane >> 4;
    constexpr int GPT = PAIR ? 2 : 4;
    const int nunits = (tile_hi - tile_lo) * GPT * 4;
    for (int un = bx; un < nunits; un += G) {
        const int rbp = un & 3, cgrp = un >> 2, tile = tile_lo + cgrp / GPT, cgp = (cgrp % GPT) * 4 + (w & 3), rb = rbp * 2 + (w >> 2);
        const int n0 = tile * 256 + cgp * 16, row = MP + rb * 16 + fr;
        const bf16_t* ap = A + (size_t)row * lda + (kmode ? 256 * (tile >> 1) : 0) + fq * 8;
        const bf16_t* bp = Bt + (size_t)(n0 + fr) * ldb + fq * 8;
        f32x4 acc0 = (f32x4){0.f, 0.f, 0.f, 0.f}, acc1 = acc0;
        for (int k0 = 0; k0 < K; k0 += 256) {
#pragma unroll
            for (int kk = 0; kk < 256; kk += 32) {
                const bf16x8 a = *(const bf16x8*)(ap + k0 + kk), b = *(const bf16x8*)(bp + k0 + kk);
                acc0 = __builtin_amdgcn_mfma_f32_16x16x32_bf16(b, a, acc0, 0, 0, 0);
                if (PAIR) { const bf16x8 b2 = *(const bf16x8*)(bp + (size_t)128 * ldb + k0 + kk); acc1 = __builtin_amdgcn_mfma_f32_16x16x32_bf16(b2, a, acc1, 0, 0, 0); }
            }
        }
        f(row, tile, cgp * 16 + 4 * fq, acc0, acc1);
    }
}

__device__ __forceinline__ int map_row(int mapmode, int n) {
    if (mapmode == 1) { if (n < FF) return 256 * (n / 128) + (n % 128); const int q = n - FF; return 256 * (q / 128) + 128 + (q % 128); }
    if (mapmode == 2) { if (n < 4352) return n; if (n < 5376) { const int q = n - 4352; return 256 * (17 + q / 128) + (q % 128); }
                        if (n < 6400) return 256 * 25 + (n - 5376); const int q = n - 6400; return 256 * (17 + q / 128) + 128 + (q % 128); }
    return n;
}
__device__ __forceinline__ void transpose_item(const float* W, int K, int N, bf16_t* WT, int mapmode, LAS float* scr, int item, int lane) {
    const int nblk = N / 32, kb = item / nblk, nb = item % nblk, k0 = 64 * kb, n0 = 32 * nb;
#pragma unroll 8
    for (int i = 0; i < 32; ++i) { const int kk = 2 * i + (lane >> 5); scr[kk * 33 + (lane & 31)] = W[(size_t)(k0 + kk) * N + n0 + (lane & 31)]; }
    asm volatile("s_waitcnt lgkmcnt(0)" ::: "memory");
    const int c = lane & 7, d0 = map_row(mapmode, n0);
#pragma unroll
    for (int j = 0; j < 4; ++j) { const int n = (lane >> 3) + 8 * j; const LAS float* s = scr + (8 * c) * 33 + n;
        u32x4 o; o.x = cvt_pk_bf16(s[0 * 33], s[1 * 33]); o.y = cvt_pk_bf16(s[2 * 33], s[3 * 33]); o.z = cvt_pk_bf16(s[4 * 33], s[5 * 33]); o.w = cvt_pk_bf16(s[6 * 33], s[7 * 33]);
        *(u32x4*)(WT + (size_t)(d0 + n) * K + k0 + 8 * c) = o; }
    asm volatile("s_waitcnt lgkmcnt(0)" ::: "memory");
}

struct Args { const float* in[39]; float* out; unsigned char* ws; int ph_lo, ph_hi; };

__device__ __forceinline__ void ln_pass(const float* PRE, const float* g, const float* b, float* H, bf16_t* HB, int gw, int ngw, int lane) {
    f32x4 gv[4], bv[4];
#pragma unroll
    for (int j = 0; j < 4; ++j) { gv[j] = *(const f32x4*)(g + 256 * j + 4 * lane); bv[j] = *(const f32x4*)(b + 256 * j + 4 * lane); }
    for (int row = gw; row < MT; row += ngw) {
        const float* p = PRE + (size_t)row * D + 4 * lane;
        f32x4 v[4]; float s = 0.f;
#pragma unroll
        for (int j = 0; j < 4; ++j) { v[j] = *(const f32x4*)(p + 256 * j); s += (v[j].x + v[j].y) + (v[j].z + v[j].w); }
        const float mean = wave_sum(s) * (1.f / D); float s2 = 0.f;
#pragma unroll
        for (int j = 0; j < 4; ++j) { v[j] = v[j] - mean; s2 += (v[j].x * v[j].x + v[j].y * v[j].y) + (v[j].z * v[j].z + v[j].w * v[j].w); }
        const float rstd = 1.0f / sqrtf(wave_sum(s2) * (1.f / D) + LN_EPS);
#pragma unroll
        for (int j = 0; j < 4; ++j) { const f32x4 o = v[j] * rstd * gv[j] + bv[j];
            *(f32x4*)(H + (size_t)row * D + 256 * j + 4 * lane) = o;
            if (HB) *(u32x2*)(HB + (size_t)row * D + 256 * j + 4 * lane) = pack4(o); }
    }
}

#define XB_TMO      128
#define XB_XCNT(j)  (256  + 64 * (j))
#define XB_XSUB(j)  (1280 + 64 * (j))
#define XB_XGEN(j)  (2304 + 64 * (j))
#define XB_TOP      3328
#define XB_TOPGEN   3392
#define XCD_BAR_WORDS 3456
#define XB_SPIN_CAP (1u << 22)
__device__ __forceinline__ unsigned xb_ld(unsigned* p)              { return __hip_atomic_load(p, __ATOMIC_RELAXED, __HIP_MEMORY_SCOPE_AGENT); }
__device__ __forceinline__ unsigned xb_add(unsigned* p, unsigned v) { return __hip_atomic_fetch_add(p, v, __ATOMIC_RELAXED, __HIP_MEMORY_SCOPE_AGENT); }
__device__ __forceinline__ unsigned xb_xcc_id() { return (unsigned)__builtin_amdgcn_s_getreg((3 << 11) | 20) & 0xFu; }
#define XB_SPIN(cond, bar) do { unsigned _sp = 0; while (cond) { __builtin_amdgcn_s_sleep(1); \
    if ((++_sp & 255u) == 0u) { if (xb_ld(&(bar)[XB_TMO])) break; if (_sp > XB_SPIN_CAP) { atomicAdd(&(bar)[XB_TMO], 1u); break; } } } } while (0)
__device__ __forceinline__ void xcd_barrier_complete(unsigned* bar, unsigned x, unsigned& nloc, unsigned& nx) {
    const unsigned G = gridDim.x;
    unsigned sum, cnt, mine, sp = 0u;
    for (;;) {
        sum = 0u; cnt = 0u; mine = 0u;
#pragma unroll
        for (unsigned j = 0; j < 16; ++j) { const unsigned c = xb_ld(&bar[XB_XCNT(j)]); sum += c; cnt += (c > 0u) ? 1u : 0u; mine = (j == x) ? c : mine; }
        if (sum == G) break;
        __builtin_amdgcn_s_sleep(1);
        if ((++sp & 255u) == 0u) { if (xb_ld(&bar[XB_TMO])) break; if (sp > XB_SPIN_CAP) { atomicAdd(&bar[XB_TMO], 1u); break; } }
    }
    nloc = mine > 0u ? mine : 1u; nx = cnt > 0u ? cnt : 1u;
}
__device__ __forceinline__ void xcd_barrier(unsigned* bar, volatile LAS unsigned* st) {
    asm volatile("s_waitcnt vmcnt(0) lgkmcnt(0)" ::: "memory");
    __syncthreads();
    if (threadIdx.x == 0) {
        __builtin_amdgcn_s_waitcnt(0);
        const unsigned x = xb_xcc_id();
        unsigned nloc = st[0], nx = st[1];
        if (nloc == 0u) { xcd_barrier_complete(bar, x, nloc, nx); st[0] = nloc; st[1] = nx; }
        const unsigned old = xb_add(&bar[XB_XSUB(x)], 1u);
        const unsigned gen = old / nloc;
        if (old + 1u == (gen + 1u) * nloc) {
            __builtin_amdgcn_fence(__ATOMIC_RELEASE, "agent");
            asm volatile("s_waitcnt vmcnt(0)" ::: "memory");
            const unsigned og = xb_add(&bar[XB_TOP], 1u);
            const unsigned tg = og / nx;
            if (og + 1u == (tg + 1u) * nx) xb_add(&bar[XB_TOPGEN], 1u);
            else XB_SPIN(xb_ld(&bar[XB_TOPGEN]) == tg, bar);
            __builtin_amdgcn_fence(__ATOMIC_ACQUIRE, "agent");
            xb_add(&bar[XB_XGEN(x)], 1u);
            asm volatile("s_waitcnt vmcnt(0)" ::: "memory");
        } else {
            XB_SPIN(xb_ld(&bar[XB_XGEN(x)]) == gen, bar);
            __builtin_amdgcn_fence(__ATOMIC_ACQUIRE, "agent");
            asm volatile("s_waitcnt vmcnt(0)" ::: "memory");
        }
    }
    __syncthreads();
}

#define PH_IDS const int tid = opaque(threadIdx.x), lane = tid & 63, wave = __builtin_amdgcn_readfirstlane(tid >> 6), gw = bx * NWAVES + wave, gt = bx * NTHR + tid; (void)lane; (void)gw; (void)gt; PH_PTRS
#define PH_PTRS \
    unsigned char* ws = args.ws; float* out = args.out; \
    bf16_t *WI = (bf16_t*)(ws + WS_WI), *WO = (bf16_t*)(ws + WS_WO), *WIN = (bf16_t*)(ws + WS_WIN), *WMIX = (bf16_t*)(ws + WS_WMIX), *WQ = (bf16_t*)(ws + WS_WQ), *WOX = (bf16_t*)(ws + WS_WOX), \
           *WKV = (bf16_t*)(ws + WS_WKV), *LORAT = (bf16_t*)(ws + WS_LORAT), *LRUT = (bf16_t*)(ws + WS_LRUT), *MEMB = (bf16_t*)(ws + WS_MEMB), *KB = (bf16_t*)(ws + WS_KB), *VT = (bf16_t*)(ws + WS_VT), \
           *HB = (bf16_t*)(ws + WS_HB), *PR = (bf16_t*)(ws + WS_PR), *PL = (bf16_t*)(ws + WS_PL), *GG = (bf16_t*)(ws + WS_GG), *SG0 = (bf16_t*)(ws + WS_SG0), *GI = (bf16_t*)(ws + WS_GI), \
           *WD = (bf16_t*)(ws + WS_WD), *AA = (bf16_t*)(ws + WS_AA), *GB = (bf16_t*)(ws + WS_G), *LB = (bf16_t*)(ws + WS_L); \
    bf16_t *ACT = PR, *XC = HB, *MB = HB, *GR = PL, *LO = GI, *QB = PL, *PB = GG, *OB = SG0; \
    float *PRE = (float*)(ws + WS_PRE), *Y = PRE, *H = out; \
    (void)WI; (void)WO; (void)WIN; (void)WMIX; (void)WQ; (void)WOX; (void)WKV; (void)LORAT; (void)LRUT; (void)MEMB; (void)KB; (void)VT; (void)HB; (void)PR; (void)PL; (void)GG; (void)SG0; (void)GI; \
    (void)WD; (void)AA; (void)GB; (void)LB; (void)ACT; (void)XC; (void)MB; (void)GR; (void)LO; (void)QB; (void)PB; (void)OB; (void)PRE; (void)Y; (void)H;
#define INP(k) (args.in[k])
#ifndef PHSEL
#define PHSEL(k) true
#endif
template <int ph>
__device__ __forceinline__ void run_phase(const Args& args, LAS unsigned char* lds, const int G, const int bx, const bool fin = true) {
    const int ngw = G * NWAVES, ngt = G * NTHR; (void)ngw; (void)ngt;
    switch (ph) {
    case 0: if (PHSEL(0)) { PH_IDS
        const float *x_prompt = INP(0), *x_sample = INP(1), *mem_prompt = INP(2), *decay_w2 = INP(18), *aaa_a2 = INP(20), *gate_g2 = INP(21), *lru_wr = INP(29), *lru_wi = INP(31);
        LAS float* scr = (LAS float*)(lds + wave * 16384);
        constexpr int I_WI = 16 * (2 * FF / 32), I_WO = (FF / 64) * 32, I_WIN = 16 * (PW / 32), I_SQ = 16 * 32;
        constexpr int NIT = I_WI + I_WO + I_WIN + 5 * I_SQ;
        for (int it = gw; it < NIT; it += ngw) {
            int r = it;
            if (r < I_WI) { transpose_item(INP(11), D, 2 * FF, WI, 1, scr, r, lane); continue; } r -= I_WI;
            if (r < I_WO) { transpose_item(INP(12), FF, D, WO, 0, scr, r, lane); continue; } r -= I_WO;
            if (r < I_WIN) { transpose_item(INP(15), D, PW, WIN, 2, scr, r, lane); continue; } r -= I_WIN;
            if (r < I_SQ) { transpose_item(INP(34), D, D, WMIX, 0, scr, r, lane); continue; } r -= I_SQ;
            if (r < I_SQ) { transpose_item(INP(35), D, D, WQ, 0, scr, r, lane); continue; } r -= I_SQ;
            if (r < I_SQ) { transpose_item(INP(36), D, D, WKV, 0, scr, r, lane); continue; } r -= I_SQ;
            if (r < I_SQ) { transpose_item(INP(37), D, D, WKV + (size_t)D * D, 0, scr, r, lane); continue; } r -= I_SQ;
            transpose_item(INP(38), D, D, WOX, 0, scr, r, lane);
        }
        for (int i = gt; i < 3072 * 256; i += ngt) { const int n = i >> 8, k = i & 255; float v = 0.f;
            if (n < 1024) { if (k < 64) v = decay_w2[k * 1024 + n]; } else if (n < 2048) { if (k >= 64 && k < 128) v = aaa_a2[(k - 64) * 1024 + (n - 1024)]; } else { if (k >= 128) v = gate_g2[(k - 128) * 1024 + (n - 2048)]; }
            LORAT[i] = f2bf(v); }
        for (int i = gt; i < 2048 * 256; i += ngt) { const int n = i >> 8, k = i & 255; const int q = n >> 8, bj = (n >> 7) & 1, j = n & 127;
            const int c = 128 * q + j, nb = c >> 6, d = c & 63; const int cin = 256 * (q >> 1) + k; float v = 0.f;
            if ((cin >> 6) == nb) v = (bj ? lru_wi : lru_wr)[(nb * 64 + (cin & 63)) * 64 + d];
            LRUT[i] = f2bf(v); }
        for (int i = gt; i < MT * D / 4; i += ngt) { const f32x4 v = (i < MP * D / 4) ? ((const f32x4*)x_prompt)[i] : ((const f32x4*)x_sample)[i - MP * D / 4];
            ((f32x4*)H)[i] = v; ((u32x2*)HB)[i] = pack4(v); }
        for (int i = gt; i < NB * 256 * D / 4; i += ngt) ((u32x2*)MEMB)[i] = pack4(((const f32x4*)mem_prompt)[i]);
    } break;

    case 1: case 16: if (PHSEL(1)) { PH_IDS
        { pg8::Gemm g{HB, WI, D, D, D}; pg8::Sched S; S.init(MP / 256, 2 * FF / 256, G, bx, 0, D, D); pg8::EpiSwiglu E{ACT}; pg8::gemm_phase(lds, g, S, E); }
        skinny<true>(HB, D, WI, D, D, 0, 2 * FF / 256, 0, bx, G, tid, [&](int row, int tile, int cin, f32x4 a, f32x4 b) {
            f32x4 o = (f32x4){silu(a[0]) * b[0], silu(a[1]) * b[1], silu(a[2]) * b[2], silu(a[3]) * b[3]};
            *(u32x2*)(ACT + (size_t)row * FF + tile * 128 + cin) = pack4(o); });
        if (ph == 1) {
        { pg8::Gemm g{MEMB, WKV, D, D, D}; pg8::Sched S; S.init(8, 8, G, bx, 0, D, D); pg8::EpiKV E{out + O_PMK, out + O_PMV, KB}; pg8::gemm_phase(lds, g, S, E); }
        { pg8::Gemm g{WKV + (size_t)D * D, MEMB, D, D, D}; pg8::Sched S; S.init(4, 8, G, bx, 0, D, D); pg8::EpiBf16 E{VT, NB * 256, 1.0f}; pg8::gemm_phase(lds, g, S, E); }
        }
    } break;
    case 2: case 17: if (PHSEL(2)) { PH_IDS
        { pg8::Gemm g{ACT, WO, FF, FF, FF}; pg8::Sched S; S.init(MP / 256, D / 256, G, bx, 0, FF, FF); pg8::EpiResid E{H, PRE, 0.5f}; pg8::gemm_phase(lds, g, S, E); }
        skinny<false>(ACT, FF, WO, FF, FF, 0, D / 256, 0, bx, G, tid, [&](int row, int tile, int cin, f32x4 a, f32x4) {
            const size_t off = (size_t)row * D + tile * 256 + cin; *(f32x4*)(PRE + off) = *(const f32x4*)(H + off) * DN_ALPHA + a * 0.5f; });
    } break;
    case 3: case 10: case 15: case 18: if (PHSEL(3)) { PH_IDS
        const float *ln_g = INP(9), *ln_b = INP(10);
        const int li = ph == 3 ? 0 : (ph == 10 ? 1 : (ph == 15 ? 2 : 3));
        ln_pass(PRE, ln_g + li * D, ln_b + li * D, H, ph == 18 ? (bf16_t*)nullptr : HB, gw, ngw, lane);
    } break;
    case 4: if (PHSEL(4)) { PH_IDS
        { pg8::Gemm g{HB, WIN, D, D, D}; pg8::Sched S; S.init(MP / 256, PW / 256, G, bx, 0, D, D); pg8::EpiProj E{PR, PL, GG, SG0}; pg8::gemm_phase(lds, g, S, E); }
        skinny<false>(HB, D, WIN, D, D, 0, 17, 0, bx, G, tid, [&](int row, int tile, int cin, f32x4 a, f32x4) {
            if (tile < 13) *(u32x2*)(PR + (size_t)row * RP + tile * 256 + cin) = pack4(a); else *(u32x2*)(PL + (size_t)row * D + (tile - 13) * 256 + cin) = pack4(a); });
        skinny<false>(HB, D, WIN, D, D, 25, 29, 0, bx, G, tid, [&](int row, int tile, int cin, f32x4 a, f32x4) {
            *(u32x2*)(SG0 + (size_t)row * D + (tile - 25) * 256 + cin) = pack4((f32x4){sigm(a[0]), sigm(a[1]), sigm(a[2]), sigm(a[3])}); });
        skinny<true>(HB, D, WIN, D, D, 17, 25, 0, bx, G, tid, [&](int row, int tile, int cin, f32x4 a, f32x4 b) {
            *(u32x2*)(GG + (size_t)row * D + (tile - 17) * 128 + cin) = pack4((f32x4){gelu_t(a[0]) * sigm(b[0]), gelu_t(a[1]) * sigm(b[1]), gelu_t(a[2]) * sigm(b[2]), gelu_t(a[3]) * sigm(b[3])}); });
    } break;
    case 5: if (PHSEL(5)) { PH_IDS
        const float *state_shift = INP(6), *state_conv = INP(8), *shift_mu = INP(16), *conv_w = INP(27), *conv_b = INP(28);
        for (int row = gw; row < MT; row += ngw) {
            const bool smp = row >= MP; const int t = row & (T - 1), b = row >> 11, si = row - MP;
            { const int c = 3072 + 4 * lane; const f32x4 p = unpack4(*(const u32x2*)(PR + (size_t)row * RP + c));
              f32x4 pv = (f32x4){0.f, 0.f, 0.f, 0.f};
              if (smp) pv = *(const f32x4*)(state_shift + (size_t)si * RP + c); else if (t > 0) pv = unpack4(*(const u32x2*)(PR + (size_t)(row - 1) * RP + c));
              const f32x4 mu = *(const f32x4*)(shift_mu + c); f32x4 xs = p + (pv - p) * mu;
              if (lane < 16) xs = (f32x4){tanh_(xs[0]), tanh_(xs[1]), tanh_(xs[2]), tanh_(xs[3])}; else if (lane >= 32) xs = (f32x4){sigm(xs[0]), sigm(xs[1]), sigm(xs[2]), sigm(xs[3])};
              *(u32x2*)(LB + (size_t)row * 256 + 4 * lane) = pack4(xs); }
#pragma unroll
            for (int j = 0; j < 4; ++j) { const int c = 256 * j + 4 * lane;
                const f32x4 p3 = unpack4(*(const u32x2*)(PL + (size_t)row * D + c));
                f32x4 p0 = (f32x4){0.f, 0.f, 0.f, 0.f}, p1 = p0, p2 = p0;
                if (smp) { p0 = *(const f32x4*)(state_conv + ((size_t)si * 3 + 0) * D + c); p1 = *(const f32x4*)(state_conv + ((size_t)si * 3 + 1) * D + c); p2 = *(const f32x4*)(state_conv + ((size_t)si * 3 + 2) * D + c); }
                else { if (t >= 3) p0 = unpack4(*(const u32x2*)(PL + (size_t)(row - 3) * D + c)); if (t >= 2) p1 = unpack4(*(const u32x2*)(PL + (size_t)(row - 2) * D + c)); if (t >= 1) p2 = unpack4(*(const u32x2*)(PL + (size_t)(row - 1) * D + c)); }
                const f32x4 xc = *(const f32x4*)(conv_b + c) + *(const f32x4*)(conv_w + c) * p0 + *(const f32x4*)(conv_w + D + c) * p1 + *(const f32x4*)(conv_w + 2 * D + c) * p2 + *(const f32x4*)(conv_w + 3 * D + c) * p3;
                *(u32x2*)(XC + (size_t)row * D + c) = pack4(xc);
                if (smp) { *(f32x4*)(out + O_SCONV + ((size_t)si * 3 + 0) * D + c) = p1; *(f32x4*)(out + O_SCONV + ((size_t)si * 3 + 1) * D + c) = p2; *(f32x4*)(out + O_SCONV + ((size_t)si * 3 + 2) * D + c) = p3; }
                else if (t >= T - 3) *(f32x4*)(out + O_PCONV + ((size_t)b * 3 + (t - (T - 3))) * D + c) = p3; }
            if (smp || t == T - 1) { float* dst = smp ? out + O_SSHIFT + (size_t)si * RP : out + O_PSHIFT + (size_t)b * RP;
                for (int c = 4 * lane; c < RP; c += 256) *(f32x4*)(dst + c) = unpack4(*(const u32x2*)(PR + (size_t)row * RP + c)); }
        }
    } break;
    case 6: if (PHSEL(6)) { PH_IDS
        const float *decay_w0 = INP(17), *aaa_a0 = INP(19), *lru_br = INP(30), *lru_bi = INP(32);
        { pg8::Gemm g{LB, LORAT, 256, 256, 256}; pg8::Sched S; S.init(MP / 256, 12, G, bx, 0, 256, 256); pg8::EpiLora E{WD, AA, GB, decay_w0, aaa_a0}; pg8::gemm_phase(lds, g, S, E); }
        { pg8::Gemm g{XC, LRUT, D, 256, 256}; pg8::Sched S; S.init(MP / 256, 8, G, bx, 1, D, 256); pg8::EpiLru E{GR, GI, lru_br, lru_bi}; pg8::gemm_phase(lds, g, S, E); }
        skinny<false>(LB, 256, LORAT, 256, 256, 0, 12, 0, bx, G, tid, [&](int row, int tile, int cin, f32x4 a, f32x4) {
            const int kind = tile >> 2, c = (tile & 3) * 256 + cin; f32x4 o = a;
            if (kind == 0) { const f32x4 bb = *(const f32x4*)(decay_w0 + c); o = (f32x4){decay_e(a[0] + bb[0]), decay_e(a[1] + bb[1]), decay_e(a[2] + bb[2]), decay_e(a[3] + bb[3])}; }
            else if (kind == 1) { const f32x4 bb = *(const f32x4*)(aaa_a0 + c); o = (f32x4){sigm(a[0] + bb[0]), sigm(a[1] + bb[1]), sigm(a[2] + bb[2]), sigm(a[3] + bb[3])}; }
            bf16_t* base = WD + (size_t)kind * ((WS_AA - WS_WD) / 2); *(u32x2*)(base + (size_t)row * D + c) = pack4(o); });
        skinny<true>(XC, D, LRUT, 256, 256, 0, 8, 1, bx, G, tid, [&](int row, int tile, int cin, f32x4 a, f32x4 b) {
            const int c = tile * 128 + cin; const f32x4 b0 = *(const f32x4*)(lru_br + c), b1 = *(const f32x4*)(lru_bi + c);
            *(u32x2*)(GR + (size_t)row * D + c) = pack4((f32x4){sigm(a[0] + b0[0]), sigm(a[1] + b0[1]), sigm(a[2] + b0[2]), sigm(a[3] + b0[3])});
            *(u32x2*)(GI + (size_t)row * D + c) = pack4((f32x4){sigm(b[0] + b1[0]), sigm(b[1] + b1[1]), sigm(b[2] + b1[2]), sigm(b[3] + b1[3])}); });
    } break;
    case 7: if (PHSEL(7)) { PH_IDS
        const float *state_rwkv = INP(5), *state_shift = INP(6), *state_lru = INP(7), *shift_mu = INP(16), *k_k = INP(22), *k_a = INP(23), *lru_lambda = INP(33);
        constexpr int TC = 32;
        LAS float* VEC = (LAS float*)lds;
        LAS float* SC = (LAS float*)(lds + 6 * TC * 64 * 4);
        LAS float* YB = (LAS float*)(lds + 6 * TC * 64 * 4 + 1024);
        for (int unit = bx; unit < 256; unit += G) {
            const int b = unit >> 5, h = (unit >> 1) & 15, half = unit & 1;
            const int tt = tid >> 4, cgq = tid & 15, chb = h * 64 + 4 * cgq;
            const f32x4 mu_r = *(const f32x4*)(shift_mu + chb), mu_k = *(const f32x4*)(shift_mu + 1024 + chb), mu_v = *(const f32x4*)(shift_mu + 2048 + chb),
                        kkc = *(const f32x4*)(k_k + chb), kac = *(const f32x4*)(k_a + chb);
            const int rowl = 4 * wave + (lane >> 4), kq = lane & 15, srow = 32 * half + rowl;
            f32x4 S = (f32x4){0.f, 0.f, 0.f, 0.f};
            u32x2 q_r, q_k, q_v, q_rp, q_kp, q_vp, q_e, q_a;
            auto issue = [&](int chunk) {
                const int tg = chunk * TC + tt; const size_t row = (size_t)b * T + tg; const bf16_t* base = PR + row * RP + chb;
                q_r = *(const u32x2*)(base); q_k = *(const u32x2*)(base + 1024); q_v = *(const u32x2*)(base + 2048);
                if (tg > 0) { q_rp = *(const u32x2*)(base - RP); q_kp = *(const u32x2*)(base - RP + 1024); q_vp = *(const u32x2*)(base - RP + 2048); }
                else { q_rp = (u32x2){0u, 0u}; q_kp = q_rp; q_vp = q_rp; }
                q_e = *(const u32x2*)(WD + row * D + chb); q_a = *(const u32x2*)(AA + row * D + chb);
            };
            issue(0);
            for (int chunk = 0; chunk < T / TC; ++chunk) {
                {
                    const f32x4 pr = unpack4(q_r), pk = unpack4(q_k), pv = unpack4(q_v);
                    const f32x4 r = pr + (unpack4(q_rp) - pr) * mu_r, k = pk + (unpack4(q_kp) - pk) * mu_k, v = pv + (unpack4(q_vp) - pv) * mu_v;
                    const f32x4 e = unpack4(q_e), a = unpack4(q_a);
                    const f32x4 w = (f32x4){__expf(-e[0]), __expf(-e[1]), __expf(-e[2]), __expf(-e[3])};
                    f32x4 kk = k * kkc; const float n2 = red16(dot4(kk, kk)); kk = kk * (1.0f / fmaxf(sqrtf(n2), 1e-12f));
                    const f32x4 kp = k * (1.0f + (a - 1.0f) * kac), bv = kk * a, wrv = w * r;
                    const float br = red16(dot4(bv, r)), kr = red16(dot4(kp, r));
                    const int o = tt * 64 + 4 * cgq;
                    *(LAS f32x4*)(VEC + 0 * TC * 64 + o) = -kk; *(LAS f32x4*)(VEC + 1 * TC * 64 + o) = wrv; *(LAS f32x4*)(VEC + 2 * TC * 64 + o) = w;
                    *(LAS f32x4*)(VEC + 3 * TC * 64 + o) = bv; *(LAS f32x4*)(VEC + 4 * TC * 64 + o) = kp; *(LAS f32x4*)(VEC + 5 * TC * 64 + o) = v;
                    if (cgq == 0) *(LAS f32x2*)(SC + 2 * tt) = (f32x2){br, kr};
                }
                __syncthreads();
                if (chunk + 1 < T / TC) issue(chunk + 1);
#pragma unroll 4
                for (int t = 0; t < TC; ++t) {
                    const int o = t * 64 + 4 * kq;
                    const f32x4 nk = *(const LAS f32x4*)(VEC + 0 * TC * 64 + o), wrv = *(const LAS f32x4*)(VEC + 1 * TC * 64 + o), wv = *(const LAS f32x4*)(VEC + 2 * TC * 64 + o),
                                bv = *(const LAS f32x4*)(VEC + 3 * TC * 64 + o), kv = *(const LAS f32x4*)(VEC + 4 * TC * 64 + o);
                    const float vv = VEC[5 * TC * 64 + t * 64 + srow]; const f32x2 sc = *(const LAS f32x2*)(SC + 2 * t);
                    const float sa = red16(dot4(S, nk)), z = red16(dot4(S, wrv));
                    const float y = z + sa * sc.x + vv * sc.y;
                    S = S * wv + bv * sa + kv * vv;
                    if (kq == 0) YB[t * 32 + rowl] = y;
                }
                __syncthreads();
                { const int t2 = tid >> 4, r2 = (tid & 15) * 2;
                  *(f32x2*)(Y + ((size_t)b * T + chunk * TC + t2) * D + h * 64 + 32 * half + r2) = *(const LAS f32x2*)(YB + t2 * 32 + r2); }
            }
            *(f32x4*)(out + O_PRWKV + (((size_t)b * 16 + h) * 64 + srow) * 64 + 4 * kq) = S;
            __syncthreads();
        }
        if (fin) {
            LAS float* V1 = (LAS float*)(lds + wave * 2048);
            const int cgq = lane & 15;
            for (int un = gw; un < NS * 16; un += ngw) {
                const int i = un >> 4, h = un & 15, chb = h * 64 + 4 * cgq; const size_t row = (size_t)MP + i;
                const bf16_t* base = PR + row * RP + chb; const float* sb = state_shift + (size_t)i * RP + chb;
                const f32x4 pr = unpack4(*(const u32x2*)(base)), pk = unpack4(*(const u32x2*)(base + 1024)), pv = unpack4(*(const u32x2*)(base + 2048));
                const f32x4 r = pr + (*(const f32x4*)(sb) - pr) * *(const f32x4*)(shift_mu + chb), k = pk + (*(const f32x4*)(sb + 1024) - pk) * *(const f32x4*)(shift_mu + 1024 + chb),
                            v = pv + (*(const f32x4*)(sb + 2048) - pv) * *(const f32x4*)(shift_mu + 2048 + chb);
                const f32x4 e = unpack4(*(const u32x2*)(WD + row * D + chb)), a = unpack4(*(const u32x2*)(AA + row * D + chb));
                const f32x4 w = (f32x4){__expf(-e[0]), __expf(-e[1]), __expf(-e[2]), __expf(-e[3])};
                f32x4 kk = k * *(const f32x4*)(k_k + chb); const float n2 = red16(dot4(kk, kk)); kk = kk * (1.0f / fmaxf(sqrtf(n2), 1e-12f));
                const f32x4 kp = k * (1.0f + (a - 1.0f) * *(const f32x4*)(k_a + chb)), bv = kk * a, wrv = w * r;
                const float br = red16(dot4(bv, r)), kr = red16(dot4(kp, r));
                if (lane < 16) *(LAS f32x4*)(V1 + 320 + 4 * cgq) = v;
                asm volatile("s_waitcnt lgkmcnt(0)" ::: "memory");
                const f32x4 nk = -kk;
                const size_t sbase = ((size_t)i * 16 + h) * 4096;
#pragma unroll 4
                for (int rg = 0; rg < 16; ++rg) {
                    const int srow = 4 * rg + (lane >> 4);
                    f32x4 S = *(const f32x4*)(state_rwkv + sbase + srow * 64 + 4 * cgq);
                    const float vv = V1[320 + srow];
                    const float sa = red16(dot4(S, nk)), z = red16(dot4(S, wrv));
                    const float y = z + sa * br + vv * kr;
                    S = S * w + bv * sa + kp * vv;
                    *(f32x4*)(out + O_SRWKV + sbase + srow * 64 + 4 * cgq) = S;
                    if (cgq == 0) Y[row * D + h * 64 + srow] = y;
                }
                asm volatile("s_waitcnt lgkmcnt(0)" ::: "memory");
            }
        }
        __syncthreads();
        if (fin) {
            LAS f32x2* sA = (LAS f32x2*)lds; LAS f32x2* sB = (LAS f32x2*)(lds + 4096);
            for (int unit = bx; unit < 128; unit += G) {
                const int b = unit >> 4, l32 = tid & 31, ch = (unit & 15) * 64 + 2 * l32, seg = tid >> 5, t0 = seg * 128;
                const f32x2 lam = *(const f32x2*)(lru_lambda + ch); const float sp0 = softplus_(-lam.x), sp1 = softplus_(-lam.y);
                const size_t base = ((size_t)b * T + t0) * D + ch;
                float A0 = 1.f, B0 = 0.f, A1 = 1.f, B1 = 0.f;
#pragma unroll 8
                for (int t = 0; t < 128; ++t) { const size_t o = base + (size_t)t * D;
                    const unsigned gr = *(const unsigned*)(GR + o), gi = *(const unsigned*)(GI + o), xc = *(const unsigned*)(XC + o);
                    const float la0 = -8.0f * __uint_as_float(gr << 16) * sp0, la1 = -8.0f * __uint_as_float(gr & 0xffff0000u) * sp1;
                    const float a0 = __expf(la0), a1 = __expf(la1);
                    const float b0 = sqrtf(fmaxf(1.0f - a0 * a0, 0.f)) * __uint_as_float(gi << 16) * __uint_as_float(xc << 16);
                    const float b1 = sqrtf(fmaxf(1.0f - a1 * a1, 0.f)) * __uint_as_float(gi & 0xffff0000u) * __uint_as_float(xc & 0xffff0000u);
                    A0 *= a0; B0 = a0 * B0 + b0; A1 *= a1; B1 = a1 * B1 + b1; }
                sA[seg * 32 + l32] = (f32x2){A0, A1}; sB[seg * 32 + l32] = (f32x2){B0, B1};
                __syncthreads();
                float h0 = 0.f, h1 = 0.f;
                for (int s2 = 0; s2 < seg; ++s2) { const f32x2 a = sA[s2 * 32 + l32], bb = sB[s2 * 32 + l32]; h0 = a.x * h0 + bb.x; h1 = a.y * h1 + bb.y; }
#pragma unroll 8
                for (int t = 0; t < 128; ++t) { const size_t o = base + (size_t)t * D;
                    const unsigned gr = *(const unsigned*)(GR + o), gi = *(const unsigned*)(GI + o), xc = *(const unsigned*)(XC + o), gg = *(const unsigned*)(GG + o);
                    const float la0 = -8.0f * __uint_as_float(gr << 16) * sp0, la1 = -8.0f * __uint_as_float(gr & 0xffff0000u) * sp1;
                    const float a0 = __expf(la0), a1 = __expf(la1);
                    const float b0 = sqrtf(fmaxf(1.0f - a0 * a0, 0.f)) * __uint_as_float(gi << 16) * __uint_as_float(xc << 16);
                    const float b1 = sqrtf(fmaxf(1.0f - a1 * a1, 0.f)) * __uint_as_float(gi & 0xffff0000u) * __uint_as_float(xc & 0xffff0000u);
                    h0 = a0 * h0 + b0; h1 = a1 * h1 + b1;
                    *(unsigned*)(LO + o) = cvt_pk_bf16(h0 * __uint_as_float(gg << 16), h1 * __uint_as_float(gg & 0xffff0000u)); }
                if (seg == 15) *(f32x2*)(out + O_PLRU + (size_t)b * D + ch) = (f32x2){h0, h1};
                __syncthreads();
            }
            for (int i = gt; i < NS * D; i += ngt) { const int ch = i & (D - 1); const size_t o = (size_t)MP * D + i;
                const float sp = softplus_(-lru_lambda[ch]);
                const float gr = bf2f(GR[o]), gi = bf2f(GI[o]), xc = bf2f(XC[o]), gg = bf2f(GG[o]);
                const float la = -8.0f * gr * sp, a = __expf(la), bb = sqrtf(fmaxf(-expm1f(2.0f * la), 0.f)) * gi * xc;
                const float hst = a * state_lru[i] + bb; out[O_SLRU + i] = hst; LO[o] = f2bf(hst * gg); }
        }
    } break;
    case 8: if (PHSEL(8)) { PH_IDS
        const float *state_shift = INP(6), *shift_mu = INP(16), *k_a = INP(23), *r_k = INP(24), *gn_g = INP(25), *gn_b = INP(26);
        for (int row = gw; row < MT; row += ngw) {
            const bool smp = row >= MP; const int t = row & (T - 1), si = row - MP;
#pragma unroll
            for (int j = 0; j < 4; ++j) { const int c = 256 * j + 4 * lane;
                const bf16_t* base = PR + (size_t)row * RP + c;
                const f32x4 pr = unpack4(*(const u32x2*)(base)), pk = unpack4(*(const u32x2*)(base + 1024)), pv = unpack4(*(const u32x2*)(base + 2048));
                f32x4 qr = (f32x4){0.f, 0.f, 0.f, 0.f}, qk = qr, qv = qr;
                if (smp) { const float* sb = state_shift + (size_t)si * RP + c; qr = *(const f32x4*)(sb); qk = *(const f32x4*)(sb + 1024); qv = *(const f32x4*)(sb + 2048); }
                else if (t > 0) { qr = unpack4(*(const u32x2*)(base - RP)); qk = unpack4(*(const u32x2*)(base - RP + 1024)); qv = unpack4(*(const u32x2*)(base - RP + 2048)); }
                const f32x4 r = pr + (qr - pr) * *(const f32x4*)(shift_mu + c), k = pk + (qk - pk) * *(const f32x4*)(shift_mu + 1024 + c), v = pv + (qv - pv) * *(const f32x4*)(shift_mu + 2048 + c);
                const f32x4 a = unpack4(*(const u32x2*)(AA + (size_t)row * D + c));
                const f32x4 kp = k * (1.0f + (a - 1.0f) * *(const f32x4*)(k_a + c));
                const float bon = red16(dot4(r * kp, *(const f32x4*)(r_k + c)));
                const f32x4 y = *(const f32x4*)(Y + (size_t)row * D + c);
                const float mean = red16((y.x + y.y) + (y.z + y.w)) * (1.0f / 64.0f);
                const f32x4 dy = y - mean; const float var = red16(dot4(dy, dy)) * (1.0f / 64.0f);
                const f32x4 yn = dy * (1.0f / sqrtf(var + GN_EPS)) * *(const f32x4*)(gn_g + c) + *(const f32x4*)(gn_b + c);
                const f32x4 gg = unpack4(*(const u32x2*)(GB + (size_t)row * D + c)), s0 = unpack4(*(const u32x2*)(SG0 + (size_t)row * D + c)), lo_ = unpack4(*(const u32x2*)(LO + (size_t)row * D + c));
                const f32x4 mg = s0 * ((yn + v * bon) * gg) + lo_;
                *(u32x2*)(MB + (size_t)row * D + c) = pack4(mg); }
        }
        __syncthreads();
        { LAS float* scr = (LAS float*)(lds + wave * 16384);
          constexpr int I_WI = 16 * (2 * FF / 32), I_WO = (FF / 64) * 32;
          for (int it = gw; it < I_WI + I_WO; it += ngw) { if (it < I_WI) transpose_item(INP(13), D, 2 * FF, WI, 1, scr, it, lane); else transpose_item(INP(14), FF, D, WO, 0, scr, it - I_WI, lane); } }
    } break;
    case 9: case 14: if (PHSEL(9)) { PH_IDS
        const bf16_t* Am = ph == 9 ? MB : OB; const bf16_t* Wt = ph == 9 ? WMIX : WOX;
        { pg8::Gemm g{Am, Wt, D, D, D}; pg8::Sched S; S.init(MP / 256, D / 256, G, bx, 0, D, D); pg8::EpiResid E{H, PRE, 1.0f}; pg8::gemm_phase(lds, g, S, E); }
        skinny<false>(Am, D, Wt, D, D, 0, D / 256, 0, bx, G, tid, [&](int row, int tile, int cin, f32x4 a, f32x4) {
            const size_t off = (size_t)row * D + tile * 256 + cin; *(f32x4*)(PRE + off) = *(const f32x4*)(H + off) * DN_ALPHA + a; });
    } break;
    case 11: if (PHSEL(11)) { PH_IDS
        const float qs = 0.0625f * 1.4426950408889634f;
        { pg8::Gemm g{HB, WQ, D, D, D}; pg8::Sched S; S.init(MP / 256, D / 256, G, bx, 0, D, D); pg8::EpiBf16 E{QB, D, qs}; pg8::gemm_phase(lds, g, S, E); }
        skinny<false>(HB, D, WQ, D, D, 0, D / 256, 0, bx, G, tid, [&](int row, int tile, int cin, f32x4 a, f32x4) { *(u32x2*)(QB + (size_t)row * D + tile * 256 + cin) = pack4(a * qs); });
    } break;
    case 12: if (PHSEL(12)) { PH_IDS
        const float *cache_k = INP(3), *cache_v = INP(4);
        { pg8::Gemm g{QB, KB, D, D, 256}; pg8::Sched S; S.init(MP / 256, 4, G, bx, 2, D, D); pg8::EpiSoftmax E{PB}; pg8::gemm_phase(lds, g, S, E); }
        __syncthreads();
        LAS float* sS = (LAS float*)lds;
        LAS float* sO = (LAS float*)(lds + 4096);
        for (int un = bx; un < NS * 4; un += G) {
            const int i = un >> 2, h = un & 3;
            const f32x4 q = unpack4(*(const u32x2*)(QB + (size_t)(MP + i) * D + h * 256 + 4 * lane));
            const float* kb = cache_k + ((size_t)i * 256 * 4 + h) * 256 + 4 * lane;
            const float* vb = cache_v + ((size_t)i * 256 * 4 + h) * 256 + 4 * lane;
#pragma unroll 8
            for (int mm = 0; mm < 32; ++mm) { const int m = wave * 32 + mm; const f32x4 kx = *(const f32x4*)(kb + (size_t)m * 1024);
                const float s = wave_sum(dot4(q, kx)); if (lane == 0) sS[m] = s; }
            __syncthreads();
            float mx = -3.0e38f;
#pragma unroll
            for (int j = 0; j < 4; ++j) mx = fmaxf(mx, sS[lane + 64 * j]);
            mx = wave_max(mx);
            float sum = 0.f;
#pragma unroll
            for (int j = 0; j < 4; ++j) sum += __builtin_amdgcn_exp2f(sS[lane + 64 * j] - mx);
            sum = wave_sum(sum); const float inv = 1.0f / sum;
            f32x4 o = (f32x4){0.f, 0.f, 0.f, 0.f};
#pragma unroll 8
            for (int mm = 0; mm < 32; ++mm) { const int m = wave * 32 + mm; const f32x4 vx = *(const f32x4*)(vb + (size_t)m * 1024);
                const float p = __builtin_amdgcn_exp2f(sS[m] - mx) * inv; o = o + vx * p; }
            *(LAS f32x4*)(sO + wave * 256 + 4 * lane) = o;
            __syncthreads();
            if (tid < 256) { float acc = 0.f;
#pragma unroll
                for (int w8 = 0; w8 < 8; ++w8) acc += sO[w8 * 256 + tid];
                OB[(size_t)(MP + i) * D + h * 256 + tid] = f2bf(acc); }
            __syncthreads();
        }
    } break;
    case 13: if (PHSEL(13)) { PH_IDS pg8::Gemm g{PB, VT, D, NB * 256, 256}; pg8::Sched S; S.init(MP / 256, 4, G, bx, 3, D, NB * 256); pg8::EpiBf16 E{OB, D, 1.0f}; pg8::gemm_phase(lds, g, S, E); } break;
    default: break;
    }
}

__global__ void __launch_bounds__(NTHR, 2) mega(Args args) {
    extern __shared__ __attribute__((aligned(16))) unsigned char lds_raw[];
    LAS unsigned char* lds = (LAS unsigned char*)lds_raw;
    cg::grid_group grid = cg::this_grid();
    const int G = gridDim.x, bx = blockIdx.x;
    const int lo = args.ph_lo, hi = args.ph_hi;
    unsigned* const bar = (unsigned*)args.ws;
    volatile LAS unsigned* const bst = (volatile LAS unsigned*)(lds + 131072 + 64);
    if (threadIdx.x < 2) bst[threadIdx.x] = 0u;
    if (threadIdx.x == 0) (void)xb_add(&bar[XB_XCNT(xb_xcc_id())], 1u);
    grid.sync();
#ifndef DUPK
#define DUPK -1
#endif
#define GSYNC() xcd_barrier(bar, bst)
#define RUN(k) if (lo <= (k) && (k) < hi) { if ((k) == DUPK) { run_phase<k>(args, lds, G, bx, false); GSYNC(); } run_phase<k>(args, lds, G, bx); if ((k) + 1 < hi) GSYNC(); }
    RUN(0) RUN(1) RUN(2) RUN(3) RUN(4) RUN(5) RUN(6) RUN(7) RUN(8) RUN(9) RUN(10) RUN(11) RUN(12) RUN(13) RUN(14) RUN(15) RUN(16) RUN(17) RUN(18)
#undef RUN
}

#ifndef N_LAUNCH_PER_PHASE
#define N_LAUNCH_PER_PHASE 0
#endif
extern "C" void kernel_launch(void* const* d_in, const int* in_sizes, int n_in, void* d_out, int out_size, void* d_ws, size_t ws_size, hipStream_t stream) {
    static int grid = 0;
    if (grid == 0) {
        if (n_in != 39 || out_size != (int)O_TOTAL || ws_size < WS_END) { fprintf(stderr, "kernel_launch: unexpected shapes (n_in %d out %d ws %zu)\n", n_in, out_size, ws_size); grid = -1; return; }
        int dev = 0, cus = 0, per_cu = 0;
        hipGetDevice(&dev); hipDeviceGetAttribute(&cus, hipDeviceAttributeMultiprocessorCount, dev);
        hipFuncSetAttribute((const void*)mega, hipFuncAttributeMaxDynamicSharedMemorySize, LDS_BYTES);
        hipOccupancyMaxActiveBlocksPerMultiprocessor(&per_cu, (const void*)mega, NTHR, LDS_BYTES);
        if (per_cu < 1) { fprintf(stderr, "kernel_launch: occupancy query says 0 blocks per CU\n"); grid = -1; return; }
        grid = cus;
    }
    if (grid < 0) return;
    if (hipMemsetAsync(d_ws, 0, 65536, stream) != hipSuccess) { fprintf(stderr, "kernel_launch: memset of control words failed\n"); return; }
    Args a{};
    for (int i = 0; i < 39; ++i) a.in[i] = (const float*)d_in[i];
    a.out = (float*)d_out; a.ws = (unsigned char*)d_ws;
#if N_LAUNCH_PER_PHASE
    for (int p = 0; p < 19; ++p) { a.ph_lo = p; a.ph_hi = p + 1; void* kargs[] = {&a};
        hipLaunchCooperativeKernel((const void*)mega, dim3(grid), dim3(NTHR), kargs, LDS_BYTES, stream); }
#else
    a.ph_lo = 0; a.ph_hi = 19; void* kargs[] = {&a};
    hipError_t e = hipLaunchCooperativeKernel((const void*)mega, dim3(grid), dim3(NTHR), kargs, LDS_BYTES, stream);
    if (e != hipSuccess) fprintf(stderr, "cooperative launch failed: %s (grid %d)\n", hipGetErrorString(e), grid);
#endif
}
```

```cpp
#include <hip/hip_runtime.h>
#include <hip/hip_cooperative_groups.h>
#include <cstdio>
#include <cstdint>
namespace cg = cooperative_groups;

#define LAS __attribute__((address_space(3)))
typedef unsigned short bf16_t;
typedef short bf16x8 __attribute__((ext_vector_type(8)));
typedef float f32x4 __attribute__((ext_vector_type(4)));
typedef float f32x2 __attribute__((ext_vector_type(2)));
typedef unsigned u32x4 __attribute__((ext_vector_type(4)));
typedef unsigned u32x2 __attribute__((ext_vector_type(2)));

constexpr int D = 1024, T = 2048, NB = 8, MP = NB * T, NS = 128, MT = MP + NS, FF = 2816, RP = 3328, PW = 7424;
constexpr int NWAVES = 8, NTHR = 512;
constexpr float DN_ALPHA = 1.189207115002721f;
constexpr float LN_EPS = 1e-5f, GN_EPS = 64e-5f;

constexpr size_t MiB = 1u << 20;
constexpr size_t WS_WI = 1 * MiB, WS_WO = 12 * MiB, WS_WIN = 19 * MiB, WS_WMIX = 34 * MiB, WS_WQ = 36 * MiB, WS_WOX = 38 * MiB, WS_WKV = 40 * MiB,
                 WS_LORAT = 44 * MiB, WS_LRUT = 46 * MiB, WS_MEMB = 47 * MiB, WS_KB = 51 * MiB, WS_VT = 55 * MiB, WS_HB = 60 * MiB, WS_PRE = 93 * MiB,
                 WS_PR = 158 * MiB, WS_PL = 263 * MiB, WS_GG = 296 * MiB, WS_SG0 = 329 * MiB, WS_GI = 362 * MiB, WS_WD = 395 * MiB, WS_AA = 428 * MiB,
                 WS_G = 461 * MiB, WS_L = 494 * MiB, WS_END = 503 * MiB;
static_assert(WS_G - WS_AA == WS_AA - WS_WD, "WD/AA/G spacing");
static_assert((size_t)MT * RP * 2 <= 105 * MiB && (size_t)MT * D * 2 <= 33 * MiB && (size_t)MT * D * 4 <= 65 * MiB && (size_t)MT * 256 * 2 <= 9 * MiB, "ws map");
constexpr size_t O_YP = 0, O_YS = 16777216, O_PMK = 16908288, O_PMV = 19005440, O_PRWKV = 21102592, O_PSHIFT = 21626880, O_PLRU = 21653504,
                 O_PCONV = 21661696, O_SRWKV = 21686272, O_SSHIFT = 30074880, O_SLRU = 30500864, O_SCONV = 30631936, O_TOTAL = 31025152;

constexpr int LDS_BYTES = 139264;

typedef __bf16 bf16x2_t __attribute__((ext_vector_type(2)));
__device__ __forceinline__ unsigned cvt_pk_bf16(float lo, float hi) { const f32x2 v = {lo, hi}; return __builtin_bit_cast(unsigned, __builtin_convertvector(v, bf16x2_t)); }
__device__ __forceinline__ bf16_t f2bf(float f) { return (bf16_t)(cvt_pk_bf16(f, 0.f) & 0xffffu); }
__device__ __forceinline__ float bf2f(bf16_t h) { return __uint_as_float(((unsigned)h) << 16); }
__device__ __forceinline__ f32x4 unpack4(u32x2 u) { return (f32x4){__uint_as_float(u.x << 16), __uint_as_float(u.x & 0xffff0000u), __uint_as_float(u.y << 16), __uint_as_float(u.y & 0xffff0000u)}; }
__device__ __forceinline__ u32x2 pack4(f32x4 v) { u32x2 r; r.x = cvt_pk_bf16(v.x, v.y); r.y = cvt_pk_bf16(v.z, v.w); return r; }
__device__ __forceinline__ float sigm(float x) { return 1.0f / (1.0f + __expf(-x)); }
__device__ __forceinline__ float silu(float x) { return x * sigm(x); }
__device__ __forceinline__ float tanh_(float x) { float e = __expf(2.0f * x); return 1.0f - 2.0f / (e + 1.0f); }
__device__ __forceinline__ float gelu_t(float x) { float u = 0.7978845608028654f * (x + 0.044715f * x * x * x); return 0.5f * x * (1.0f + tanh_(u)); }
__device__ __forceinline__ float softplus_(float x) { return x > 20.f ? x : log1pf(expf(x)); }
__device__ __forceinline__ float decay_e(float pre) { return 0.6065306597126334f * sigm(pre); }
template <int CTRL> __device__ __forceinline__ float dppf(float x) { return __builtin_bit_cast(float, __builtin_amdgcn_update_dpp(0, __builtin_bit_cast(int, x), CTRL, 0xf, 0xf, true)); }
__device__ __forceinline__ float red16(float x) {
    x += dppf<0xB1>(x); x += dppf<0x4E>(x); x += dppf<0x141>(x); x += dppf<0x140>(x); return x;
}
__device__ __forceinline__ int opaque(int x) { asm volatile("" : "+v"(x)); return x; }
__device__ __forceinline__ float dot4(f32x4 a, f32x4 b) { return (a.x * b.x + a.y * b.y) + (a.z * b.z + a.w * b.w); }
__device__ __forceinline__ float wave_sum(float v) {
#pragma unroll
    for (int o = 1; o < 64; o <<= 1) v += __shfl_xor(v, o);
    return v;
}
__device__ __forceinline__ float wave_max(float v) {
#pragma unroll
    for (int o = 1; o < 64; o <<= 1) v = fmaxf(v, __shfl_xor(v, o));
    return v;
}

namespace pg8 {
constexpr int BM = 256, BK = 64, HALF = 128, HTB = HALF * BK * 2, STAGE_BYTES = 8 * HTB, NXCD = 8, WGM = 8;
__host__ __device__ __forceinline__ int lds_byte(int r, int c) { const int st = (r >> 4) * 2 + (c >> 5), rr = r & 15, cc = c & 31, ob = rr * 64 + cc * 2; return st * 1024 + (ob ^ (((ob >> 9) & 1) << 5)); }
__host__ __device__ __forceinline__ void stage_rc(int b, int& R, int& C) { const int st = b / 1024, sb = b % 1024, swz = sb ^ (((sb >> 9) & 1) << 5); R = (st >> 1) * 16 + swz / 64; C = (st & 1) * 32 + (swz % 64) / 2; }
__host__ __device__ __forceinline__ int perm32(int rho) { const int n = rho >> 4, i = rho & 15; return 8 * (i >> 2) + 4 * n + (i & 3); }

struct Unit { int pm, pn; };
struct Gemm { const bf16_t* A; const bf16_t* Bt; int lda, ldb, K; };

struct Sched {
    int nM, nN, nwg, G, c, mode;
    long lda, ldb;
    __device__ void init(int nM_, int nN_, int G_, int c_, int mode_, int lda_, int ldb_) { nM = nM_; nN = nN_; nwg = nM * nN; G = G_; c = c_; mode = mode_; lda = lda_; ldb = ldb_; }
    __device__ bool next(int i, Unit& u) const {
        const int L = i * G + c; if (L >= nwg) return false;
        int wgid = L; { const int q = nwg / NXCD, r = nwg % NXCD, xcd = wgid % NXCD, off = wgid / NXCD; wgid = (xcd < r ? xcd * (q + 1) : r * (q + 1) + (xcd - r) * q) + off; }
        const int nig = WGM * nN, gid = wgid / nig, fm = gid * WGM, gsz = (nM - fm) < WGM ? (nM - fm) : WGM;
        u.pm = fm + ((wgid % nig) % gsz); u.pn = (wgid % nig) / gsz; return true;
    }
    __device__ __forceinline__ long aoff(const Unit& u) const {
        long o = (long)u.pm * 256 * lda;
        if (mode == 1) o += 256 * (u.pn >> 1); else if (mode >= 2) o += u.pn * 256;
        return o;
    }
    __device__ __forceinline__ long boff(const Unit& u) const {
        if (mode == 2) return (long)(u.pm >> 3) * 256 * ldb + u.pn * 256;
        if (mode == 3) return (long)u.pn * 256 * ldb + (u.pm >> 3) * 256;
        return (long)u.pn * 256 * ldb;
    }
};

template <class Epi>
__device__ __forceinline__ void gemm_phase(LAS unsigned char* lds, const Gemm g, const Sched& S, const Epi& E) {
    const int tid = opaque(threadIdx.x), wid = __builtin_amdgcn_readfirstlane(tid >> 6), lane = tid & 63, wr = wid >> 2, wc = wid & 3, fr = lane & 15, fq = lane >> 4;
    const int K = g.K, nt = K / BK;
    unsigned voffA[2], voffB[2];
#pragma unroll
    for (int i = 0; i < 2; ++i) { int R, C; stage_rc(tid * 16 + i * 8192, R, C); const int Rb = Epi::PERM ? ((R & ~31) + perm32(R & 31)) : R;
        voffA[i] = (unsigned)(R * g.lda + C) * 2u; voffB[i] = (unsigned)(Rb * g.ldb + C) * 2u; }
    const size_t kstep = (size_t)(BK * 2);
    const size_t hstepA = (size_t)HALF * g.lda * 2, hstepB = (size_t)HALF * g.ldb * 2;
    const unsigned ldsw = (unsigned)wid * 1024u;
    const int aoff = lds_byte(wr * 64 + fr, fq * 8), boff = lds_byte(wc * 32 + fr, fq * 8);
#define PG8_SA(b, h) (((b) * 2 + (h)) * HTB)
#define PG8_SB(b, h) ((4 + (b) * 2 + (h)) * HTB)
#define PG8_STAGE(bufoff, gbase, voff) do { _Pragma("unroll") for (int _i = 0; _i < 2; ++_i) \
        __builtin_amdgcn_global_load_lds((const unsigned*)((const char*)(gbase) + (voff)[_i]), (LAS unsigned*)(lds + (bufoff) + ldsw + _i * 8192), 16, 0, 0); } while (0)
#define PG8_LDA(dst, b, h) do { _Pragma("unroll") for (int m = 0; m < 4; ++m) _Pragma("unroll") for (int k = 0; k < 2; ++k) dst[m][k] = *(const LAS bf16x8*)(lds + PG8_SA(b, h) + aoff + m * 2048 + k * 1024); } while (0)
#define PG8_LDB(dst, b, h) do { _Pragma("unroll") for (int n = 0; n < 2; ++n) _Pragma("unroll") for (int k = 0; k < 2; ++k) dst[n][k] = *(const LAS bf16x8*)(lds + PG8_SB(b, h) + boff + n * 2048 + k * 1024); } while (0)
#define PG8_MMA(ai, bj, At, Bt) do { __builtin_amdgcn_s_setprio(1); _Pragma("unroll") for (int m = 0; m < 4; ++m) _Pragma("unroll") for (int n = 0; n < 2; ++n) _Pragma("unroll") for (int k = 0; k < 2; ++k) \
        acc[ai][bj][m][n] = __builtin_amdgcn_mfma_f32_16x16x32_bf16(Bt[n][k], At[m][k], acc[ai][bj][m][n], 0, 0, 0); __builtin_amdgcn_s_setprio(0); } while (0)
#define PG8_WAIT_V(n) asm volatile("s_waitcnt vmcnt(" #n ")" ::: "memory")
#define PG8_WAIT_L(n) asm volatile("s_waitcnt lgkmcnt(" #n ")" ::: "memory")
#define PG8_BAR __builtin_amdgcn_s_barrier()
#define PG8_SCHED __builtin_amdgcn_sched_barrier(0)
    Unit cur, nxt; int ui = 0;
    if (!S.next(0, cur)) return;
    f32x4 acc[2][2][4][2];
#pragma unroll
    for (int a = 0; a < 2; ++a)
#pragma unroll
        for (int b = 0; b < 2; ++b)
#pragma unroll
            for (int m = 0; m < 4; ++m)
#pragma unroll
                for (int n = 0; n < 2; ++n) acc[a][b][m][n] = (f32x4){0.f, 0.f, 0.f, 0.f};
    bf16x8 At[4][2], B0[2][2], B1[2][2];
    const char* cA = (const char*)g.A + (size_t)S.aoff(cur) * 2; const char* cB = (const char*)g.Bt + (size_t)S.boff(cur) * 2;
    PG8_STAGE(PG8_SB(0, 0), cB, voffB); PG8_STAGE(PG8_SB(0, 1), cB + hstepB, voffB); PG8_STAGE(PG8_SA(0, 0), cA, voffA); PG8_STAGE(PG8_SA(0, 1), cA + hstepA, voffA);
    if (wr == 1) PG8_BAR;
    PG8_WAIT_V(2); PG8_BAR;
    PG8_STAGE(PG8_SB(1, 0), cB + kstep, voffB); PG8_STAGE(PG8_SA(1, 0), cA + kstep, voffA); PG8_STAGE(PG8_SB(1, 1), cB + hstepB + kstep, voffB);
    PG8_WAIT_V(6); PG8_BAR;
    for (;;) {
        const bool has_next = S.next(ui + 1, nxt);
        const char* nA = has_next ? (const char*)g.A + (size_t)S.aoff(nxt) * 2 : cA; const char* nB = has_next ? (const char*)g.Bt + (size_t)S.boff(nxt) * 2 : cB;
        _Pragma("nounroll")
        for (int t = 0; t < nt; t += 2) {
            const bool last = (t == nt - 2);
            const char* a1 = cA + (size_t)(t + 1) * kstep;
            const char* a2 = last ? nA : cA + (size_t)(t + 2) * kstep; const char* b2 = last ? nB : cB + (size_t)(t + 2) * kstep;
            const char* a3 = a2 + kstep; const char* b3 = b2 + kstep;
            PG8_LDB(B0, 0, 0); PG8_LDB(B1, 0, 1); PG8_SCHED; PG8_LDA(At, 0, 0); PG8_STAGE(PG8_SA(1, 1), a1 + hstepA, voffA);
            PG8_WAIT_V(8); PG8_WAIT_L(0); PG8_BAR; PG8_MMA(0, 0, At, B0); PG8_MMA(0, 1, At, B1); PG8_BAR; PG8_SCHED;
            PG8_LDA(At, 0, 1); PG8_STAGE(PG8_SB(0, 0), b2, voffB); PG8_STAGE(PG8_SB(0, 1), b2 + hstepB, voffB); PG8_STAGE(PG8_SA(0, 0), a2, voffA);
            PG8_WAIT_V(8); PG8_WAIT_L(0); PG8_BAR; PG8_MMA(1, 0, At, B0); PG8_MMA(1, 1, At, B1); PG8_BAR; PG8_SCHED;
            PG8_LDB(B0, 1, 0); PG8_LDB(B1, 1, 1); PG8_SCHED; PG8_LDA(At, 1, 0); PG8_STAGE(PG8_SA(0, 1), a2 + hstepA, voffA);
            PG8_WAIT_V(8); PG8_WAIT_L(0); PG8_BAR; PG8_MMA(0, 0, At, B0); PG8_MMA(0, 1, At, B1); PG8_BAR; PG8_SCHED;
            PG8_LDA(At, 1, 1); PG8_STAGE(PG8_SB(1, 0), b3, voffB); PG8_STAGE(PG8_SB(1, 1), b3 + hstepB, voffB); PG8_STAGE(PG8_SA(1, 0), a3, voffA);
            PG8_WAIT_V(8); PG8_WAIT_L(0); PG8_BAR; PG8_MMA(1, 0, At, B0); PG8_MMA(1, 1, At, B1); PG8_BAR; PG8_SCHED;
        }
        if (wr == 0) PG8_BAR;
        if constexpr (!Epi::AFTER_DRAIN) { E(acc, cur, wr, wc, fr, fq); }
        if (!has_next) break;
#pragma unroll
        for (int a = 0; a < 2; ++a)
#pragma unroll
            for (int b = 0; b < 2; ++b)
#pragma unroll
                for (int m = 0; m < 4; ++m)
#pragma unroll
                    for (int n = 0; n < 2; ++n) acc[a][b][m][n] = (f32x4){0.f, 0.f, 0.f, 0.f};
        cur = nxt; cA = nA; cB = nB; ++ui;
        if (wr == 1) PG8_BAR;
    }
    PG8_WAIT_V(0);
    PG8_BAR;
    if constexpr (Epi::AFTER_DRAIN) { E.fused(acc, cur, wr, wc, fr, fq, lds, wid, lane); }
#undef PG8_SA
#undef PG8_SB
#undef PG8_STAGE
#undef PG8_LDA
#undef PG8_LDB
#undef PG8_MMA
#undef PG8_WAIT_V
#undef PG8_WAIT_L
#undef PG8_BAR
#undef PG8_SCHED
}

#define EPI_ROWS(ai, m) (u.pm * BM + (ai) * HALF + wr * 64 + (m) * 16 + fr)
typedef const f32x4 (&AccRef)[2][2][4][2];

struct EpiSwiglu {
    static constexpr bool PERM = true, AFTER_DRAIN = false;
    bf16_t* O;
    __device__ __forceinline__ void operator()(AccRef acc, const Unit& u, int wr, int wc, int fr, int fq) const {
        const int col0 = u.pn * 128 + wc * 32 + 8 * fq;
#pragma unroll
        for (int ai = 0; ai < 2; ++ai)
#pragma unroll
            for (int m = 0; m < 4; ++m) {
                const f32x4 g0 = acc[ai][0][m][0], g1 = acc[ai][0][m][1], u0 = acc[ai][1][m][0], u1 = acc[ai][1][m][1];
                u32x4 w;
                w.x = cvt_pk_bf16(silu(g0[0]) * u0[0], silu(g0[1]) * u0[1]); w.y = cvt_pk_bf16(silu(g0[2]) * u0[2], silu(g0[3]) * u0[3]);
                w.z = cvt_pk_bf16(silu(g1[0]) * u1[0], silu(g1[1]) * u1[1]); w.w = cvt_pk_bf16(silu(g1[2]) * u1[2], silu(g1[3]) * u1[3]);
                *(u32x4*)(O + (size_t)EPI_ROWS(ai, m) * FF + col0) = w;
            }
    }
};
struct EpiBf16 {
    static constexpr bool PERM = true, AFTER_DRAIN = false;
    bf16_t* O; int ldc; float scale;
    __device__ __forceinline__ void operator()(AccRef acc, const Unit& u, int wr, int wc, int fr, int fq) const {
        const int col0 = u.pn * BM + wc * 32 + 8 * fq;
#pragma unroll
        for (int ai = 0; ai < 2; ++ai)
#pragma unroll
            for (int m = 0; m < 4; ++m) { bf16_t* rowp = O + (size_t)EPI_ROWS(ai, m) * ldc + col0;
#pragma unroll
                for (int bj = 0; bj < 2; ++bj) { const f32x4 v0 = acc[ai][bj][m][0] * scale, v1 = acc[ai][bj][m][1] * scale;
                    u32x4 w; w.x = cvt_pk_bf16(v0[0], v0[1]); w.y = cvt_pk_bf16(v0[2], v0[3]); w.z = cvt_pk_bf16(v1[0], v1[1]); w.w = cvt_pk_bf16(v1[2], v1[3]);
                    *(u32x4*)(rowp + bj * HALF) = w; } }
    }
};
struct EpiProj {
    static constexpr bool PERM = true, AFTER_DRAIN = false;
    bf16_t *PR, *PL, *GG, *SG0;
    __device__ __forceinline__ void operator()(AccRef acc, const Unit& u, int wr, int wc, int fr, int fq) const {
        const int pn = u.pn, cw = wc * 32 + 8 * fq;
        if (pn >= 17 && pn < 25) {
            const int col0 = (pn - 17) * 128 + cw;
#pragma unroll
            for (int ai = 0; ai < 2; ++ai)
#pragma unroll
                for (int m = 0; m < 4; ++m) {
                    const f32x4 g0 = acc[ai][0][m][0], g1 = acc[ai][0][m][1], s0 = acc[ai][1][m][0], s1 = acc[ai][1][m][1];
                    u32x4 w;
                    w.x = cvt_pk_bf16(gelu_t(g0[0]) * sigm(s0[0]), gelu_t(g0[1]) * sigm(s0[1])); w.y = cvt_pk_bf16(gelu_t(g0[2]) * sigm(s0[2]), gelu_t(g0[3]) * sigm(s0[3]));
                    w.z = cvt_pk_bf16(gelu_t(g1[0]) * sigm(s1[0]), gelu_t(g1[1]) * sigm(s1[1])); w.w = cvt_pk_bf16(gelu_t(g1[2]) * sigm(s1[2]), gelu_t(g1[3]) * sigm(s1[3]));
                    *(u32x4*)(GG + (size_t)EPI_ROWS(ai, m) * D + col0) = w;
                }
        } else {
            bf16_t* base; int ldc, colt; bool sg = false;
            if (pn < 13) { base = PR; ldc = RP; colt = pn * 256; } else { ldc = D; sg = pn >= 17; colt = ((pn - 13) & 3) * 256; base = sg ? SG0 : PL; }
#pragma unroll
            for (int ai = 0; ai < 2; ++ai)
#pragma unroll
                for (int m = 0; m < 4; ++m) { bf16_t* rowp = base + (size_t)EPI_ROWS(ai, m) * ldc + colt + cw;
#pragma unroll
                    for (int bj = 0; bj < 2; ++bj) { f32x4 v0 = acc[ai][bj][m][0], v1 = acc[ai][bj][m][1];
                        if (sg) { v0 = (f32x4){sigm(v0[0]), sigm(v0[1]), sigm(v0[2]), sigm(v0[3])}; v1 = (f32x4){sigm(v1[0]), sigm(v1[1]), sigm(v1[2]), sigm(v1[3])}; }
                        u32x4 w; w.x = cvt_pk_bf16(v0[0], v0[1]); w.y = cvt_pk_bf16(v0[2], v0[3]); w.z = cvt_pk_bf16(v1[0], v1[1]); w.w = cvt_pk_bf16(v1[2], v1[3]);
                        *(u32x4*)(rowp + bj * HALF) = w; } }
        }
    }
};
struct EpiResid {
    static constexpr bool PERM = false, AFTER_DRAIN = false;
    const float* base; float* out; float s;
    __device__ __forceinline__ void operator()(AccRef acc, const Unit& u, int wr, int wc, int fr, int fq) const {
        const int col0 = u.pn * BM + wc * 32 + 4 * fq;
#pragma unroll
        for (int ai = 0; ai < 2; ++ai)
#pragma unroll
            for (int m = 0; m < 4; ++m) { const size_t off = (size_t)EPI_ROWS(ai, m) * D + col0;
#pragma unroll
                for (int bj = 0; bj < 2; ++bj)
#pragma unroll
                    for (int n = 0; n < 2; ++n) { const f32x4 b = *(const f32x4*)(base + off + bj * HALF + n * 16);
                        *(f32x4*)(out + off + bj * HALF + n * 16) = b * DN_ALPHA + acc[ai][bj][m][n] * s; } }
    }
};
struct EpiKV {
    static constexpr bool PERM = false, AFTER_DRAIN = false;
    float *ok, *ov; bf16_t* KB;
    __device__ __forceinline__ void operator()(AccRef acc, const Unit& u, int wr, int wc, int fr, int fq) const {
        const bool isk = u.pn < 4; float* o = isk ? ok : ov; const int col0 = (u.pn & 3) * BM + wc * 32 + 4 * fq;
#pragma unroll
        for (int ai = 0; ai < 2; ++ai)
#pragma unroll
            for (int m = 0; m < 4; ++m) { const size_t off = (size_t)EPI_ROWS(ai, m) * D + col0;
#pragma unroll
                for (int bj = 0; bj < 2; ++bj)
#pragma unroll
                    for (int n = 0; n < 2; ++n) { const f32x4 v = acc[ai][bj][m][n]; *(f32x4*)(o + off + bj * HALF + n * 16) = v;
                        if (isk) *(u32x2*)(KB + off + bj * HALF + n * 16) = pack4(v); } }
    }
};
struct EpiLora {
    static constexpr bool PERM = true, AFTER_DRAIN = false;
    bf16_t *WD, *AA, *G; const float *w0, *a0;
    __device__ __forceinline__ void operator()(AccRef acc, const Unit& u, int wr, int wc, int fr, int fq) const {
        const int kind = u.pn >> 2, colt = (u.pn & 3) * 256 + wc * 32 + 8 * fq;
        bf16_t* base = WD + (size_t)kind * ((WS_AA - WS_WD) / 2);
        const float* bias = kind == 0 ? w0 : a0;
#pragma unroll
        for (int bj = 0; bj < 2; ++bj) {
            f32x4 b0 = (f32x4){0.f, 0.f, 0.f, 0.f}, b1 = b0;
            if (kind < 2) { b0 = *(const f32x4*)(bias + colt + bj * HALF); b1 = *(const f32x4*)(bias + colt + bj * HALF + 4); }
#pragma unroll
            for (int ai = 0; ai < 2; ++ai)
#pragma unroll
                for (int m = 0; m < 4; ++m) { f32x4 v0 = acc[ai][bj][m][0] + b0, v1 = acc[ai][bj][m][1] + b1;
                    if (kind == 0) { v0 = (f32x4){decay_e(v0[0]), decay_e(v0[1]), decay_e(v0[2]), decay_e(v0[3])}; v1 = (f32x4){decay_e(v1[0]), decay_e(v1[1]), decay_e(v1[2]), decay_e(v1[3])}; }
                    else if (kind == 1) { v0 = (f32x4){sigm(v0[0]), sigm(v0[1]), sigm(v0[2]), sigm(v0[3])}; v1 = (f32x4){sigm(v1[0]), sigm(v1[1]), sigm(v1[2]), sigm(v1[3])}; }
                    u32x4 w; w.x = cvt_pk_bf16(v0[0], v0[1]); w.y = cvt_pk_bf16(v0[2], v0[3]); w.z = cvt_pk_bf16(v1[0], v1[1]); w.w = cvt_pk_bf16(v1[2], v1[3]);
                    *(u32x4*)(base + (size_t)EPI_ROWS(ai, m) * D + colt + bj * HALF) = w; }
        }
    }
};
struct EpiLru {
    static constexpr bool PERM = true, AFTER_DRAIN = false;
    bf16_t *GR, *GI; const float *br, *bi;
    __device__ __forceinline__ void operator()(AccRef acc, const Unit& u, int wr, int wc, int fr, int fq) const {
        const int col0 = u.pn * 128 + wc * 32 + 8 * fq;
#pragma unroll
        for (int bj = 0; bj < 2; ++bj) {
            const float* bias = bj ? bi : br; bf16_t* base = bj ? GI : GR;
            const f32x4 b0 = *(const f32x4*)(bias + col0), b1 = *(const f32x4*)(bias + col0 + 4);
#pragma unroll
            for (int ai = 0; ai < 2; ++ai)
#pragma unroll
                for (int m = 0; m < 4; ++m) { const f32x4 v0 = acc[ai][bj][m][0] + b0, v1 = acc[ai][bj][m][1] + b1;
                    u32x4 w; w.x = cvt_pk_bf16(sigm(v0[0]), sigm(v0[1])); w.y = cvt_pk_bf16(sigm(v0[2]), sigm(v0[3])); w.z = cvt_pk_bf16(sigm(v1[0]), sigm(v1[1])); w.w = cvt_pk_bf16(sigm(v1[2]), sigm(v1[3]));
                    *(u32x4*)(base + (size_t)EPI_ROWS(ai, m) * D + col0) = w; }
        }
    }
};
struct EpiSoftmax {
    static constexpr bool PERM = true, AFTER_DRAIN = true;
    bf16_t* P;
    __device__ __forceinline__ void fused(f32x4 (&acc)[2][2][4][2], const Unit& u, int wr, int wc, int fr, int fq, LAS unsigned char* lds, int wid, int lane) const {
        LAS float* MX = (LAS float*)lds;
        LAS float* SM = (LAS float*)(lds + 4096);
#pragma unroll
        for (int ai = 0; ai < 2; ++ai)
#pragma unroll
            for (int m = 0; m < 4; ++m) {
                float mx = -3.0e38f;
#pragma unroll
                for (int bj = 0; bj < 2; ++bj)
#pragma unroll
                    for (int n = 0; n < 2; ++n) { const f32x4 x = acc[ai][bj][m][n]; mx = fmaxf(mx, fmaxf(fmaxf(x[0], x[1]), fmaxf(x[2], x[3]))); }
                mx = fmaxf(mx, __shfl_xor(mx, 16)); mx = fmaxf(mx, __shfl_xor(mx, 32));
                if (fq == 0) MX[(ai * HALF + wr * 64 + m * 16 + fr) * 4 + wc] = mx;
            }
        __syncthreads();
#pragma unroll
        for (int ai = 0; ai < 2; ++ai)
#pragma unroll
            for (int m = 0; m < 4; ++m) {
                const int rl = ai * HALF + wr * 64 + m * 16 + fr;
                const f32x4 mm = *(const LAS f32x4*)(MX + rl * 4);
                const float mx = fmaxf(fmaxf(mm[0], mm[1]), fmaxf(mm[2], mm[3]));
                float s = 0.f;
#pragma unroll
                for (int bj = 0; bj < 2; ++bj)
#pragma unroll
                    for (int n = 0; n < 2; ++n) { f32x4 x = acc[ai][bj][m][n];
                        x = (f32x4){__builtin_amdgcn_exp2f(x[0] - mx), __builtin_amdgcn_exp2f(x[1] - mx), __builtin_amdgcn_exp2f(x[2] - mx), __builtin_amdgcn_exp2f(x[3] - mx)};
                        acc[ai][bj][m][n] = x; s += (x[0] + x[1]) + (x[2] + x[3]); }
                s += __shfl_xor(s, 16); s += __shfl_xor(s, 32);
                if (fq == 0) SM[rl * 4 + wc] = s;
            }
        __syncthreads();
        const int col0 = u.pn * BM + wc * 32 + 8 * fq;
#pragma unroll
        for (int ai = 0; ai < 2; ++ai)
#pragma unroll
            for (int m = 0; m < 4; ++m) {
                const int rl = ai * HALF + wr * 64 + m * 16 + fr;
                const f32x4 ss = *(const LAS f32x4*)(SM + rl * 4);
                const float inv = 1.0f / ((ss[0] + ss[1]) + (ss[2] + ss[3]));
                bf16_t* rowp = P + (size_t)(u.pm * BM + rl) * D + col0;
#pragma unroll
                for (int bj = 0; bj < 2; ++bj) { const f32x4 v0 = acc[ai][bj][m][0] * inv, v1 = acc[ai][bj][m][1] * inv;
                    u32x4 w; w.x = cvt_pk_bf16(v0[0], v0[1]); w.y = cvt_pk_bf16(v0[2], v0[3]); w.z = cvt_pk_bf16(v1[0], v1[1]); w.w = cvt_pk_bf16(v1[2], v1[3]);
                    *(u32x4*)(rowp + bj * HALF) = w; }
            }
        __syncthreads();
    }
};
}

template <bool PAIR, class F>
__device__ __forceinline__ void skinny(const bf16_t* A, int lda, const bf16_t* Bt, int ldb, int K, int tile_lo, int tile_hi, int kmode, int bx, int G, int tid_, F f) {
    const int tid = opaque(tid_), lane = tid & 63, w = __builtin_amdgcn_readfirstlane(tid >> 6), fr = lane & 15, fq = lane >> 4;
    constexpr int GPT = PAIR ? 2 : 4;
    const int nunits = (tile_hi - tile_lo) * GPT * 4;
    for (int un = bx; un < nunits; un += G) {
        const int rbp = un & 3, cgrp = un >> 2, tile = tile_lo + cgrp / GPT, cgp = (cgrp % GPT) * 4 + (w & 3), rb = rbp * 2 + (w >> 2);
        const int n0 = tile * 256 + cgp * 16, row = MP + rb * 16 + fr;
        const bf16_t* ap = A + (size_t)row * lda + (kmode ? 256 * (tile >> 1) : 0) + fq * 8;
        const bf16_t* bp = Bt + (size_t)(n0 + fr) * ldb + fq * 8;
        f32x4 acc0 = (f32x4){0.f, 0.f, 0.f, 0.f}, acc1 = acc0;
        for (int k0 = 0; k0 < K; k0 += 256) {
#pragma unroll
            for (int kk = 0; kk < 256; kk += 32) {
                const bf16x8 a = *(const bf16x8*)(ap + k0 + kk), b = *(const bf16x8*)(bp + k0 + kk);
                acc0 = __builtin_amdgcn_mfma_f32_16x16x32_bf16(b, a, acc0, 0, 0, 0);
                if (PAIR) { const bf16x8 b2 = *(const bf16x8*)(bp + (size_t)128 * ldb + k0 + kk); acc1 = __builtin_amdgcn_mfma_f32_16x16x32_bf16(b2, a, acc1, 0, 0, 0); }
            }
        }
        f(row, tile, cgp * 16 + 4 * fq, acc0, acc1);
    }
}

__device__ __forceinline__ int map_row(int mapmode, int n) {
    if (mapmode == 1) { if (n < FF) return 256 * (n / 128) + (n % 128); const int q = n - FF; return 256 * (q / 128) + 128 + (q % 128); }
    if (mapmode == 2) { if (n < 4352) return n; if (n < 5376) { const int q = n - 4352; return 256 * (17 + q / 128) + (q % 128); }
                        if (n < 6400) return 256 * 25 + (n - 5376); const int q = n - 6400; return 256 * (17 + q / 128) + 128 + (q % 128); }
    return n;
}
__device__ __forceinline__ void transpose_item(const float* W, int K, int N, bf16_t* WT, int mapmode, LAS float* scr, int item, int lane) {
    const int nblk = N / 32, kb = item / nblk, nb = item % nblk, k0 = 64 * kb, n0 = 32 * nb;
#pragma unroll 8
    for (int i = 0; i < 32; ++i) { const int kk = 2 * i + (lane >> 5); scr[kk * 33 + (lane & 31)] = W[(size_t)(k0 + kk) * N + n0 + (lane & 31)]; }
    asm volatile("s_waitcnt lgkmcnt(0)" ::: "memory");
    const int c = lane & 7, d0 = map_row(mapmode, n0);
#pragma unroll
    for (int j = 0; j < 4; ++j) { const int n = (lane >> 3) + 8 * j; const LAS float* s = scr + (8 * c) * 33 + n;
        u32x4 o; o.x = cvt_pk_bf16(s[0 * 33], s[1 * 33]); o.y = cvt_pk_bf16(s[2 * 33], s[3 * 33]); o.z = cvt_pk_bf16(s[4 * 33], s[5 * 33]); o.w = cvt_pk_bf16(s[6 * 33], s[7 * 33]);
        *(u32x4*)(WT + (size_t)(d0 + n) * K + k0 + 8 * c) = o; }
    asm volatile("s_waitcnt lgkmcnt(0)" ::: "memory");
}

struct Args { const float* in[39]; float* out; unsigned char* ws; int ph_lo, ph_hi; };

__device__ __forceinline__ void ln_pass(const float* PRE, const float* g, const float* b, float* H, bf16_t* HB, int gw, int ngw, int lane) {
    f32x4 gv[4], bv[4];
#pragma unroll
    for (int j = 0; j < 4; ++j) { gv[j] = *(const f32x4*)(g + 256 * j + 4 * lane); bv[j] = *(const f32x4*)(b + 256 * j + 4 * lane); }
    for (int row = gw; row < MT; row += ngw) {
        const float* p = PRE + (size_t)row * D + 4 * lane;
        f32x4 v[4]; float s = 0.f;
#pragma unroll
        for (int j = 0; j < 4; ++j) { v[j] = *(const f32x4*)(p + 256 * j); s += (v[j].x + v[j].y) + (v[j].z + v[j].w); }
        const float mean = wave_sum(s) * (1.f / D); float s2 = 0.f;
#pragma unroll
        for (int j = 0; j < 4; ++j) { v[j] = v[j] - mean; s2 += (v[j].x * v[j].x + v[j].y * v[j].y) + (v[j].z * v[j].z + v[j].w * v[j].w); }
        const float rstd = 1.0f / sqrtf(wave_sum(s2) * (1.f / D) + LN_EPS);
#pragma unroll
        for (int j = 0; j < 4; ++j) { const f32x4 o = v[j] * rstd * gv[j] + bv[j];
            *(f32x4*)(H + (size_t)row * D + 256 * j + 4 * lane) = o;
            if (HB) *(u32x2*)(HB + (size_t)row * D + 256 * j + 4 * lane) = pack4(o); }
    }
}

#define XB_TMO      128
#define XB_XCNT(j)  (256  + 64 * (j))
#define XB_XSUB(j)  (1280 + 64 * (j))
#define XB_XGEN(j)  (2304 + 64 * (j))
#define XB_TOP      3328
#define XB_TOPGEN   3392
#define XCD_BAR_WORDS 3456
#define XB_SPIN_CAP (1u << 22)
__device__ __forceinline__ unsigned xb_ld(unsigned* p)              { return __hip_atomic_load(p, __ATOMIC_RELAXED, __HIP_MEMORY_SCOPE_AGENT); }
__device__ __forceinline__ unsigned xb_add(unsigned* p, unsigned v) { return __hip_atomic_fetch_add(p, v, __ATOMIC_RELAXED, __HIP_MEMORY_SCOPE_AGENT); }
__device__ __forceinline__ unsigned xb_xcc_id() { return (unsigned)__builtin_amdgcn_s_getreg((3 << 11) | 20) & 0xFu; }
#define XB_SPIN(cond, bar) do { unsigned _sp = 0; while (cond) { __builtin_amdgcn_s_sleep(1); \
    if ((++_sp & 255u) == 0u) { if (xb_ld(&(bar)[XB_TMO])) break; if (_sp > XB_SPIN_CAP) { atomicAdd(&(bar)[XB_TMO], 1u); break; } } } } while (0)
__device__ __forceinline__ void xcd_barrier_complete(unsigned* bar, unsigned x, unsigned& nloc, unsigned& nx) {
    const unsigned G = gridDim.x;
    unsigned sum, cnt, mine, sp = 0u;
    for (;;) {
        sum = 0u; cnt = 0u; mine = 0u;
#pragma unroll
        for (unsigned j = 0; j < 16; ++j) { const unsigned c = xb_ld(&bar[XB_XCNT(j)]); sum += c; cnt += (c > 0u) ? 1u : 0u; mine = (j == x) ? c : mine; }
        if (sum == G) break;
        __builtin_amdgcn_s_sleep(1);
        if ((++sp & 255u) == 0u) { if (xb_ld(&bar[XB_TMO])) break; if (sp > XB_SPIN_CAP) { atomicAdd(&bar[XB_TMO], 1u); break; } }
    }
    nloc = mine > 0u ? mine : 1u; nx = cnt > 0u ? cnt : 1u;
}
__device__ __forceinline__ void xcd_barrier(unsigned* bar, volatile LAS unsigned* st) {
    asm volatile("s_waitcnt vmcnt(0) lgkmcnt(0)" ::: "memory");
    __syncthreads();
    if (threadIdx.x == 0) {
        __builtin_amdgcn_s_waitcnt(0);
        const unsigned x = xb_xcc_id();
        unsigned nloc = st[0], nx = st[1];
        if (nloc == 0u) { xcd_barrier_complete(bar, x, nloc, nx); st[0] = nloc; st[1] = nx; }
        const unsigned old = xb_add(&bar[XB_XSUB(x)], 1u);
        const unsigned gen = old / nloc;
        if (old + 1u == (gen + 1u) * nloc) {
            __builtin_amdgcn_fence(__ATOMIC_RELEASE, "agent");
            asm volatile("s_waitcnt vmcnt(0)" ::: "memory");
            const unsigned og = xb_add(&bar[XB_TOP], 1u);
            const unsigned tg = og / nx;
            if (og + 1u == (tg + 1u) * nx) xb_add(&bar[XB_TOPGEN], 1u);
            else XB_SPIN(xb_ld(&bar[XB_TOPGEN]) == tg, bar);
            __builtin_amdgcn_fence(__ATOMIC_ACQUIRE, "agent");
            xb_add(&bar[XB_XGEN(x)], 1u);
            asm volatile("s_waitcnt vmcnt(0)" ::: "memory");
        } else {
            XB_SPIN(xb_ld(&bar[XB_XGEN(x)]) == gen, bar);
            __builtin_amdgcn_fence(__ATOMIC_ACQUIRE, "agent");
            asm volatile("s_waitcnt vmcnt(0)" ::: "memory");
        }
    }
    __syncthreads();
}

#define PH_IDS const int tid = opaque(threadIdx.x), lane = tid & 63, wave = __builtin_amdgcn_readfirstlane(tid >> 6), gw = bx * NWAVES + wave, gt = bx * NTHR + tid; (void)lane; (void)gw; (void)gt; PH_PTRS
#define PH_PTRS \
    unsigned char* ws = args.ws; float* out = args.out; \
    bf16_t *WI = (bf16_t*)(ws + WS_WI), *WO = (bf16_t*)(ws + WS_WO), *WIN = (bf16_t*)(ws + WS_WIN), *WMIX = (bf16_t*)(ws + WS_WMIX), *WQ = (bf16_t*)(ws + WS_WQ), *WOX = (bf16_t*)(ws + WS_WOX), \
           *WKV = (bf16_t*)(ws + WS_WKV), *LORAT = (bf16_t*)(ws + WS_LORAT), *LRUT = (bf16_t*)(ws + WS_LRUT), *MEMB = (bf16_t*)(ws + WS_MEMB), *KB = (bf16_t*)(ws + WS_KB), *VT = (bf16_t*)(ws + WS_VT), \
           *HB = (bf16_t*)(ws + WS_HB), *PR = (bf16_t*)(ws + WS_PR), *PL = (bf16_t*)(ws + WS_PL), *GG = (bf16_t*)(ws + WS_GG), *SG0 = (bf16_t*)(ws + WS_SG0), *GI = (bf16_t*)(ws + WS_GI), \
           *WD = (bf16_t*)(ws + WS_WD), *AA = (bf16_t*)(ws + WS_AA), *GB = (bf16_t*)(ws + WS_G), *LB = (bf16_t*)(ws + WS_L); \
    bf16_t *ACT = PR, *XC = HB, *MB = HB, *GR = PL, *LO = GI, *QB = PL, *PB = GG, *OB = SG0; \
    float *PRE = (float*)(ws + WS_PRE), *Y = PRE, *H = out; \
    (void)WI; (void)WO; (void)WIN; (void)WMIX; (void)WQ; (void)WOX; (void)WKV; (void)LORAT; (void)LRUT; (void)MEMB; (void)KB; (void)VT; (void)HB; (void)PR; (void)PL; (void)GG; (void)SG0; (void)GI; \
    (void)WD; (void)AA; (void)GB; (void)LB; (void)ACT; (void)XC; (void)MB; (void)GR; (void)LO; (void)QB; (void)PB; (void)OB; (void)PRE; (void)Y; (void)H;
#define INP(k) (args.in[k])
#ifndef PHSEL
#define PHSEL(k) true
#endif
template <int ph>
__device__ __forceinline__ void run_phase(const Args& args, LAS unsigned char* lds, const int G, const int bx, const bool fin = true) {
    const int ngw = G * NWAVES, ngt = G * NTHR; (void)ngw; (void)ngt;
    switch (ph) {
    case 0: if (PHSEL(0)) { PH_IDS
        const float *x_prompt = INP(0), *x_sample = INP(1), *mem_prompt = INP(2), *decay_w2 = INP(18), *aaa_a2 = INP(20), *gate_g2 = INP(21), *lru_wr = INP(29), *lru_wi = INP(31);
        LAS float* scr = (LAS float*)(lds + wave * 16384);
        constexpr int I_WI = 16 * (2 * FF / 32), I_WO = (FF / 64) * 32, I_WIN = 16 * (PW / 32), I_SQ = 16 * 32;
        constexpr int NIT = I_WI + I_WO + I_WIN + 5 * I_SQ;
        for (int it = gw; it < NIT; it += ngw) {
            int r = it;
            if (r < I_WI) { transpose_item(INP(11), D, 2 * FF, WI, 1, scr, r, lane); continue; } r -= I_WI;
            if (r < I_WO) { transpose_item(INP(12), FF, D, WO, 0, scr, r, lane); continue; } r -= I_WO;
            if (r < I_WIN) { transpose_item(INP(15), D, PW, WIN, 2, scr, r, lane); continue; } r -= I_WIN;
            if (r < I_SQ) { transpose_item(INP(34), D, D, WMIX, 0, scr, r, lane); continue; } r -= I_SQ;
            if (r < I_SQ) { transpose_item(INP(35), D, D, WQ, 0, scr, r, lane); continue; } r -= I_SQ;
            if (r < I_SQ) { transpose_item(INP(36), D, D, WKV, 0, scr, r, lane); continue; } r -= I_SQ;
            if (r < I_SQ) { transpose_item(INP(37), D, D, WKV + (size_t)D * D, 0, scr, r, lane); continue; } r -= I_SQ;
            transpose_item(INP(38), D, D, WOX, 0, scr, r, lane);
        }
        for (int i = gt; i < 3072 * 256; i += ngt) { const int n = i >> 8, k = i & 255; float v = 0.f;
            if (n < 1024) { if (k < 64) v = decay_w2[k * 1024 + n]; } else if (n < 2048) { if (k >= 64 && k < 128) v = aaa_a2[(k - 64) * 1024 + (n - 1024)]; } else { if (k >= 128) v = gate_g2[(k - 128) * 1024 + (n - 2048)]; }
            LORAT[i] = f2bf(v); }
        for (int i = gt; i < 2048 * 256; i += ngt) { const int n = i >> 8, k = i & 255; const int q = n >> 8, bj = (n >> 7) & 1, j = n & 127;
            const int c = 128 * q + j, nb = c >> 6, d = c & 63; const int cin = 256 * (q >> 1) + k; float v = 0.f;
            if ((cin >> 6) == nb) v = (bj ? lru_wi : lru_wr)[(nb * 64 + (cin & 63)) * 64 + d];
            LRUT[i] = f2bf(v); }
        for (int i = gt; i < MT * D / 4; i += ngt) { const f32x4 v = (i < MP * D / 4) ? ((const f32x4*)x_prompt)[i] : ((const f32x4*)x_sample)[i - MP * D / 4];
            ((f32x4*)H)[i] = v; ((u32x2*)HB)[i] = pack4(v); }
        for (int i = gt; i < NB * 256 * D / 4; i += ngt) ((u32x2*)MEMB)[i] = pack4(((const f32x4*)mem_prompt)[i]);
    } break;

    case 1: case 16: if (PHSEL(1)) { PH_IDS
        { pg8::Gemm g{HB, WI, D, D, D}; pg8::Sched S; S.init(MP / 256, 2 * FF / 256, G, bx, 0, D, D); pg8::EpiSwiglu E{ACT}; pg8::gemm_phase(lds, g, S, E); }
        skinny<true>(HB, D, WI, D, D, 0, 2 * FF / 256, 0, bx, G, tid, [&](int row, int tile, int cin, f32x4 a, f32x4 b) {
            f32x4 o = (f32x4){silu(a[0]) * b[0], silu(a[1]) * b[1], silu(a[2]) * b[2], silu(a[3]) * b[3]};
            *(u32x2*)(ACT + (size_t)row * FF + tile * 128 + cin) = pack4(o); });
        if (ph == 1) {
        { pg8::Gemm g{MEMB, WKV, D, D, D}; pg8::Sched S; S.init(8, 8, G, bx, 0, D, D); pg8::EpiKV E{out + O_PMK, out + O_PMV, KB}; pg8::gemm_phase(lds, g, S, E); }
        { pg8::Gemm g{WKV + (size_t)D * D, MEMB, D, D, D}; pg8::Sched S; S.init(4, 8, G, bx, 0, D, D); pg8::EpiBf16 E{VT, NB * 256, 1.0f}; pg8::gemm_phase(lds, g, S, E); }
        }
    } break;
    case 2: case 17: if (PHSEL(2)) { PH_IDS
        { pg8::Gemm g{ACT, WO, FF, FF, FF}; pg8::Sched S; S.init(MP / 256, D / 256, G, bx, 0, FF, FF); pg8::EpiResid E{H, PRE, 0.5f}; pg8::gemm_phase(lds, g, S, E); }
        skinny<false>(ACT, FF, WO, FF, FF, 0, D / 256, 0, bx, G, tid, [&](int row, int tile, int cin, f32x4 a, f32x4) {
            const size_t off = (size_t)row * D + tile * 256 + cin; *(f32x4*)(PRE + off) = *(const f32x4*)(H + off) * DN_ALPHA + a * 0.5f; });
    } break;
    case 3: case 10: case 15: case 18: if (PHSEL(3)) { PH_IDS
        const float *ln_g = INP(9), *ln_b = INP(10);
        const int li = ph == 3 ? 0 : (ph == 10 ? 1 : (ph == 15 ? 2 : 3));
        ln_pass(PRE, ln_g + li * D, ln_b + li * D, H, ph == 18 ? (bf16_t*)nullptr : HB, gw, ngw, lane);
    } break;
    case 4: if (PHSEL(4)) { PH_IDS
        { pg8::Gemm g{HB, WIN, D, D, D}; pg8::Sched S; S.init(MP / 256, PW / 256, G, bx, 0, D, D); pg8::EpiProj E{PR, PL, GG, SG0}; pg8::gemm_phase(lds, g, S, E); }
        skinny<false>(HB, D, WIN, D, D, 0, 17, 0, bx, G, tid, [&](int row, int tile, int cin, f32x4 a, f32x4) {
            if (tile < 13) *(u32x2*)(PR + (size_t)row * RP + tile * 256 + cin) = pack4(a); else *(u32x2*)(PL + (size_t)row * D + (tile - 13) * 256 + cin) = pack4(a); });
        skinny<false>(HB, D, WIN, D, D, 25, 29, 0, bx, G, tid, [&](int row, int tile, int cin, f32x4 a, f32x4) {
            *(u32x2*)(SG0 + (size_t)row * D + (tile - 25) * 256 + cin) = pack4((f32x4){sigm(a[0]), sigm(a[1]), sigm(a[2]), sigm(a[3])}); });
        skinny<true>(HB, D, WIN, D, D, 17, 25, 0, bx, G, tid, [&](int row, int tile, int cin, f32x4 a, f32x4 b) {
            *(u32x2*)(GG + (size_t)row * D + (tile - 17) * 128 + cin) = pack4((f32x4){gelu_t(a[0]) * sigm(b[0]), gelu_t(a[1]) * sigm(b[1]), gelu_t(a[2]) * sigm(b[2]), gelu_t(a[3]) * sigm(b[3])}); });
    } break;
    case 5: if (PHSEL(5)) { PH_IDS
        const float *state_shift = INP(6), *state_conv = INP(8), *shift_mu = INP(16), *conv_w = INP(27), *conv_b = INP(28);
        for (int row = gw; row < MT; row += ngw) {
            const bool smp = row >= MP; const int t = row & (T - 1), b = row >> 11, si = row - MP;
            { const int c = 3072 + 4 * lane; const f32x4 p = unpack4(*(const u32x2*)(PR + (size_t)row * RP + c));
              f32x4 pv = (f32x4){0.f, 0.f, 0.f, 0.f};
              if (smp) pv = *(const f32x4*)(state_shift + (size_t)si * RP + c); else if (t > 0) pv = unpack4(*(const u32x2*)(PR + (size_t)(row - 1) * RP + c));
              const f32x4 mu = *(const f32x4*)(shift_mu + c); f32x4 xs = p + (pv - p) * mu;
              if (lane < 16) xs = (f32x4){tanh_(xs[0]), tanh_(xs[1]), tanh_(xs[2]), tanh_(xs[3])}; else if (lane >= 32) xs = (f32x4){sigm(xs[0]), sigm(xs[1]), sigm(xs[2]), sigm(xs[3])};
              *(u32x2*)(LB + (size_t)row * 256 + 4 * lane) = pack4(xs); }
#pragma unroll
            for (int j = 0; j < 4; ++j) { const int c = 256 * j + 4 * lane;
                const f32x4 p3 = unpack4(*(const u32x2*)(PL + (size_t)row * D + c));
                f32x4 p0 = (f32x4){0.f, 0.f, 0.f, 0.f}, p1 = p0, p2 = p0;
                if (smp) { p0 = *(const f32x4*)(state_conv + ((size_t)si * 3 + 0) * D + c); p1 = *(const f32x4*)(state_conv + ((size_t)si * 3 + 1) * D + c); p2 = *(const f32x4*)(state_conv + ((size_t)si * 3 + 2) * D + c); }
                else { if (t >= 3) p0 = unpack4(*(const u32x2*)(PL + (size_t)(row - 3) * D + c)); if (t >= 2) p1 = unpack4(*(const u32x2*)(PL + (size_t)(row - 2) * D + c)); if (t >= 1) p2 = unpack4(*(const u32x2*)(PL + (size_t)(row - 1) * D + c)); }
                const f32x4 xc = *(const f32x4*)(conv_b + c) + *(const f32x4*)(conv_w + c) * p0 + *(const f32x4*)(conv_w + D + c) * p1 + *(const f32x4*)(conv_w + 2 * D + c) * p2 + *(const f32x4*)(conv_w + 3 * D + c) * p3;
                *(u32x2*)(XC + (size_t)row * D + c) = pack4(xc);
                if (smp) { *(f32x4*)(out + O_SCONV + ((size_t)si * 3 + 0) * D + c) = p1; *(f32x4*)(out + O_SCONV + ((size_t)si * 3 + 1) * D + c) = p2; *(f32x4*)(out + O_SCONV + ((size_t)si * 3 + 2) * D + c) = p3; }
                else if (t >= T - 3) *(f32x4*)(out + O_PCONV + ((size_t)b * 3 + (t - (T - 3))) * D + c) = p3; }
            if (smp || t == T - 1) { float* dst = smp ? out + O_SSHIFT + (size_t)si * RP : out + O_PSHIFT + (size_t)b * RP;
                for (int c = 4 * lane; c < RP; c += 256) *(f32x4*)(dst + c) = unpack4(*(const u32x2*)(PR + (size_t)row * RP + c)); }
        }
    } break;
    case 6: if (PHSEL(6)) { PH_IDS
        const float *decay_w0 = INP(17), *aaa_a0 = INP(19), *lru_br = INP(30), *lru_bi = INP(32);
        { pg8::Gemm g{LB, LORAT, 256, 256, 256}; pg8::Sched S; S.init(MP / 256, 12, G, bx, 0, 256, 256); pg8::EpiLora E{WD, AA, GB, decay_w0, aaa_a0}; pg8::gemm_phase(lds, g, S, E); }
        { pg8::Gemm g{XC, LRUT, D, 256, 256}; pg8::Sched S; S.init(MP / 256, 8, G, bx, 1, D, 256); pg8::EpiLru E{GR, GI, lru_br, lru_bi}; pg8::gemm_phase(lds, g, S, E); }
        skinny<false>(LB, 256, LORAT, 256, 256, 0, 12, 0, bx, G, tid, [&](int row, int tile, int cin, f32x4 a, f32x4) {
            const int kind = tile >> 2, c = (tile & 3) * 256 + cin; f32x4 o = a;
            if (kind == 0) { const f32x4 bb = *(const f32x4*)(decay_w0 + c); o = (f32x4){decay_e(a[0] + bb[0]), decay_e(a[1] + bb[1]), decay_e(a[2] + bb[2]), decay_e(a[3] + bb[3])}; }
            else if (kind == 1) { const f32x4 bb = *(const f32x4*)(aaa_a0 + c); o = (f32x4){sigm(a[0] + bb[0]), sigm(a[1] + bb[1]), sigm(a[2] + bb[2]), sigm(a[3] + bb[3])}; }
            bf16_t* base = WD + (size_t)kind * ((WS_AA - WS_WD) / 2); *(u32x2*)(base + (size_t)row * D + c) = pack4(o); });
        skinny<true>(XC, D, LRUT, 256, 256, 0, 8, 1, bx, G, tid, [&](int row, int tile, int cin, f32x4 a, f32x4 b) {
            const int c = tile * 128 + cin; const f32x4 b0 = *(const f32x4*)(lru_br + c), b1 = *(const f32x4*)(lru_bi + c);
            *(u32x2*)(GR + (size_t)row * D + c) = pack4((f32x4){sigm(a[0] + b0[0]), sigm(a[1] + b0[1]), sigm(a[2] + b0[2]), sigm(a[3] + b0[3])});
            *(u32x2*)(GI + (size_t)row * D + c) = pack4((f32x4){sigm(b[0] + b1[0]), sigm(b[1] + b1[1]), sigm(b[2] + b1[2]), sigm(b[3] + b1[3])}); });
    } break;
    case 7: if (PHSEL(7)) { PH_IDS
        const float *state_rwkv = INP(5), *state_shift = INP(6), *state_lru = INP(7), *shift_mu = INP(16), *k_k = INP(22), *k_a = INP(23), *lru_lambda = INP(33);
        constexpr int TC = 32, VB = 6 * TC * 64;
        LAS float* VECb = (LAS float*)lds;
        LAS float* SCb = (LAS float*)(lds + 2 * VB * 4);
        LAS float* YBb = (LAS float*)(lds + 2 * VB * 4 + 512);
        for (int unit = bx; unit < 256; unit += G) {
            const int b = unit >> 5, h = (unit >> 1) & 15, half = unit & 1;
            const bool producer = wave >= 4;
            const int ptid = tid & 255, tt0 = ptid >> 4, cgq = ptid & 15, chb = h * 64 + 4 * cgq;
            f32x4 mu_r, mu_k, mu_v, kkc, kac;
            u32x2 q_r[2], q_k[2], q_v[2], q_rp[2], q_kp[2], q_vp[2], q_e[2], q_a[2];
            auto issue = [&](int chunk) {
#pragma unroll
                for (int it = 0; it < 2; ++it) {
                    const int tg = chunk * TC + tt0 + 16 * it; const size_t row = (size_t)b * T + tg; const bf16_t* base = PR + row * RP + chb;
                    q_r[it] = *(const u32x2*)(base); q_k[it] = *(const u32x2*)(base + 1024); q_v[it] = *(const u32x2*)(base + 2048);
                    if (tg > 0) { q_rp[it] = *(const u32x2*)(base - RP); q_kp[it] = *(const u32x2*)(base - RP + 1024); q_vp[it] = *(const u32x2*)(base - RP + 2048); }
                    else { q_rp[it] = (u32x2){0u, 0u}; q_kp[it] = q_rp[it]; q_vp[it] = q_rp[it]; }
                    q_e[it] = *(const u32x2*)(WD + row * D + chb); q_a[it] = *(const u32x2*)(AA + row * D + chb);
                }
            };
            auto derive = [&](int buf) {
                LAS float* V = VECb + buf * VB;
#pragma unroll
                for (int it = 0; it < 2; ++it) {
                    const int tt = tt0 + 16 * it;
                    const f32x4 pr = unpack4(q_r[it]), pk = unpack4(q_k[it]), pv = unpack4(q_v[it]);
                    const f32x4 r = pr + (unpack4(q_rp[it]) - pr) * mu_r, k = pk + (unpack4(q_kp[it]) - pk) * mu_k, v = pv + (unpack4(q_vp[it]) - pv) * mu_v;
                    const f32x4 e = unpack4(q_e[it]), a = unpack4(q_a[it]);
                    const f32x4 w = (f32x4){__expf(-e[0]), __expf(-e[1]), __expf(-e[2]), __expf(-e[3])};
                    f32x4 kk = k * kkc; const float n2 = red16(dot4(kk, kk)); kk = kk * (1.0f / fmaxf(sqrtf(n2), 1e-12f));
                    const f32x4 kp = k * (1.0f + (a - 1.0f) * kac), bv = kk * a, wrv = w * r;
                    const float br = red16(dot4(bv, r)), kr = red16(dot4(kp, r));
                    const int o = tt * 64 + 4 * cgq;
                    *(LAS f32x4*)(V + 0 * TC * 64 + o) = -kk; *(LAS f32x4*)(V + 1 * TC * 64 + o) = wrv; *(LAS f32x4*)(V + 2 * TC * 64 + o) = w;
                    *(LAS f32x4*)(V + 3 * TC * 64 + o) = bv; *(LAS f32x4*)(V + 4 * TC * 64 + o) = kp; *(LAS f32x4*)(V + 5 * TC * 64 + o) = v;
                    if (cgq == 0) *(LAS f32x2*)(SCb + buf * TC * 2 + 2 * tt) = (f32x2){br, kr};
                }
            };
            auto storeY = [&](int chunk, int buf) {
                const int t2 = ptid >> 3, r4 = (ptid & 7) * 4;
                *(f32x4*)(Y + ((size_t)b * T + chunk * TC + t2) * D + h * 64 + 32 * half + r4) = *(const LAS f32x4*)(YBb + buf * TC * 32 + t2 * 32 + r4);
            };
            const int r8 = lane >> 3, kq = lane & 7, rowl = 8 * (wave & 3) + r8, srow = 32 * half + rowl;
            f32x2 S0 = (f32x2){0.f, 0.f}, S1 = S0, S2 = S0, S3 = S0;
            if (producer) {
                mu_r = *(const f32x4*)(shift_mu + chb); mu_k = *(const f32x4*)(shift_mu + 1024 + chb); mu_v = *(const f32x4*)(shift_mu + 2048 + chb);
                kkc = *(const f32x4*)(k_k + chb); kac = *(const f32x4*)(k_a + chb);
                issue(0); derive(0); issue(1);
            }
            __syncthreads();
            for (int chunk = 0; chunk < T / TC; ++chunk) {
                const int buf = chunk & 1;
                if (producer) {
                    if (chunk > 0) storeY(chunk - 1, buf ^ 1);
                    if (chunk + 1 < T / TC) { derive(buf ^ 1); if (chunk + 2 < T / TC) issue(chunk + 2); }
                } else {
                    const LAS float* V = VECb + buf * VB + 8 * kq; const LAS float* SCp = SCb + buf * TC * 2; LAS float* YBp = YBb + buf * TC * 32 + rowl;
                    const LAS float* Vv = VECb + buf * VB + 5 * TC * 64 + srow;
#define SCAN_LOAD(X, t_) const LAS float* p##X = V + (t_) * 64; \
                        f32x4 nkA##X = *(const LAS f32x4*)(p##X), nkB##X = *(const LAS f32x4*)(p##X + 4), wrA##X = *(const LAS f32x4*)(p##X + 1 * TC * 64), wrB##X = *(const LAS f32x4*)(p##X + 1 * TC * 64 + 4), \
                              wA##X = *(const LAS f32x4*)(p##X + 2 * TC * 64), wB##X = *(const LAS f32x4*)(p##X + 2 * TC * 64 + 4), bA##X = *(const LAS f32x4*)(p##X + 3 * TC * 64), bB##X = *(const LAS f32x4*)(p##X + 3 * TC * 64 + 4), \
                              kA##X = *(const LAS f32x4*)(p##X + 4 * TC * 64), kB##X = *(const LAS f32x4*)(p##X + 4 * TC * 64 + 4); float vv##X = Vv[(t_) * 64];
#define SCAN_STEP(X, t_) { const f32x2 sc = *(const LAS f32x2*)(SCp + 2 * (t_)); \
                        f32x2 da = S0 * (f32x2){nkA##X[0], nkA##X[1]}; da = S1 * (f32x2){nkA##X[2], nkA##X[3]} + da; da = S2 * (f32x2){nkB##X[0], nkB##X[1]} + da; da = S3 * (f32x2){nkB##X[2], nkB##X[3]} + da; \
                        f32x2 dz = S0 * (f32x2){wrA##X[0], wrA##X[1]}; dz = S1 * (f32x2){wrA##X[2], wrA##X[3]} + dz; dz = S2 * (f32x2){wrB##X[0], wrB##X[1]} + dz; dz = S3 * (f32x2){wrB##X[2], wrB##X[3]} + dz; \
                        float sa = da.x + da.y, z = dz.x + dz.y; \
                        sa += dppf<0xB1>(sa); z += dppf<0xB1>(z); sa += dppf<0x4E>(sa); z += dppf<0x4E>(z); sa += dppf<0x141>(sa); z += dppf<0x141>(z); \
                        const float y = z + sa * sc.x + vv##X * sc.y; const f32x2 sa2 = (f32x2){sa, sa}, vv2 = (f32x2){vv##X, vv##X}; \
                        S0 = S0 * (f32x2){wA##X[0], wA##X[1]} + (f32x2){bA##X[0], bA##X[1]} * sa2 + (f32x2){kA##X[0], kA##X[1]} * vv2; \
                        S1 = S1 * (f32x2){wA##X[2], wA##X[3]} + (f32x2){bA##X[2], bA##X[3]} * sa2 + (f32x2){kA##X[2], kA##X[3]} * vv2; \
                        S2 = S2 * (f32x2){wB##X[0], wB##X[1]} + (f32x2){bB##X[0], bB##X[1]} * sa2 + (f32x2){kB##X[0], kB##X[1]} * vv2; \
                        S3 = S3 * (f32x2){wB##X[2], wB##X[3]} + (f32x2){bB##X[2], bB##X[3]} * sa2 + (f32x2){kB##X[2], kB##X[3]} * vv2; \
                        if (kq == 0) YBp[(t_) * 32] = y; }
                    { SCAN_LOAD(a, 0)
#pragma unroll 1
                      for (int t = 0; t < TC; t += 2) {
                          SCAN_LOAD(b, t + 1)
                          __builtin_amdgcn_sched_barrier(0);
                          SCAN_STEP(a, t)
                          __builtin_amdgcn_sched_barrier(0);
                          { const LAS float* pn = V + (t + 2) * 64;
                            nkAa = *(const LAS f32x4*)(pn); nkBa = *(const LAS f32x4*)(pn + 4); wrAa = *(const LAS f32x4*)(pn + 1 * TC * 64); wrBa = *(const LAS f32x4*)(pn + 1 * TC * 64 + 4);
                            wAa = *(const LAS f32x4*)(pn + 2 * TC * 64); wBa = *(const LAS f32x4*)(pn + 2 * TC * 64 + 4); bAa = *(const LAS f32x4*)(pn + 3 * TC * 64); bBa = *(const LAS f32x4*)(pn + 3 * TC * 64 + 4);
                            kAa = *(const LAS f32x4*)(pn + 4 * TC * 64); kBa = *(const LAS f32x4*)(pn + 4 * TC * 64 + 4); vva = Vv[(t + 2) * 64]; }
                          __builtin_amdgcn_sched_barrier(0);
                          SCAN_STEP(b, t + 1)
                          __builtin_amdgcn_sched_barrier(0);
                      } }
#undef SCAN_LOAD
#undef SCAN_STEP
                }
                __syncthreads();
            }
            if (producer) storeY(T / TC - 1, 1);
            else { float* sp = out + O_PRWKV + (((size_t)b * 16 + h) * 64 + srow) * 64 + 8 * kq;
                   *(f32x4*)(sp) = (f32x4){S0.x, S0.y, S1.x, S1.y}; *(f32x4*)(sp + 4) = (f32x4){S2.x, S2.y, S3.x, S3.y}; }
            __syncthreads();
        }
        if (fin) {
            LAS float* V1 = (LAS float*)(lds + wave * 2048);
            const int cgq = lane & 15;
            for (int un = gw; un < NS * 16; un += ngw) {
                const int i = un >> 4, h = un & 15, chb = h * 64 + 4 * cgq; const size_t row = (size_t)MP + i;
                const bf16_t* base = PR + row * RP + chb; const float* sb = state_shift + (size_t)i * RP + chb;
                const f32x4 pr = unpack4(*(const u32x2*)(base)), pk = unpack4(*(const u32x2*)(base + 1024)), pv = unpack4(*(const u32x2*)(base + 2048));
                const f32x4 r = pr + (*(const f32x4*)(sb) - pr) * *(const f32x4*)(shift_mu + chb), k = pk + (*(const f32x4*)(sb + 1024) - pk) * *(const f32x4*)(shift_mu + 1024 + chb),
                            v = pv + (*(const f32x4*)(sb + 2048) - pv) * *(const f32x4*)(shift_mu + 2048 + chb);
                const f32x4 e = unpack4(*(const u32x2*)(WD + row * D + chb)), a = unpack4(*(const u32x2*)(AA + row * D + chb));
                const f32x4 w = (f32x4){__expf(-e[0]), __expf(-e[1]), __expf(-e[2]), __expf(-e[3])};
                f32x4 kk = k * *(const f32x4*)(k_k + chb); const float n2 = red16(dot4(kk, kk)); kk = kk * (1.0f / fmaxf(sqrtf(n2), 1e-12f));
                const f32x4 kp = k * (1.0f + (a - 1.0f) * *(const f32x4*)(k_a + chb)), bv = kk * a, wrv = w * r;
                const float br = red16(dot4(bv, r)), kr = red16(dot4(kp, r));
                if (lane < 16) *(LAS f32x4*)(V1 + 320 + 4 * cgq) = v;
                asm volatile("s_waitcnt lgkmcnt(0)" ::: "memory");
                const f32x4 nk = -kk;
                const size_t sbase = ((size_t)i * 16 + h) * 4096;
#pragma unroll 4
                for (int rg = 0; rg < 16; ++rg) {
                    const int srow = 4 * rg + (lane >> 4);
                    f32x4 S = *(const f32x4*)(state_rwkv + sbase + srow * 64 + 4 * cgq);
                    const float vv = V1[320 + srow];
                    const float sa = red16(dot4(S, nk)), z = red16(dot4(S, wrv));
                    const float y = z + sa * br + vv * kr;
                    S = S * w + bv * sa + kp * vv;
                    *(f32x4*)(out + O_SRWKV + sbase + srow * 64 + 4 * cgq) = S;
                    if (cgq == 0) Y[row * D + h * 64 + srow] = y;
                }
                asm volatile("s_waitcnt lgkmcnt(0)" ::: "memory");
            }
        }
        __syncthreads();
        if (fin) {
            LAS f32x2* sA = (LAS f32x2*)lds; LAS f32x2* sB = (LAS f32x2*)(lds + 4096);
            for (int unit = bx; unit < 128; unit += G) {
                const int b = unit >> 4, l32 = tid & 31, ch = (unit & 15) * 64 + 2 * l32, seg = tid >> 5, t0 = seg * 128;
                const f32x2 lam = *(const f32x2*)(lru_lambda + ch); const float sp0 = softplus_(-lam.x), sp1 = softplus_(-lam.y);
                const size_t base = ((size_t)b * T + t0) * D + ch;
                float A0 = 1.f, B0 = 0.f, A1 = 1.f, B1 = 0.f;
#pragma unroll 8
                for (int t = 0; t < 128; ++t) { const size_t o = base + (size_t)t * D;
                    const unsigned gr = *(const unsigned*)(GR + o), gi = *(const unsigned*)(GI + o), xc = *(const unsigned*)(XC + o);
                    const float la0 = -8.0f * __uint_as_float(gr << 16) * sp0, la1 = -8.0f * __uint_as_float(gr & 0xffff0000u) * sp1;
                    const float a0 = __expf(la0), a1 = __expf(la1);
                    const float b0 = sqrtf(fmaxf(1.0f - a0 * a0, 0.f)) * __uint_as_float(gi << 16) * __uint_as_float(xc << 16);
                    const float b1 = sqrtf(fmaxf(1.0f - a1 * a1, 0.f)) * __uint_as_float(gi & 0xffff0000u) * __uint_as_float(xc & 0xffff0000u);
                    A0 *= a0; B0 = a0 * B0 + b0; A1 *= a1; B1 = a1 * B1 + b1; }
                sA[seg * 32 + l32] = (f32x2){A0, A1}; sB[seg * 32 + l32] = (f32x2){B0, B1};
                __syncthreads();
                float h0 = 0.f, h1 = 0.f;
                for (int s2 = 0; s2 < seg; ++s2) { const f32x2 a = sA[s2 * 32 + l32], bb = sB[s2 * 32 + l32]; h0 = a.x * h0 + bb.x; h1 = a.y * h1 + bb.y; }
#pragma unroll 8
                for (int t = 0; t < 128; ++t) { const size_t o = base + (size_t)t * D;
                    const unsigned gr = *(const unsigned*)(GR + o), gi = *(const unsigned*)(GI + o), xc = *(const unsigned*)(XC + o), gg = *(const unsigned*)(GG + o);
                    const float la0 = -8.0f * __uint_as_float(gr << 16) * sp0, la1 = -8.0f * __uint_as_float(gr & 0xffff0000u) * sp1;
                    const float a0 = __expf(la0), a1 = __expf(la1);
                    const float b0 = sqrtf(fmaxf(1.0f - a0 * a0, 0.f)) * __uint_as_float(gi << 16) * __uint_as_float(xc << 16);
                    const float b1 = sqrtf(fmaxf(1.0f - a1 * a1, 0.f)) * __uint_as_float(gi & 0xffff0000u) * __uint_as_float(xc & 0xffff0000u);
                    h0 = a0 * h0 + b0; h1 = a1 * h1 + b1;
                    *(unsigned*)(LO + o) = cvt_pk_bf16(h0 * __uint_as_float(gg << 16), h1 * __uint_as_float(gg & 0xffff0000u)); }
                if (seg == 15) *(f32x2*)(out + O_PLRU + (size_t)b * D + ch) = (f32x2){h0, h1};
                __syncthreads();
            }
            for (int i = gt; i < NS * D; i += ngt) { const int ch = i & (D - 1); const size_t o = (size_t)MP * D + i;
                const float sp = softplus_(-lru_lambda[ch]);
                const float gr = bf2f(GR[o]), gi = bf2f(GI[o]), xc = bf2f(XC[o]), gg = bf2f(GG[o]);
                const float la = -8.0f * gr * sp, a = __expf(la), bb = sqrtf(fmaxf(-expm1f(2.0f * la), 0.f)) * gi * xc;
                const float hst = a * state_lru[i] + bb; out[O_SLRU + i] = hst; LO[o] = f2bf(hst * gg); }
        }
    } break;
    case 8: if (PHSEL(8)) { PH_IDS
        const float *state_shift = INP(6), *shift_mu = INP(16), *k_a = INP(23), *r_k = INP(24), *gn_g = INP(25), *gn_b = INP(26);
        for (int row = gw; row < MT; row += ngw) {
            const bool smp = row >= MP; const int t = row & (T - 1), si = row - MP;
#pragma unroll
            for (int j = 0; j < 4; ++j) { const int c = 256 * j + 4 * lane;
                const bf16_t* base = PR + (size_t)row * RP + c;
                const f32x4 pr = unpack4(*(const u32x2*)(base)), pk = unpack4(*(const u32x2*)(base + 1024)), pv = unpack4(*(const u32x2*)(base + 2048));
                f32x4 qr = (f32x4){0.f, 0.f, 0.f, 0.f}, qk = qr, qv = qr;
                if (smp) { const float* sb = state_shift + (size_t)si * RP + c; qr = *(const f32x4*)(sb); qk = *(const f32x4*)(sb + 1024); qv = *(const f32x4*)(sb + 2048); }
                else if (t > 0) { qr = unpack4(*(const u32x2*)(base - RP)); qk = unpack4(*(const u32x2*)(base - RP + 1024)); qv = unpack4(*(const u32x2*)(base - RP + 2048)); }
                const f32x4 r = pr + (qr - pr) * *(const f32x4*)(shift_mu + c), k = pk + (qk - pk) * *(const f32x4*)(shift_mu + 1024 + c), v = pv + (qv - pv) * *(const f32x4*)(shift_mu + 2048 + c);
                const f32x4 a = unpack4(*(const u32x2*)(AA + (size_t)row * D + c));
                const f32x4 kp = k * (1.0f + (a - 1.0f) * *(const f32x4*)(k_a + c));
                const float bon = red16(dot4(r * kp, *(const f32x4*)(r_k + c)));
                const f32x4 y = *(const f32x4*)(Y + (size_t)row * D + c);
                const float mean = red16((y.x + y.y) + (y.z + y.w)) * (1.0f / 64.0f);
                const f32x4 dy = y - mean; const float var = red16(dot4(dy, dy)) * (1.0f / 64.0f);
                const f32x4 yn = dy * (1.0f / sqrtf(var + GN_EPS)) * *(const f32x4*)(gn_g + c) + *(const f32x4*)(gn_b + c);
                const f32x4 gg = unpack4(*(const u32x2*)(GB + (size_t)row * D + c)), s0 = unpack4(*(const u32x2*)(SG0 + (size_t)row * D + c)), lo_ = unpack4(*(const u32x2*)(LO + (size_t)row * D + c));
                const f32x4 mg = s0 * ((yn + v * bon) * gg) + lo_;
                *(u32x2*)(MB + (size_t)row * D + c) = pack4(mg); }
        }
        __syncthreads();
        { LAS float* scr = (LAS float*)(lds + wave * 16384);
          constexpr int I_WI = 16 * (2 * FF / 32), I_WO = (FF / 64) * 32;
          for (int it = gw; it < I_WI + I_WO; it += ngw) { if (it < I_WI) transpose_item(INP(13), D, 2 * FF, WI, 1, scr, it, lane); else transpose_item(INP(14), FF, D, WO, 0, scr, it - I_WI, lane); } }
    } break;
    case 9: case 14: if (PHSEL(9)) { PH_IDS
        const bf16_t* Am = ph == 9 ? MB : OB; const bf16_t* Wt = ph == 9 ? WMIX : WOX;
        { pg8::Gemm g{Am, Wt, D, D, D}; pg8::Sched S; S.init(MP / 256, D / 256, G, bx, 0, D, D); pg8::EpiResid E{H, PRE, 1.0f}; pg8::gemm_phase(lds, g, S, E); }
        skinny<false>(Am, D, Wt, D, D, 0, D / 256, 0, bx, G, tid, [&](int row, int tile, int cin, f32x4 a, f32x4) {
            const size_t off = (size_t)row * D + tile * 256 + cin; *(f32x4*)(PRE + off) = *(const f32x4*)(H + off) * DN_ALPHA + a; });
    } break;
    case 11: if (PHSEL(11)) { PH_IDS
        const float qs = 0.0625f * 1.4426950408889634f;
        { pg8::Gemm g{HB, WQ, D, D, D}; pg8::Sched S; S.init(MP / 256, D / 256, G, bx, 0, D, D); pg8::EpiBf16 E{QB, D, qs}; pg8::gemm_phase(lds, g, S, E); }
        skinny<false>(HB, D, WQ, D, D, 0, D / 256, 0, bx, G, tid, [&](int row, int tile, int cin, f32x4 a, f32x4) { *(u32x2*)(QB + (size_t)row * D + tile * 256 + cin) = pack4(a * qs); });
    } break;
    case 12: if (PHSEL(12)) { PH_IDS
        const float *cache_k = INP(3), *cache_v = INP(4);
        { pg8::Gemm g{QB, KB, D, D, 256}; pg8::Sched S; S.init(MP / 256, 4, G, bx, 2, D, D); pg8::EpiSoftmax E{PB}; pg8::gemm_phase(lds, g, S, E); }
        __syncthreads();
        LAS float* sS = (LAS float*)lds;
        LAS float* sO = (LAS float*)(lds + 4096);
        for (int un = bx; un < NS * 4; un += G) {
            const int i = un >> 2, h = un & 3;
            const f32x4 q = unpack4(*(const u32x2*)(QB + (size_t)(MP + i) * D + h * 256 + 4 * lane));
            const float* kb = cache_k + ((size_t)i * 256 * 4 + h) * 256 + 4 * lane;
            const float* vb = cache_v + ((size_t)i * 256 * 4 + h) * 256 + 4 * lane;
#pragma unroll 8
            for (int mm = 0; mm < 32; ++mm) { const int m = wave * 32 + mm; const f32x4 kx = *(const f32x4*)(kb + (size_t)m * 1024);
                const float s = wave_sum(dot4(q, kx)); if (lane == 0) sS[m] = s; }
            __syncthreads();
            float mx = -3.0e38f;
#pragma unroll
            for (int j = 0; j < 4; ++j) mx = fmaxf(mx, sS[lane + 64 * j]);
            mx = wave_max(mx);
            float sum = 0.f;
#pragma unroll
            for (int j = 0; j < 4; ++j) sum += __builtin_amdgcn_exp2f(sS[lane + 64 * j] - mx);
            sum = wave_sum(sum); const float inv = 1.0f / sum;
            f32x4 o = (f32x4){0.f, 0.f, 0.f, 0.f};
#pragma unroll 8
            for (int mm = 0; mm < 32; ++mm) { const int m = wave * 32 + mm; const f32x4 vx = *(const f32x4*)(vb + (size_t)m * 1024);
                const float p = __builtin_amdgcn_exp2f(sS[m] - mx) * inv; o = o + vx * p; }
            *(LAS f32x4*)(sO + wave * 256 + 4 * lane) = o;
            __syncthreads();
            if (tid < 256) { float acc = 0.f;
#pragma unroll
                for (int w8 = 0; w8 < 8; ++w8) acc += sO[w8 * 256 + tid];
                OB[(size_t)(MP + i) * D + h * 256 + tid] = f2bf(acc); }
            __syncthreads();
        }
    } break;
    case 13: if (PHSEL(13)) { PH_IDS pg8::Gemm g{PB, VT, D, NB * 256, 256}; pg8::Sched S; S.init(MP / 256, 4, G, bx, 3, D, NB * 256); pg8::EpiBf16 E{OB, D, 1.0f}; pg8::gemm_phase(lds, g, S, E); } break;
    default: break;
    }
}

__global__ void __launch_bounds__(NTHR, 2) mega(Args args) {
    extern __shared__ __attribute__((aligned(16))) unsigned char lds_raw[];
    LAS unsigned char* lds = (LAS unsigned char*)lds_raw;
    cg::grid_group grid = cg::this_grid();
    const int G = gridDim.x, bx = blockIdx.x;
    const int lo = args.ph_lo, hi = args.ph_hi;
    unsigned* const bar = (unsigned*)args.ws;
    volatile LAS unsigned* const bst = (volatile LAS unsigned*)(lds + 131072 + 64);
    if (threadIdx.x < 2) bst[threadIdx.x] = 0u;
    if (threadIdx.x == 0) (void)xb_add(&bar[XB_XCNT(xb_xcc_id())], 1u);
    grid.sync();
#ifndef DUPK
#define DUPK -1
#endif
#define GSYNC() xcd_barrier(bar, bst)
#define RUN(k) if (lo <= (k) && (k) < hi) { if ((k) == DUPK) { run_phase<k>(args, lds, G, bx, false); GSYNC(); } run_phase<k>(args, lds, G, bx); if ((k) + 1 < hi) GSYNC(); }
    RUN(0) RUN(1) RUN(2) RUN(3) RUN(4) RUN(5) RUN(6) RUN(7) RUN(8) RUN(9) RUN(10) RUN(11) RUN(12) RUN(13) RUN(14) RUN(15) RUN(16) RUN(17) RUN(18)
#undef RUN
}

#ifndef N_LAUNCH_PER_PHASE
#define N_LAUNCH_PER_PHASE 0
#endif
extern "C" void kernel_launch(void* const* d_in, const int* in_sizes, int n_in, void* d_out, int out_size, void* d_ws, size_t ws_size, hipStream_t stream) {
    static int grid = 0;
    if (grid == 0) {
        if (n_in != 39 || out_size != (int)O_TOTAL || ws_size < WS_END) { fprintf(stderr, "kernel_launch: unexpected shapes (n_in %d out %d ws %zu)\n", n_in, out_size, ws_size); grid = -1; return; }
        int dev = 0, cus = 0, per_cu = 0;
        hipGetDevice(&dev); hipDeviceGetAttribute(&cus, hipDeviceAttributeMultiprocessorCount, dev);
        hipFuncSetAttribute((const void*)mega, hipFuncAttributeMaxDynamicSharedMemorySize, LDS_BYTES);
        hipOccupancyMaxActiveBlocksPerMultiprocessor(&per_cu, (const void*)mega, NTHR, LDS_BYTES);
        if (per_cu < 1) { fprintf(stderr, "kernel_launch: occupancy query says 0 blocks per CU\n"); grid = -1; return; }
        grid = cus;
    }
    if (grid < 0) return;
    if (hipMemsetAsync(d_ws, 0, 65536, stream) != hipSuccess) { fprintf(stderr, "kernel_launch: memset of control words failed\n"); return; }
    Args a{};
    for (int i = 0; i < 39; ++i) a.in[i] = (const float*)d_in[i];
    a.out = (float*)d_out; a.ws = (unsigned char*)d_ws;
#if N_LAUNCH_PER_PHASE
    for (int p = 0; p < 19; ++p) { a.ph_lo = p; a.ph_hi = p + 1; void* kargs[] = {&a};
        hipLaunchCooperativeKernel((const void*)mega, dim3(grid), dim3(NTHR), kargs, LDS_BYTES, stream); }
#else
    a.ph_lo = 0; a.ph_hi = 19; void* kargs[] = {&a};
    hipError_t e = hipLaunchCooperativeKernel((const void*)mega, dim3(grid), dim3(NTHR), kargs, LDS_BYTES, stream);
    if (e != hipSuccess) fprintf(stderr, "cooperative launch failed: %s (grid %d)\n", hipGetErrorString(e), grid);
#endif
}
```

```cpp
#include <hip/hip_runtime.h>
#include <hip/hip_cooperative_groups.h>
#include <cstdio>
#include <cstdint>
namespace cg = cooperative_groups;

#define LAS __attribute__((address_space(3)))
typedef unsigned short bf16_t;
typedef short bf16x8 __attribute__((ext_vector_type(8)));
typedef float f32x4 __attribute__((ext_vector_type(4)));
typedef float f32x2 __attribute__((ext_vector_type(2)));
typedef unsigned u32x4 __attribute__((ext_vector_type(4)));
typedef unsigned u32x2 __attribute__((ext_vector_type(2)));

constexpr int D = 1024, T = 2048, NB = 8, MP = NB * T, NS = 128, MT = MP + NS, FF = 2816, RP = 3328, PW = 7424;
constexpr int NWAVES = 8, NTHR = 512;
constexpr float DN_ALPHA = 1.189207115002721f;
constexpr float LN_EPS = 1e-5f, GN_EPS = 64e-5f;

constexpr size_t MiB = 1u << 20;
constexpr size_t WS_WI = 1 * MiB, WS_WO = 12 * MiB, WS_WIN = 19 * MiB, WS_WMIX = 34 * MiB, WS_WQ = 36 * MiB, WS_WOX = 38 * MiB, WS_WKV = 40 * MiB,
                 WS_LORAT = 44 * MiB, WS_LRUT = 46 * MiB, WS_MEMB = 47 * MiB, WS_KB = 51 * MiB, WS_VT = 55 * MiB, WS_HB = 60 * MiB, WS_PRE = 93 * MiB,
                 WS_PR = 158 * MiB, WS_PL = 263 * MiB, WS_GG = 296 * MiB, WS_SG0 = 329 * MiB, WS_GI = 362 * MiB, WS_WD = 395 * MiB, WS_AA = 428 * MiB,
                 WS_G = 461 * MiB, WS_L = 494 * MiB, WS_END = 503 * MiB;
static_assert(WS_G - WS_AA == WS_AA - WS_WD, "WD/AA/G spacing");
static_assert((size_t)MT * RP * 2 <= 105 * MiB && (size_t)MT * D * 2 <= 33 * MiB && (size_t)MT * D * 4 <= 65 * MiB && (size_t)MT * 256 * 2 <= 9 * MiB, "ws map");
constexpr size_t O_YP = 0, O_YS = 16777216, O_PMK = 16908288, O_PMV = 19005440, O_PRWKV = 21102592, O_PSHIFT = 21626880, O_PLRU = 21653504,
                 O_PCONV = 21661696, O_SRWKV = 21686272, O_SSHIFT = 30074880, O_SLRU = 30500864, O_SCONV = 30631936, O_TOTAL = 31025152;

constexpr int LDS_BYTES = 139264;

typedef __bf16 bf16x2_t __attribute__((ext_vector_type(2)));
__device__ __forceinline__ unsigned cvt_pk_bf16(float lo, float hi) { const f32x2 v = {lo, hi}; return __builtin_bit_cast(unsigned, __builtin_convertvector(v, bf16x2_t)); }
__device__ __forceinline__ bf16_t f2bf(float f) { return (bf16_t)(cvt_pk_bf16(f, 0.f) & 0xffffu); }
__device__ __forceinline__ float bf2f(bf16_t h) { return __uint_as_float(((unsigned)h) << 16); }
__device__ __forceinline__ f32x4 unpack4(u32x2 u) { return (f32x4){__uint_as_float(u.x << 16), __uint_as_float(u.x & 0xffff0000u), __uint_as_float(u.y << 16), __uint_as_float(u.y & 0xffff0000u)}; }
__device__ __forceinline__ u32x2 pack4(f32x4 v) { u32x2 r; r.x = cvt_pk_bf16(v.x, v.y); r.y = cvt_pk_bf16(v.z, v.w); return r; }
__device__ __forceinline__ float sigm(float x) { return 1.0f / (1.0f + __expf(-x)); }
__device__ __forceinline__ float silu(float x) { return x * sigm(x); }
__device__ __forceinline__ float tanh_(float x) { float e = __expf(2.0f * x); return 1.0f - 2.0f / (e + 1.0f); }
__device__ __forceinline__ float gelu_t(float x) { float u = 0.7978845608028654f * (x + 0.044715f * x * x * x); return 0.5f * x * (1.0f + tanh_(u)); }
__device__ __forceinline__ float softplus_(float x) { return x > 20.f ? x : log1pf(expf(x)); }
__device__ __forceinline__ float decay_e(float pre) { return 0.6065306597126334f * sigm(pre); }
template <int CTRL> __device__ __forceinline__ float dppf(float x) { return __builtin_bit_cast(float, __builtin_amdgcn_update_dpp(0, __builtin_bit_cast(int, x), CTRL, 0xf, 0xf, true)); }
__device__ __forceinline__ float red16(float x) {
    x += dppf<0xB1>(x); x += dppf<0x4E>(x); x += dppf<0x141>(x); x += dppf<0x140>(x); return x;
}
__device__ __forceinline__ int opaque(int x) { asm volatile("" : "+v"(x)); return x; }
__device__ __forceinline__ float dot4(f32x4 a, f32x4 b) { return (a.x * b.x + a.y * b.y) + (a.z * b.z + a.w * b.w); }
__device__ __forceinline__ float wave_sum(float v) {
#pragma unroll
    for (int o = 1; o < 64; o <<= 1) v += __shfl_xor(v, o);
    return v;
}
__device__ __forceinline__ float wave_max(float v) {
#pragma unroll
    for (int o = 1; o < 64; o <<= 1) v = fmaxf(v, __shfl_xor(v, o));
    return v;
}

namespace pg8 {
constexpr int BM = 256, BK = 64, HALF = 128, HTB = HALF * BK * 2, STAGE_BYTES = 8 * HTB, NXCD = 8, WGM = 8;
__host__ __device__ __forceinline__ int lds_byte(int r, int c) { const int st = (r >> 4) * 2 + (c >> 5), rr = r & 15, cc = c & 31, ob = rr * 64 + cc * 2; return st * 1024 + (ob ^ (((ob >> 9) & 1) << 5)); }
__host__ __device__ __forceinline__ void stage_rc(int b, int& R, int& C) { const int st = b / 1024, sb = b % 1024, swz = sb ^ (((sb >> 9) & 1) << 5); R = (st >> 1) * 16 + swz / 64; C = (st & 1) * 32 + (swz % 64) / 2; }
__host__ __device__ __forceinline__ int perm32(int rho) { const int n = rho >> 4, i = rho & 15; return 8 * (i >> 2) + 4 * n + (i & 3); }

struct Unit { int pm, pn; };
struct Gemm { const bf16_t* A; const bf16_t* Bt; int lda, ldb, K; };

struct Sched {
    int nM, nN, nwg, G, c, mode;
    long lda, ldb;
    __device__ void init(int nM_, int nN_, int G_, int c_, int mode_, int lda_, int ldb_) { nM = nM_; nN = nN_; nwg = nM * nN; G = G_; c = c_; mode = mode_; lda = lda_; ldb = ldb_; }
    __device__ bool next(int i, Unit& u) const {
        const int L = i * G + c; if (L >= nwg) return false;
        int wgid = L; { const int q = nwg / NXCD, r = nwg % NXCD, xcd = wgid % NXCD, off = wgid / NXCD; wgid = (xcd < r ? xcd * (q + 1) : r * (q + 1) + (xcd - r) * q) + off; }
        const int nig = WGM * nN, gid = wgid / nig, fm = gid * WGM, gsz = (nM - fm) < WGM ? (nM - fm) : WGM;
        u.pm = fm + ((wgid % nig) % gsz); u.pn = (wgid % nig) / gsz; return true;
    }
    __device__ __forceinline__ long aoff(const Unit& u) const {
        long o = (long)u.pm * 256 * lda;
        if (mode == 1) o += 256 * (u.pn >> 1); else if (mode >= 2) o += u.pn * 256;
        return o;
    }
    __device__ __forceinline__ long boff(const Unit& u) const {
        if (mode == 2) return (long)(u.pm >> 3) * 256 * ldb + u.pn * 256;
        if (mode == 3) return (long)u.pn * 256 * ldb + (u.pm >> 3) * 256;
        return (long)u.pn * 256 * ldb;
    }
};

template <class Epi>
__device__ __forceinline__ void gemm_phase(LAS unsigned char* lds, const Gemm g, const Sched& S, const Epi& E) {
    const int tid = opaque(threadIdx.x), wid = __builtin_amdgcn_readfirstlane(tid >> 6), lane = tid & 63, wr = wid >> 2, wc = wid & 3, fr = lane & 15, fq = lane >> 4;
    const int K = g.K, nt = K / BK;
    unsigned voffA[2], voffB[2];
#pragma unroll
    for (int i = 0; i < 2; ++i) { int R, C; stage_rc(tid * 16 + i * 8192, R, C); const int Rb = Epi::PERM ? ((R & ~31) + perm32(R & 31)) : R;
        voffA[i] = (unsigned)(R * g.lda + C) * 2u; voffB[i] = (unsigned)(Rb * g.ldb + C) * 2u; }
    const size_t kstep = (size_t)(BK * 2);
    const size_t hstepA = (size_t)HALF * g.lda * 2, hstepB = (size_t)HALF * g.ldb * 2;
    const unsigned ldsw = (unsigned)wid * 1024u;
    const int aoff = lds_byte(wr * 64 + fr, fq * 8), boff = lds_byte(wc * 32 + fr, fq * 8);
#define PG8_SA(b, h) (((b) * 2 + (h)) * HTB)
#define PG8_SB(b, h) ((4 + (b) * 2 + (h)) * HTB)
#define PG8_STAGE(bufoff, gbase, voff) do { _Pragma("unroll") for (int _i = 0; _i < 2; ++_i) \
        __builtin_amdgcn_global_load_lds((const unsigned*)((const char*)(gbase) + (voff)[_i]), (LAS unsigned*)(lds + (bufoff) + ldsw + _i * 8192), 16, 0, 0); } while (0)
#define PG8_LDA(dst, b, h) do { _Pragma("unroll") for (int m = 0; m < 4; ++m) _Pragma("unroll") for (int k = 0; k < 2; ++k) dst[m][k] = *(const LAS bf16x8*)(lds + PG8_SA(b, h) + aoff + m * 2048 + k * 1024); } while (0)
#define PG8_LDB(dst, b, h) do { _Pragma("unroll") for (int n = 0; n < 2; ++n) _Pragma("unroll") for (int k = 0; k < 2; ++k) dst[n][k] = *(const LAS bf16x8*)(lds + PG8_SB(b, h) + boff + n * 2048 + k * 1024); } while (0)
#define PG8_MMA(ai, bj, At, Bt) do { __builtin_amdgcn_s_setprio(1); _Pragma("unroll") for (int m = 0; m < 4; ++m) _Pragma("unroll") for (int n = 0; n < 2; ++n) _Pragma("unroll") for (int k = 0; k < 2; ++k) \
        acc[ai][bj][m][n] = __builtin_amdgcn_mfma_f32_16x16x32_bf16(Bt[n][k], At[m][k], acc[ai][bj][m][n], 0, 0, 0); __builtin_amdgcn_s_setprio(0); } while (0)
#define PG8_WAIT_V(n) asm volatile("s_waitcnt vmcnt(" #n ")" ::: "memory")
#define PG8_WAIT_L(n) asm volatile("s_waitcnt lgkmcnt(" #n ")" ::: "memory")
#define PG8_BAR __builtin_amdgcn_s_barrier()
#define PG8_SCHED __builtin_amdgcn_sched_barrier(0)
    Unit cur, nxt; int ui = 0;
    if (!S.next(0, cur)) return;
    f32x4 acc[2][2][4][2];
#pragma unroll
    for (int a = 0; a < 2; ++a)
#pragma unroll
        for (int b = 0; b < 2; ++b)
#pragma unroll
            for (int m = 0; m < 4; ++m)
#pragma unroll
                for (int n = 0; n < 2; ++n) acc[a][b][m][n] = (f32x4){0.f, 0.f, 0.f, 0.f};
    bf16x8 At[4][2], B0[2][2], B1[2][2];
    const char* cA = (const char*)g.A + (size_t)S.aoff(cur) * 2; const char* cB = (const char*)g.Bt + (size_t)S.boff(cur) * 2;
    PG8_STAGE(PG8_SB(0, 0), cB, voffB); PG8_STAGE(PG8_SB(0, 1), cB + hstepB, voffB); PG8_STAGE(PG8_SA(0, 0), cA, voffA); PG8_STAGE(PG8_SA(0, 1), cA + hstepA, voffA);
    if (wr == 1) PG8_BAR;
    PG8_WAIT_V(2); PG8_BAR;
    PG8_STAGE(PG8_SB(1, 0), cB + kstep, voffB); PG8_STAGE(PG8_SA(1, 0), cA + kstep, voffA); PG8_STAGE(PG8_SB(1, 1), cB + hstepB + kstep, voffB);
    PG8_WAIT_V(6); PG8_BAR;
    for (;;) {
        const bool has_next = S.next(ui + 1, nxt);
        const char* nA = has_next ? (const char*)g.A + (size_t)S.aoff(nxt) * 2 : cA; const char* nB = has_next ? (const char*)g.Bt + (size_t)S.boff(nxt) * 2 : cB;
        _Pragma("nounroll")
        for (int t = 0; t < nt; t += 2) {
            const bool last = (t == nt - 2);
            const char* a1 = cA + (size_t)(t + 1) * kstep;
            const char* a2 = last ? nA : cA + (size_t)(t + 2) * kstep; const char* b2 = last ? nB : cB + (size_t)(t + 2) * kstep;
            const char* a3 = a2 + kstep; const char* b3 = b2 + kstep;
            PG8_LDB(B0, 0, 0); PG8_LDB(B1, 0, 1); PG8_SCHED; PG8_LDA(At, 0, 0); PG8_STAGE(PG8_SA(1, 1), a1 + hstepA, voffA);
            PG8_WAIT_V(8); PG8_WAIT_L(0); PG8_BAR; PG8_MMA(0, 0, At, B0); PG8_MMA(0, 1, At, B1); PG8_BAR; PG8_SCHED;
            PG8_LDA(At, 0, 1); PG8_STAGE(PG8_SB(0, 0), b2, voffB); PG8_STAGE(PG8_SB(0, 1), b2 + hstepB, voffB); PG8_STAGE(PG8_SA(0, 0), a2, voffA);
            PG8_WAIT_V(8); PG8_WAIT_L(0); PG8_BAR; PG8_MMA(1, 0, At, B0); PG8_MMA(1, 1, At, B1); PG8_BAR; PG8_SCHED;
            PG8_LDB(B0, 1, 0); PG8_LDB(B1, 1, 1); PG8_SCHED; PG8_LDA(At, 1, 0); PG8_STAGE(PG8_SA(0, 1), a2 + hstepA, voffA);
            PG8_WAIT_V(8); PG8_WAIT_L(0); PG8_BAR; PG8_MMA(0, 0, At, B0); PG8_MMA(0, 1, At, B1); PG8_BAR; PG8_SCHED;
            PG8_LDA(At, 1, 1); PG8_STAGE(PG8_SB(1, 0), b3, voffB); PG8_STAGE(PG8_SB(1, 1), b3 + hstepB, voffB); PG8_STAGE(PG8_SA(1, 0), a3, voffA);
            PG8_WAIT_V(8); PG8_WAIT_L(0); PG8_BAR; PG8_MMA(1, 0, At, B0); PG8_MMA(1, 1, At, B1); PG8_BAR; PG8_SCHED;
        }
        if (wr == 0) PG8_BAR;
        if constexpr (!Epi::AFTER_DRAIN) { E(acc, cur, wr, wc, fr, fq); }
        if (!has_next) break;
#pragma unroll
        for (int a = 0; a < 2; ++a)
#pragma unroll
            for (int b = 0; b < 2; ++b)
#pragma unroll
                for (int m = 0; m < 4; ++m)
#pragma unroll
                    for (int n = 0; n < 2; ++n) acc[a][b][m][n] = (f32x4){0.f, 0.f, 0.f, 0.f};
        cur = nxt; cA = nA; cB = nB; ++ui;
        if (wr == 1) PG8_BAR;
    }
    PG8_WAIT_V(0);
    PG8_BAR;
    if constexpr (Epi::AFTER_DRAIN) { E.fused(acc, cur, wr, wc, fr, fq, lds, wid, lane); }
#undef PG8_SA
#undef PG8_SB
#undef PG8_STAGE
#undef PG8_LDA
#undef PG8_LDB
#undef PG8_MMA
#undef PG8_WAIT_V
#undef PG8_WAIT_L
#undef PG8_BAR
#undef PG8_SCHED
}

#define EPI_ROWS(ai, m) (u.pm * BM + (ai) * HALF + wr * 64 + (m) * 16 + fr)
typedef const f32x4 (&AccRef)[2][2][4][2];

struct EpiSwiglu {
    static constexpr bool PERM = true, AFTER_DRAIN = false;
    bf16_t* O;
    __device__ __forceinline__ void operator()(AccRef acc, const Unit& u, int wr, int wc, int fr, int fq) const {
        const int col0 = u.pn * 128 + wc * 32 + 8 * fq;
#pragma unroll
        for (int ai = 0; ai < 2; ++ai)
#pragma unroll
            for (int m = 0; m < 4; ++m) {
                const f32x4 g0 = acc[ai][0][m][0], g1 = acc[ai][0][m][1], u0 = acc[ai][1][m][0], u1 = acc[ai][1][m][1];
                u32x4 w;
                w.x = cvt_pk_bf16(silu(g0[0]) * u0[0], silu(g0[1]) * u0[1]); w.y = cvt_pk_bf16(silu(g0[2]) * u0[2], silu(g0[3]) * u0[3]);
                w.z = cvt_pk_bf16(silu(g1[0]) * u1[0], silu(g1[1]) * u1[1]); w.w = cvt_pk_bf16(silu(g1[2]) * u1[2], silu(g1[3]) * u1[3]);
                *(u32x4*)(O + (size_t)EPI_ROWS(ai, m) * FF + col0) = w;
            }
    }
};
struct EpiBf16 {
    static constexpr bool PERM = true, AFTER_DRAIN = false;
    bf16_t* O; int ldc; float scale;
    __device__ __forceinline__ void operator()(AccRef acc, const Unit& u, int wr, int wc, int fr, int fq) const {
        const int col0 = u.pn * BM + wc * 32 + 8 * fq;
#pragma unroll
        for (int ai = 0; ai < 2; ++ai)
#pragma unroll
            for (int m = 0; m < 4; ++m) { bf16_t* rowp = O + (size_t)EPI_ROWS(ai, m) * ldc + col0;
#pragma unroll
                for (int bj = 0; bj < 2; ++bj) { const f32x4 v0 = acc[ai][bj][m][0] * scale, v1 = acc[ai][bj][m][1] * scale;
                    u32x4 w; w.x = cvt_pk_bf16(v0[0], v0[1]); w.y = cvt_pk_bf16(v0[2], v0[3]); w.z = cvt_pk_bf16(v1[0], v1[1]); w.w = cvt_pk_bf16(v1[2], v1[3]);
                    *(u32x4*)(rowp + bj * HALF) = w; } }
    }
};
struct EpiProj {
    static constexpr bool PERM = true, AFTER_DRAIN = false;
    bf16_t *PR, *PL, *GG, *SG0;
    __device__ __forceinline__ void operator()(AccRef acc, const Unit& u, int wr, int wc, int fr, int fq) const {
        const int pn = u.pn, cw = wc * 32 + 8 * fq;
        if (pn >= 17 && pn < 25) {
            const int col0 = (pn - 17) * 128 + cw;
#pragma unroll
            for (int ai = 0; ai < 2; ++ai)
#pragma unroll
                for (int m = 0; m < 4; ++m) {
                    const f32x4 g0 = acc[ai][0][m][0], g1 = acc[ai][0][m][1], s0 = acc[ai][1][m][0], s1 = acc[ai][1][m][1];
                    u32x4 w;
                    w.x = cvt_pk_bf16(gelu_t(g0[0]) * sigm(s0[0]), gelu_t(g0[1]) * sigm(s0[1])); w.y = cvt_pk_bf16(gelu_t(g0[2]) * sigm(s0[2]), gelu_t(g0[3]) * sigm(s0[3]));
                    w.z = cvt_pk_bf16(gelu_t(g1[0]) * sigm(s1[0]), gelu_t(g1[1]) * sigm(s1[1])); w.w = cvt_pk_bf16(gelu_t(g1[2]) * sigm(s1[2]), gelu_t(g1[3]) * sigm(s1[3]));
                    *(u32x4*)(GG + (size_t)EPI_ROWS(ai, m) * D + col0) = w;
                }
        } else {
            bf16_t* base; int ldc, colt; bool sg = false;
            if (pn < 13) { base = PR; ldc = RP; colt = pn * 256; } else { ldc = D; sg = pn >= 17; colt = ((pn - 13) & 3) * 256; base = sg ? SG0 : PL; }
#pragma unroll
            for (int ai = 0; ai < 2; ++ai)
#pragma unroll
                for (int m = 0; m < 4; ++m) { bf16_t* rowp = base + (size_t)EPI_ROWS(ai, m) * ldc + colt + cw;
#pragma unroll
                    for (int bj = 0; bj < 2; ++bj) { f32x4 v0 = acc[ai][bj][m][0], v1 = acc[ai][bj][m][1];
                        if (sg) { v0 = (f32x4){sigm(v0[0]), sigm(v0[1]), sigm(v0[2]), sigm(v0[3])}; v1 = (f32x4){sigm(v1[0]), sigm(v1[1]), sigm(v1[2]), sigm(v1[3])}; }
                        u32x4 w; w.x = cvt_pk_bf16(v0[0], v0[1]); w.y = cvt_pk_bf16(v0[2], v0[3]); w.z = cvt_pk_bf16(v1[0], v1[1]); w.w = cvt_pk_bf16(v1[2], v1[3]);
                        *(u32x4*)(rowp + bj * HALF) = w; } }
        }
    }
};
struct EpiResid {
    static constexpr bool PERM = false, AFTER_DRAIN = false;
    const float* base; float* out; float s;
    __device__ __forceinline__ void operator()(AccRef acc, const Unit& u, int wr, int wc, int fr, int fq) const {
        const int col0 = u.pn * BM + wc * 32 + 4 * fq;
#pragma unroll
        for (int ai = 0; ai < 2; ++ai)
#pragma unroll
            for (int m = 0; m < 4; ++m) { const size_t off = (size_t)EPI_ROWS(ai, m) * D + col0;
#pragma unroll
                for (int bj = 0; bj < 2; ++bj)
#pragma unroll
                    for (int n = 0; n < 2; ++n) { const f32x4 b = *(const f32x4*)(base + off + bj * HALF + n * 16);
                        *(f32x4*)(out + off + bj * HALF + n * 16) = b * DN_ALPHA + acc[ai][bj][m][n] * s; } }
    }
};
struct EpiKV {
    static constexpr bool PERM = false, AFTER_DRAIN = false;
    float *ok, *ov; bf16_t* KB;
    __device__ __forceinline__ void operator()(AccRef acc, const Unit& u, int wr, int wc, int fr, int fq) const {
        const bool isk = u.pn < 4; float* o = isk ? ok : ov; const int col0 = (u.pn & 3) * BM + wc * 32 + 4 * fq;
#pragma unroll
        for (int ai = 0; ai < 2; ++ai)
#pragma unroll
            for (int m = 0; m < 4; ++m) { const size_t off = (size_t)EPI_ROWS(ai, m) * D + col0;
#pragma unroll
                for (int bj = 0; bj < 2; ++bj)
#pragma unroll
                    for (int n = 0; n < 2; ++n) { const f32x4 v = acc[ai][bj][m][n]; *(f32x4*)(o + off + bj * HALF + n * 16) = v;
                        if (isk) *(u32x2*)(KB + off + bj * HALF + n * 16) = pack4(v); } }
    }
};
struct EpiLora {
    static constexpr bool PERM = true, AFTER_DRAIN = false;
    bf16_t *WD, *AA, *G; const float *w0, *a0;
    __device__ __forceinline__ void operator()(AccRef acc, const Unit& u, int wr, int wc, int fr, int fq) const {
        const int kind = u.pn >> 2, colt = (u.pn & 3) * 256 + wc * 32 + 8 * fq;
        bf16_t* base = WD + (size_t)kind * ((WS_AA - WS_WD) / 2);
        const float* bias = kind == 0 ? w0 : a0;
#pragma unroll
        for (int bj = 0; bj < 2; ++bj) {
            f32x4 b0 = (f32x4){0.f, 0.f, 0.f, 0.f}, b1 = b0;
            if (kind < 2) { b0 = *(const f32x4*)(bias + colt + bj * HALF); b1 = *(const f32x4*)(bias + colt + bj * HALF + 4); }
#pragma unroll
            for (int ai = 0; ai < 2; ++ai)
#pragma unroll
                for (int m = 0; m < 4; ++m) { f32x4 v0 = acc[ai][bj][m][0] + b0, v1 = acc[ai][bj][m][1] + b1;
                    if (kind == 0) { v0 = (f32x4){decay_e(v0[0]), decay_e(v0[1]), decay_e(v0[2]), decay_e(v0[3])}; v1 = (f32x4){decay_e(v1[0]), decay_e(v1[1]), decay_e(v1[2]), decay_e(v1[3])}; }
                    else if (kind == 1) { v0 = (f32x4){sigm(v0[0]), sigm(v0[1]), sigm(v0[2]), sigm(v0[3])}; v1 = (f32x4){sigm(v1[0]), sigm(v1[1]), sigm(v1[2]), sigm(v1[3])}; }
                    u32x4 w; w.x = cvt_pk_bf16(v0[0], v0[1]); w.y = cvt_pk_bf16(v0[2], v0[3]); w.z = cvt_pk_bf16(v1[0], v1[1]); w.w = cvt_pk_bf16(v1[2], v1[3]);
                    *(u32x4*)(base + (size_t)EPI_ROWS(ai, m) * D + colt + bj * HALF) = w; }
        }
    }
};
struct EpiLru {
    static constexpr bool PERM = true, AFTER_DRAIN = false;
    bf16_t *GR, *GI; const float *br, *bi;
    __device__ __forceinline__ void operator()(AccRef acc, const Unit& u, int wr, int wc, int fr, int fq) const {
        const int col0 = u.pn * 128 + wc * 32 + 8 * fq;
#pragma unroll
        for (int bj = 0; bj < 2; ++bj) {
            const float* bias = bj ? bi : br; bf16_t* base = bj ? GI : GR;
            const f32x4 b0 = *(const f32x4*)(bias + col0), b1 = *(const f32x4*)(bias + col0 + 4);
#pragma unroll
            for (int ai = 0; ai < 2; ++ai)
#pragma unroll
                for (int m = 0; m < 4; ++m) { const f32x4 v0 = acc[ai][bj][m][0] + b0, v1 = acc[ai][bj][m][1] + b1;
                    u32x4 w; w.x = cvt_pk_bf16(sigm(v0[0]), sigm(v0[1])); w.y = cvt_pk_bf16(sigm(v0[2]), sigm(v0[3])); w.z = cvt_pk_bf16(sigm(v1[0]), sigm(v1[1])); w.w = cvt_pk_bf16(sigm(v1[2]), sigm(v1[3]));
                    *(u32x4*)(base + (size_t)EPI_ROWS(ai, m) * D + col0) = w; }
        }
    }
};
struct EpiSoftmax {
    static constexpr bool PERM = true, AFTER_DRAIN = true;
    bf16_t* P;
    __device__ __forceinline__ void fused(f32x4 (&acc)[2][2][4][2], const Unit& u, int wr, int wc, int fr, int fq, LAS unsigned char* lds, int wid, int lane) const {
        LAS float* MX = (LAS float*)lds;
        LAS float* SM = (LAS float*)(lds + 4096);
#pragma unroll
        for (int ai = 0; ai < 2; ++ai)
#pragma unroll
            for (int m = 0; m < 4; ++m) {
                float mx = -3.0e38f;
#pragma unroll
                for (int bj = 0; bj < 2; ++bj)
#pragma unroll
                    for (int n = 0; n < 2; ++n) { const f32x4 x = acc[ai][bj][m][n]; mx = fmaxf(mx, fmaxf(fmaxf(x[0], x[1]), fmaxf(x[2], x[3]))); }
                mx = fmaxf(mx, __shfl_xor(mx, 16)); mx = fmaxf(mx, __shfl_xor(mx, 32));
                if (fq == 0) MX[(ai * HALF + wr * 64 + m * 16 + fr) * 4 + wc] = mx;
            }
        __syncthreads();
#pragma unroll
        for (int ai = 0; ai < 2; ++ai)
#pragma unroll
            for (int m = 0; m < 4; ++m) {
                const int rl = ai * HALF + wr * 64 + m * 16 + fr;
                const f32x4 mm = *(const LAS f32x4*)(MX + rl * 4);
                const float mx = fmaxf(fmaxf(mm[0], mm[1]), fmaxf(mm[2], mm[3]));
                float s = 0.f;
#pragma unroll
                for (int bj = 0; bj < 2; ++bj)
#pragma unroll
                    for (int n = 0; n < 2; ++n) { f32x4 x = acc[ai][bj][m][n];
                        x = (f32x4){__builtin_amdgcn_exp2f(x[0] - mx), __builtin_amdgcn_exp2f(x[1] - mx), __builtin_amdgcn_exp2f(x[2] - mx), __builtin_amdgcn_exp2f(x[3] - mx)};
                        acc[ai][bj][m][n] = x; s += (x[0] + x[1]) + (x[2] + x[3]); }
                s += __shfl_xor(s, 16); s += __shfl_xor(s, 32);
                if (fq == 0) SM[rl * 4 + wc] = s;
            }
        __syncthreads();
        const int col0 = u.pn * BM + wc * 32 + 8 * fq;
#pragma unroll
        for (int ai = 0; ai < 2; ++ai)
#pragma unroll
            for (int m = 0; m < 4; ++m) {
                const int rl = ai * HALF + wr * 64 + m * 16 + fr;
                const f32x4 ss = *(const LAS f32x4*)(SM + rl * 4);
                const float inv = 1.0f / ((ss[0] + ss[1]) + (ss[2] + ss[3]));
                bf16_t* rowp = P + (size_t)(u.pm * BM + rl) * D + col0;
#pragma unroll
                for (int bj = 0; bj < 2; ++bj) { const f32x4 v0 = acc[ai][bj][m][0] * inv, v1 = acc[ai][bj][m][1] * inv;
                    u32x4 w; w.x = cvt_pk_bf16(v0[0], v0[1]); w.y = cvt_pk_bf16(v0[2], v0[3]); w.z = cvt_pk_bf16(v1[0], v1[1]); w.w = cvt_pk_bf16(v1[2], v1[3]);
                    *(u32x4*)(rowp + bj * HALF) = w; }
            }
        __syncthreads();
    }
};
}

template <bool PAIR, class F>
__device__ __forceinline__ void skinny(const bf16_t* A, int lda, const bf16_t* Bt, int ldb, int K, int tile_lo, int tile_hi, int kmode, int bx, int G, int tid_, F f) {
    const int tid = opaque(tid_), lane = tid & 63, w = __builtin_amdgcn_readfirstlane(tid >> 6), fr = lane & 15, fq = lane >> 4;
    constexpr int GPT = PAIR ? 2 : 4;
    const int nunits = (tile_hi - tile_lo) * GPT * 4;
    for (int un = G - 1 - bx; un < nunits; un += G) {
        const int rbp = un & 3, cgrp = un >> 2, tile = tile_lo + cgrp / GPT, cgp = (cgrp % GPT) * 4 + (w & 3), rb = rbp * 2 + (w >> 2);
        const int n0 = tile * 256 + cgp * 16, row = MP + rb * 16 + fr;
        const bf16_t* ap = A + (size_t)row * lda + (kmode ? 256 * (tile >> 1) : 0) + fq * 8;
        const bf16_t* bp = Bt + (size_t)(n0 + fr) * ldb + fq * 8;
        f32x4 acc0 = (f32x4){0.f, 0.f, 0.f, 0.f}, acc1 = acc0;
        for (int k0 = 0; k0 < K; k0 += 256) {
#pragma unroll
            for (int kk = 0; kk < 256; kk += 32) {
                const bf16x8 a = *(const bf16x8*)(ap + k0 + kk), b = *(const bf16x8*)(bp + k0 + kk);
                acc0 = __builtin_amdgcn_mfma_f32_16x16x32_bf16(b, a, acc0, 0, 0, 0);
                if (PAIR) { const bf16x8 b2 = *(const bf16x8*)(bp + (size_t)128 * ldb + k0 + kk); acc1 = __builtin_amdgcn_mfma_f32_16x16x32_bf16(b2, a, acc1, 0, 0, 0); }
            }
        }
        f(row, tile, cgp * 16 + 4 * fq, acc0, acc1);
    }
}

__device__ __forceinline__ int map_row(int mapmode, int n) {
    if (mapmode == 1) { if (n < FF) return 256 * (n / 128) + (n % 128); const int q = n - FF; return 256 * (q / 128) + 128 + (q % 128); }
    if (mapmode == 2) { if (n < 4352) return n; if (n < 5376) { const int q = n - 4352; return 256 * (17 + q / 128) + (q % 128); }
                        if (n < 6400) return 256 * 25 + (n - 5376); const int q = n - 6400; return 256 * (17 + q / 128) + 128 + (q % 128); }
    return n;
}
__device__ __forceinline__ void transpose_item(const float* W, int K, int N, bf16_t* WT, int mapmode, LAS float* scr, int item, int lane) {
    const int nblk = N / 32, kb = item / nblk, nb = item % nblk, k0 = 64 * kb, n0 = 32 * nb;
#pragma unroll 8
    for (int i = 0; i < 32; ++i) { const int kk = 2 * i + (lane >> 5); scr[kk * 33 + (lane & 31)] = W[(size_t)(k0 + kk) * N + n0 + (lane & 31)]; }
    asm volatile("s_waitcnt lgkmcnt(0)" ::: "memory");
    const int c = lane & 7, d0 = map_row(mapmode, n0);
#pragma unroll
    for (int j = 0; j < 4; ++j) { const int n = (lane >> 3) + 8 * j; const LAS float* s = scr + (8 * c) * 33 + n;
        u32x4 o; o.x = cvt_pk_bf16(s[0 * 33], s[1 * 33]); o.y = cvt_pk_bf16(s[2 * 33], s[3 * 33]); o.z = cvt_pk_bf16(s[4 * 33], s[5 * 33]); o.w = cvt_pk_bf16(s[6 * 33], s[7 * 33]);
        *(u32x4*)(WT + (size_t)(d0 + n) * K + k0 + 8 * c) = o; }
    asm volatile("s_waitcnt lgkmcnt(0)" ::: "memory");
}

struct Args { const float* in[39]; float* out; unsigned char* ws; int ph_lo, ph_hi; };

__device__ __forceinline__ void ln_pass(const float* PRE, const float* g, const float* b, float* H, bf16_t* HB, int gw, int ngw, int lane) {
    f32x4 gv[4], bv[4];
#pragma unroll
    for (int j = 0; j < 4; ++j) { gv[j] = *(const f32x4*)(g + 256 * j + 4 * lane); bv[j] = *(const f32x4*)(b + 256 * j + 4 * lane); }
    for (int row = gw; row < MT; row += ngw) {
        const float* p = PRE + (size_t)row * D + 4 * lane;
        f32x4 v[4]; float s = 0.f;
#pragma unroll
        for (int j = 0; j < 4; ++j) { v[j] = *(const f32x4*)(p + 256 * j); s += (v[j].x + v[j].y) + (v[j].z + v[j].w); }
        const float mean = wave_sum(s) * (1.f / D); float s2 = 0.f;
#pragma unroll
        for (int j = 0; j < 4; ++j) { v[j] = v[j] - mean; s2 += (v[j].x * v[j].x + v[j].y * v[j].y) + (v[j].z * v[j].z + v[j].w * v[j].w); }
        const float rstd = 1.0f / sqrtf(wave_sum(s2) * (1.f / D) + LN_EPS);
#pragma unroll
        for (int j = 0; j < 4; ++j) { const f32x4 o = v[j] * rstd * gv[j] + bv[j];
            *(f32x4*)(H + (size_t)row * D + 256 * j + 4 * lane) = o;
            if (HB) *(u32x2*)(HB + (size_t)row * D + 256 * j + 4 * lane) = pack4(o); }
    }
}

#define XB_TMO      128
#define XB_XCNT(j)  (256  + 64 * (j))
#define XB_XSUB(j)  (1280 + 64 * (j))
#define XB_XGEN(j)  (2304 + 64 * (j))
#define XB_TOP      3328
#define XB_TOPGEN   3392
#define XCD_BAR_WORDS 3456
#define XB_SPIN_CAP (1u << 22)
__device__ __forceinline__ unsigned xb_ld(unsigned* p)              { return __hip_atomic_load(p, __ATOMIC_RELAXED, __HIP_MEMORY_SCOPE_AGENT); }
__device__ __forceinline__ unsigned xb_add(unsigned* p, unsigned v) { return __hip_atomic_fetch_add(p, v, __ATOMIC_RELAXED, __HIP_MEMORY_SCOPE_AGENT); }
__device__ __forceinline__ unsigned xb_xcc_id() { return (unsigned)__builtin_amdgcn_s_getreg((3 << 11) | 20) & 0xFu; }
#define XB_SPIN(cond, bar) do { unsigned _sp = 0; while (cond) { __builtin_amdgcn_s_sleep(1); \
    if ((++_sp & 255u) == 0u) { if (xb_ld(&(bar)[XB_TMO])) break; if (_sp > XB_SPIN_CAP) { atomicAdd(&(bar)[XB_TMO], 1u); break; } } } } while (0)
__device__ __forceinline__ void xcd_barrier_complete(unsigned* bar, unsigned x, unsigned& nloc, unsigned& nx) {
    const unsigned G = gridDim.x;
    unsigned sum, cnt, mine, sp = 0u;
    for (;;) {
        sum = 0u; cnt = 0u; mine = 0u;
#pragma unroll
        for (unsigned j = 0; j < 16; ++j) { const unsigned c = xb_ld(&bar[XB_XCNT(j)]); sum += c; cnt += (c > 0u) ? 1u : 0u; mine = (j == x) ? c : mine; }
        if (sum == G) break;
        __builtin_amdgcn_s_sleep(1);
        if ((++sp & 255u) == 0u) { if (xb_ld(&bar[XB_TMO])) break; if (sp > XB_SPIN_CAP) { atomicAdd(&bar[XB_TMO], 1u); break; } }
    }
    nloc = mine > 0u ? mine : 1u; nx = cnt > 0u ? cnt : 1u;
}
__device__ __forceinline__ void xcd_barrier(unsigned* bar, volatile LAS unsigned* st) {
    asm volatile("s_waitcnt vmcnt(0) lgkmcnt(0)" ::: "memory");
    __syncthreads();
    if (threadIdx.x == 0) {
        __builtin_amdgcn_s_waitcnt(0);
        const unsigned x = xb_xcc_id();
        unsigned nloc = st[0], nx = st[1];
        if (nloc == 0u) { xcd_barrier_complete(bar, x, nloc, nx); st[0] = nloc; st[1] = nx; }
        const unsigned old = xb_add(&bar[XB_XSUB(x)], 1u);
        const unsigned gen = old / nloc;
        if (old + 1u == (gen + 1u) * nloc) {
            __builtin_amdgcn_fence(__ATOMIC_RELEASE, "agent");
            asm volatile("s_waitcnt vmcnt(0)" ::: "memory");
            const unsigned og = xb_add(&bar[XB_TOP], 1u);
            const unsigned tg = og / nx;
            if (og + 1u == (tg + 1u) * nx) xb_add(&bar[XB_TOPGEN], 1u);
            else XB_SPIN(xb_ld(&bar[XB_TOPGEN]) == tg, bar);
            __builtin_amdgcn_fence(__ATOMIC_ACQUIRE, "agent");
            xb_add(&bar[XB_XGEN(x)], 1u);
            asm volatile("s_waitcnt vmcnt(0)" ::: "memory");
        } else {
            XB_SPIN(xb_ld(&bar[XB_XGEN(x)]) == gen, bar);
            __builtin_amdgcn_fence(__ATOMIC_ACQUIRE, "agent");
            asm volatile("s_waitcnt vmcnt(0)" ::: "memory");
        }
    }
    __syncthreads();
}

#define PH_IDS const int tid = opaque(threadIdx.x), lane = tid & 63, wave = __builtin_amdgcn_readfirstlane(tid >> 6), gw = bx * NWAVES + wave, gt = bx * NTHR + tid; (void)lane; (void)gw; (void)gt; PH_PTRS
#define PH_PTRS \
    unsigned char* ws = args.ws; float* out = args.out; \
    bf16_t *WI = (bf16_t*)(ws + WS_WI), *WO = (bf16_t*)(ws + WS_WO), *WIN = (bf16_t*)(ws + WS_WIN), *WMIX = (bf16_t*)(ws + WS_WMIX), *WQ = (bf16_t*)(ws + WS_WQ), *WOX = (bf16_t*)(ws + WS_WOX), \
           *WKV = (bf16_t*)(ws + WS_WKV), *LORAT = (bf16_t*)(ws + WS_LORAT), *LRUT = (bf16_t*)(ws + WS_LRUT), *MEMB = (bf16_t*)(ws + WS_MEMB), *KB = (bf16_t*)(ws + WS_KB), *VT = (bf16_t*)(ws + WS_VT), \
           *HB = (bf16_t*)(ws + WS_HB), *PR = (bf16_t*)(ws + WS_PR), *PL = (bf16_t*)(ws + WS_PL), *GG = (bf16_t*)(ws + WS_GG), *SG0 = (bf16_t*)(ws + WS_SG0), *GI = (bf16_t*)(ws + WS_GI), \
           *WD = (bf16_t*)(ws + WS_WD), *AA = (bf16_t*)(ws + WS_AA), *GB = (bf16_t*)(ws + WS_G), *LB = (bf16_t*)(ws + WS_L); \
    bf16_t *ACT = PR, *XC = HB, *MB = HB, *GR = PL, *LO = GI, *QB = PL, *PB = GG, *OB = SG0; \
    float *PRE = (float*)(ws + WS_PRE), *Y = PRE, *H = out; \
    (void)WI; (void)WO; (void)WIN; (void)WMIX; (void)WQ; (void)WOX; (void)WKV; (void)LORAT; (void)LRUT; (void)MEMB; (void)KB; (void)VT; (void)HB; (void)PR; (void)PL; (void)GG; (void)SG0; (void)GI; \
    (void)WD; (void)AA; (void)GB; (void)LB; (void)ACT; (void)XC; (void)MB; (void)GR; (void)LO; (void)QB; (void)PB; (void)OB; (void)PRE; (void)Y; (void)H;
#define INP(k) (args.in[k])
#ifndef PHSEL
#define PHSEL(k) true
#endif
template <int ph>
__device__ __forceinline__ void run_phase(const Args& args, LAS unsigned char* lds, const int G, const int bx, const bool fin = true) {
    const int ngw = G * NWAVES, ngt = G * NTHR; (void)ngw; (void)ngt;
    switch (ph) {
    case 0: if (PHSEL(0)) { PH_IDS
        const float *x_prompt = INP(0), *x_sample = INP(1), *mem_prompt = INP(2), *decay_w2 = INP(18), *aaa_a2 = INP(20), *gate_g2 = INP(21), *lru_wr = INP(29), *lru_wi = INP(31);
        LAS float* scr = (LAS float*)(lds + wave * 16384);
        constexpr int I_WI = 16 * (2 * FF / 32), I_WO = (FF / 64) * 32, I_WIN = 16 * (PW / 32), I_SQ = 16 * 32;
        constexpr int NIT = I_WI + I_WO + I_WIN + 5 * I_SQ;
        for (int it = gw; it < NIT; it += ngw) {
            int r = it;
            if (r < I_WI) { transpose_item(INP(11), D, 2 * FF, WI, 1, scr, r, lane); continue; } r -= I_WI;
            if (r < I_WO) { transpose_item(INP(12), FF, D, WO, 0, scr, r, lane); continue; } r -= I_WO;
            if (r < I_WIN) { transpose_item(INP(15), D, PW, WIN, 2, scr, r, lane); continue; } r -= I_WIN;
            if (r < I_SQ) { transpose_item(INP(34), D, D, WMIX, 0, scr, r, lane); continue; } r -= I_SQ;
            if (r < I_SQ) { transpose_item(INP(35), D, D, WQ, 0, scr, r, lane); continue; } r -= I_SQ;
            if (r < I_SQ) { transpose_item(INP(36), D, D, WKV, 0, scr, r, lane); continue; } r -= I_SQ;
            if (r < I_SQ) { transpose_item(INP(37), D, D, WKV + (size_t)D * D, 0, scr, r, lane); continue; } r -= I_SQ;
            transpose_item(INP(38), D, D, WOX, 0, scr, r, lane);
        }
        for (int i = gt; i < 3072 * 256; i += ngt) { const int n = i >> 8, k = i & 255; float v = 0.f;
            if (n < 1024) { if (k < 64) v = decay_w2[k * 1024 + n]; } else if (n < 2048) { if (k >= 64 && k < 128) v = aaa_a2[(k - 64) * 1024 + (n - 1024)]; } else { if (k >= 128) v = gate_g2[(k - 128) * 1024 + (n - 2048)]; }
            LORAT[i] = f2bf(v); }
        for (int i = gt; i < 2048 * 256; i += ngt) { const int n = i >> 8, k = i & 255; const int q = n >> 8, bj = (n >> 7) & 1, j = n & 127;
            const int c = 128 * q + j, nb = c >> 6, d = c & 63; const int cin = 256 * (q >> 1) + k; float v = 0.f;
            if ((cin >> 6) == nb) v = (bj ? lru_wi : lru_wr)[(nb * 64 + (cin & 63)) * 64 + d];
            LRUT[i] = f2bf(v); }
        for (int i = gt; i < MT * D / 4; i += ngt) { const f32x4 v = (i < MP * D / 4) ? ((const f32x4*)x_prompt)[i] : ((const f32x4*)x_sample)[i - MP * D / 4];
            ((f32x4*)H)[i] = v; ((u32x2*)HB)[i] = pack4(v); }
        for (int i = gt; i < NB * 256 * D / 4; i += ngt) ((u32x2*)MEMB)[i] = pack4(((const f32x4*)mem_prompt)[i]);
    } break;

    case 1: case 16: if (PHSEL(1)) { PH_IDS
        { pg8::Gemm g{HB, WI, D, D, D}; pg8::Sched S; S.init(MP / 256, 2 * FF / 256, G, bx, 0, D, D); pg8::EpiSwiglu E{ACT}; pg8::gemm_phase(lds, g, S, E); }
        skinny<true>(HB, D, WI, D, D, 0, 2 * FF / 256, 0, bx, G, tid, [&](int row, int tile, int cin, f32x4 a, f32x4 b) {
            f32x4 o = (f32x4){silu(a[0]) * b[0], silu(a[1]) * b[1], silu(a[2]) * b[2], silu(a[3]) * b[3]};
            *(u32x2*)(ACT + (size_t)row * FF + tile * 128 + cin) = pack4(o); });
        if (ph == 1) {
        { pg8::Gemm g{MEMB, WKV, D, D, D}; pg8::Sched S; S.init(8, 8, G, bx, 0, D, D); pg8::EpiKV E{out + O_PMK, out + O_PMV, KB}; pg8::gemm_phase(lds, g, S, E); }
        { pg8::Gemm g{WKV + (size_t)D * D, MEMB, D, D, D}; pg8::Sched S; S.init(4, 8, G, bx, 0, D, D); pg8::EpiBf16 E{VT, NB * 256, 1.0f}; pg8::gemm_phase(lds, g, S, E); }
        }
    } break;
    case 2: case 17: if (PHSEL(2)) { PH_IDS
        { pg8::Gemm g{ACT, WO, FF, FF, FF}; pg8::Sched S; S.init(MP / 256, D / 256, G, bx, 0, FF, FF); pg8::EpiResid E{H, PRE, 0.5f}; pg8::gemm_phase(lds, g, S, E); }
        skinny<false>(ACT, FF, WO, FF, FF, 0, D / 256, 0, bx, G, tid, [&](int row, int tile, int cin, f32x4 a, f32x4) {
            const size_t off = (size_t)row * D + tile * 256 + cin; *(f32x4*)(PRE + off) = *(const f32x4*)(H + off) * DN_ALPHA + a * 0.5f; });
    } break;
    case 3: case 10: case 15: case 18: if (PHSEL(3)) { PH_IDS
        const float *ln_g = INP(9), *ln_b = INP(10);
        const int li = ph == 3 ? 0 : (ph == 10 ? 1 : (ph == 15 ? 2 : 3));
        ln_pass(PRE, ln_g + li * D, ln_b + li * D, H, ph == 18 ? (bf16_t*)nullptr : HB, gw, ngw, lane);
    } break;
    case 4: if (PHSEL(4)) { PH_IDS
        { pg8::Gemm g{HB, WIN, D, D, D}; pg8::Sched S; S.init(MP / 256, PW / 256, G, bx, 0, D, D); pg8::EpiProj E{PR, PL, GG, SG0}; pg8::gemm_phase(lds, g, S, E); }
        skinny<false>(HB, D, WIN, D, D, 0, 17, 0, bx, G, tid, [&](int row, int tile, int cin, f32x4 a, f32x4) {
            if (tile < 13) *(u32x2*)(PR + (size_t)row * RP + tile * 256 + cin) = pack4(a); else *(u32x2*)(PL + (size_t)row * D + (tile - 13) * 256 + cin) = pack4(a); });
        skinny<false>(HB, D, WIN, D, D, 25, 29, 0, bx, G, tid, [&](int row, int tile, int cin, f32x4 a, f32x4) {
            *(u32x2*)(SG0 + (size_t)row * D + (tile - 25) * 256 + cin) = pack4((f32x4){sigm(a[0]), sigm(a[1]), sigm(a[2]), sigm(a[3])}); });
        skinny<true>(HB, D, WIN, D, D, 17, 25, 0, bx, G, tid, [&](int row, int tile, int cin, f32x4 a, f32x4 b) {
            *(u32x2*)(GG + (size_t)row * D + (tile - 17) * 128 + cin) = pack4((f32x4){gelu_t(a[0]) * sigm(b[0]), gelu_t(a[1]) * sigm(b[1]), gelu_t(a[2]) * sigm(b[2]), gelu_t(a[3]) * sigm(b[3])}); });
    } break;
    case 5: if (PHSEL(5)) { PH_IDS
        const float *state_shift = INP(6), *state_conv = INP(8), *shift_mu = INP(16), *conv_w = INP(27), *conv_b = INP(28);
        for (int row = gw; row < MT; row += ngw) {
            const bool smp = row >= MP; const int t = row & (T - 1), b = row >> 11, si = row - MP;
            { const int c = 3072 + 4 * lane; const f32x4 p = unpack4(*(const u32x2*)(PR + (size_t)row * RP + c));
              f32x4 pv = (f32x4){0.f, 0.f, 0.f, 0.f};
              if (smp) pv = *(const f32x4*)(state_shift + (size_t)si * RP + c); else if (t > 0) pv = unpack4(*(const u32x2*)(PR + (size_t)(row - 1) * RP + c));
              const f32x4 mu = *(const f32x4*)(shift_mu + c); f32x4 xs = p + (pv - p) * mu;
              if (lane < 16) xs = (f32x4){tanh_(xs[0]), tanh_(xs[1]), tanh_(xs[2]), tanh_(xs[3])}; else if (lane >= 32) xs = (f32x4){sigm(xs[0]), sigm(xs[1]), sigm(xs[2]), sigm(xs[3])};
              *(u32x2*)(LB + (size_t)row * 256 + 4 * lane) = pack4(xs); }
#pragma unroll
            for (int j = 0; j < 4; ++j) { const int c = 256 * j + 4 * lane;
                const f32x4 p3 = unpack4(*(const u32x2*)(PL + (size_t)row * D + c));
                f32x4 p0 = (f32x4){0.f, 0.f, 0.f, 0.f}, p1 = p0, p2 = p0;
                if (smp) { p0 = *(const f32x4*)(state_conv + ((size_t)si * 3 + 0) * D + c); p1 = *(const f32x4*)(state_conv + ((size_t)si * 3 + 1) * D + c); p2 = *(const f32x4*)(state_conv + ((size_t)si * 3 + 2) * D + c); }
                else { if (t >= 3) p0 = unpack4(*(const u32x2*)(PL + (size_t)(row - 3) * D + c)); if (t >= 2) p1 = unpack4(*(const u32x2*)(PL + (size_t)(row - 2) * D + c)); if (t >= 1) p2 = unpack4(*(const u32x2*)(PL + (size_t)(row - 1) * D + c)); }
                const f32x4 xc = *(const f32x4*)(conv_b + c) + *(const f32x4*)(conv_w + c) * p0 + *(const f32x4*)(conv_w + D + c) * p1 + *(const f32x4*)(conv_w + 2 * D + c) * p2 + *(const f32x4*)(conv_w + 3 * D + c) * p3;
                *(u32x2*)(XC + (size_t)row * D + c) = pack4(xc);
                if (smp) { *(f32x4*)(out + O_SCONV + ((size_t)si * 3 + 0) * D + c) = p1; *(f32x4*)(out + O_SCONV + ((size_t)si * 3 + 1) * D + c) = p2; *(f32x4*)(out + O_SCONV + ((size_t)si * 3 + 2) * D + c) = p3; }
                else if (t >= T - 3) *(f32x4*)(out + O_PCONV + ((size_t)b * 3 + (t - (T - 3))) * D + c) = p3; }
            if (smp || t == T - 1) { float* dst = smp ? out + O_SSHIFT + (size_t)si * RP : out + O_PSHIFT + (size_t)b * RP;
                for (int c = 4 * lane; c < RP; c += 256) *(f32x4*)(dst + c) = unpack4(*(const u32x2*)(PR + (size_t)row * RP + c)); }
        }
    } break;
    case 6: if (PHSEL(6)) { PH_IDS
        const float *decay_w0 = INP(17), *aaa_a0 = INP(19), *lru_br = INP(30), *lru_bi = INP(32);
        { pg8::Gemm g{LB, LORAT, 256, 256, 256}; pg8::Sched S; S.init(MP / 256, 12, G, bx, 0, 256, 256); pg8::EpiLora E{WD, AA, GB, decay_w0, aaa_a0}; pg8::gemm_phase(lds, g, S, E); }
        { pg8::Gemm g{XC, LRUT, D, 256, 256}; pg8::Sched S; S.init(MP / 256, 8, G, bx, 1, D, 256); pg8::EpiLru E{GR, GI, lru_br, lru_bi}; pg8::gemm_phase(lds, g, S, E); }
        skinny<false>(LB, 256, LORAT, 256, 256, 0, 12, 0, bx, G, tid, [&](int row, int tile, int cin, f32x4 a, f32x4) {
            const int kind = tile >> 2, c = (tile & 3) * 256 + cin; f32x4 o = a;
            if (kind == 0) { const f32x4 bb = *(const f32x4*)(decay_w0 + c); o = (f32x4){decay_e(a[0] + bb[0]), decay_e(a[1] + bb[1]), decay_e(a[2] + bb[2]), decay_e(a[3] + bb[3])}; }
            else if (kind == 1) { const f32x4 bb = *(const f32x4*)(aaa_a0 + c); o = (f32x4){sigm(a[0] + bb[0]), sigm(a[1] + bb[1]), sigm(a[2] + bb[2]), sigm(a[3] + bb[3])}; }
            bf16_t* base = WD + (size_t)kind * ((WS_AA - WS_WD) / 2); *(u32x2*)(base + (size_t)row * D + c) = pack4(o); });
        skinny<true>(XC, D, LRUT, 256, 256, 0, 8, 1, bx, G, tid, [&](int row, int tile, int cin, f32x4 a, f32x4 b) {
            const int c = tile * 128 + cin; const f32x4 b0 = *(const f32x4*)(lru_br + c), b1 = *(const f32x4*)(lru_bi + c);
            *(u32x2*)(GR + (size_t)row * D + c) = pack4((f32x4){sigm(a[0] + b0[0]), sigm(a[1] + b0[1]), sigm(a[2] + b0[2]), sigm(a[3] + b0[3])});
            *(u32x2*)(GI + (size_t)row * D + c) = pack4((f32x4){sigm(b[0] + b1[0]), sigm(b[1] + b1[1]), sigm(b[2] + b1[2]), sigm(b[3] + b1[3])}); });
    } break;
    case 7: if (PHSEL(7)) { PH_IDS
        const float *state_rwkv = INP(5), *state_shift = INP(6), *state_lru = INP(7), *shift_mu = INP(16), *k_k = INP(22), *k_a = INP(23), *lru_lambda = INP(33);
        constexpr int TC = 32, VB = 6 * TC * 64;
        LAS float* VECb = (LAS float*)lds;
        LAS float* SCb = (LAS float*)(lds + 2 * VB * 4);
        LAS float* YBb = (LAS float*)(lds + 2 * VB * 4 + 512);
        for (int unit = bx; unit < 256; unit += G) {
            const int b = unit >> 5, h = (unit >> 1) & 15, half = unit & 1;
            const bool producer = wave >= 4;
            const int ptid = tid & 255, tt0 = ptid >> 4, cgq = ptid & 15, chb = h * 64 + 4 * cgq;
            f32x4 mu_r, mu_k, mu_v, kkc, kac;
            u32x2 q_r[2], q_k[2], q_v[2], q_rp[2], q_kp[2], q_vp[2], q_e[2], q_a[2];
            auto issue = [&](int chunk) {
#pragma unroll
                for (int it = 0; it < 2; ++it) {
                    const int tg = chunk * TC + tt0 + 16 * it; const size_t row = (size_t)b * T + tg; const bf16_t* base = PR + row * RP + chb;
                    q_r[it] = *(const u32x2*)(base); q_k[it] = *(const u32x2*)(base + 1024); q_v[it] = *(const u32x2*)(base + 2048);
                    if (tg > 0) { q_rp[it] = *(const u32x2*)(base - RP); q_kp[it] = *(const u32x2*)(base - RP + 1024); q_vp[it] = *(const u32x2*)(base - RP + 2048); }
                    else { q_rp[it] = (u32x2){0u, 0u}; q_kp[it] = q_rp[it]; q_vp[it] = q_rp[it]; }
                    q_e[it] = *(const u32x2*)(WD + row * D + chb); q_a[it] = *(const u32x2*)(AA + row * D + chb);
                }
            };
            auto derive = [&](int buf) {
                LAS float* V = VECb + buf * VB;
#pragma unroll
                for (int it = 0; it < 2; ++it) {
                    const int tt = tt0 + 16 * it;
                    const f32x4 pr = unpack4(q_r[it]), pk = unpack4(q_k[it]), pv = unpack4(q_v[it]);
                    const f32x4 r = pr + (unpack4(q_rp[it]) - pr) * mu_r, k = pk + (unpack4(q_kp[it]) - pk) * mu_k, v = pv + (unpack4(q_vp[it]) - pv) * mu_v;
                    const f32x4 e = unpack4(q_e[it]), a = unpack4(q_a[it]);
                    const f32x4 w = (f32x4){__expf(-e[0]), __expf(-e[1]), __expf(-e[2]), __expf(-e[3])};
                    f32x4 kk = k * kkc; const float n2 = red16(dot4(kk, kk)); kk = kk * (1.0f / fmaxf(sqrtf(n2), 1e-12f));
                    const f32x4 kp = k * (1.0f + (a - 1.0f) * kac), bv = kk * a, wrv = w * r;
                    const float br = red16(dot4(bv, r)), kr = red16(dot4(kp, r));
                    const int o = tt * 64 + 4 * cgq;
                    *(LAS f32x4*)(V + 0 * TC * 64 + o) = -kk; *(LAS f32x4*)(V + 1 * TC * 64 + o) = wrv; *(LAS f32x4*)(V + 2 * TC * 64 + o) = w;
                    *(LAS f32x4*)(V + 3 * TC * 64 + o) = bv; *(LAS f32x4*)(V + 4 * TC * 64 + o) = kp; *(LAS f32x4*)(V + 5 * TC * 64 + o) = v;
                    if (cgq == 0) *(LAS f32x2*)(SCb + buf * TC * 2 + 2 * tt) = (f32x2){br, kr};
                }
            };
            auto storeY = [&](int chunk, int buf) {
                const int t2 = ptid >> 3, r4 = (ptid & 7) * 4;
                *(f32x4*)(Y + ((size_t)b * T + chunk * TC + t2) * D + h * 64 + 32 * half + r4) = *(const LAS f32x4*)(YBb + buf * TC * 32 + t2 * 32 + r4);
            };
            const int r8 = lane >> 3, kq = lane & 7, rowl = 8 * (wave & 3) + r8, srow = 32 * half + rowl;
            f32x2 S0 = (f32x2){0.f, 0.f}, S1 = S0, S2 = S0, S3 = S0;
            if (producer) {
                mu_r = *(const f32x4*)(shift_mu + chb); mu_k = *(const f32x4*)(shift_mu + 1024 + chb); mu_v = *(const f32x4*)(shift_mu + 2048 + chb);
                kkc = *(const f32x4*)(k_k + chb); kac = *(const f32x4*)(k_a + chb);
                issue(0); derive(0); issue(1);
            }
            __syncthreads();
            for (int chunk = 0; chunk < T / TC; ++chunk) {
                const int buf = chunk & 1;
                if (producer) {
                    if (chunk > 0) storeY(chunk - 1, buf ^ 1);
                    if (chunk + 1 < T / TC) { derive(buf ^ 1); if (chunk + 2 < T / TC) issue(chunk + 2); }
                } else {
                    const LAS float* V = VECb + buf * VB + 8 * kq; const LAS float* SCp = SCb + buf * TC * 2;
                    LAS float* YBp = (kq == 0) ? (YBb + buf * TC * 32 + rowl) : (YBb + 2 * TC * 32 + wave * 64 + lane); const int ystr = (kq == 0) ? 32 : 0;
                    const LAS float* Vv = VECb + buf * VB + 5 * TC * 64 + srow;
#define SCAN_LOAD(X, t_) const LAS float* p##X = V + (t_) * 64; \
                        f32x4 nkA##X = *(const LAS f32x4*)(p##X), nkB##X = *(const LAS f32x4*)(p##X + 4), wrA##X = *(const LAS f32x4*)(p##X + 1 * TC * 64), wrB##X = *(const LAS f32x4*)(p##X + 1 * TC * 64 + 4), \
                              wA##X = *(const LAS f32x4*)(p##X + 2 * TC * 64), wB##X = *(const LAS f32x4*)(p##X + 2 * TC * 64 + 4), bA##X = *(const LAS f32x4*)(p##X + 3 * TC * 64), bB##X = *(const LAS f32x4*)(p##X + 3 * TC * 64 + 4), \
                              kA##X = *(const LAS f32x4*)(p##X + 4 * TC * 64), kB##X = *(const LAS f32x4*)(p##X + 4 * TC * 64 + 4); float vv##X = Vv[(t_) * 64]; f32x2 sc##X = *(const LAS f32x2*)(SCp + 2 * (t_));
#define SCAN_STEP(X, t_) { const f32x2 sc = sc##X; \
                        f32x2 da = S0 * (f32x2){nkA##X[0], nkA##X[1]}; da = S1 * (f32x2){nkA##X[2], nkA##X[3]} + da; da = S2 * (f32x2){nkB##X[0], nkB##X[1]} + da; da = S3 * (f32x2){nkB##X[2], nkB##X[3]} + da; \
                        f32x2 dz = S0 * (f32x2){wrA##X[0], wrA##X[1]}; dz = S1 * (f32x2){wrA##X[2], wrA##X[3]} + dz; dz = S2 * (f32x2){wrB##X[0], wrB##X[1]} + dz; dz = S3 * (f32x2){wrB##X[2], wrB##X[3]} + dz; \
                        float sa = da.x + da.y, z = dz.x + dz.y; \
                        sa += dppf<0xB1>(sa); z += dppf<0xB1>(z); sa += dppf<0x4E>(sa); z += dppf<0x4E>(z); sa += dppf<0x141>(sa); z += dppf<0x141>(z); \
                        const float y = z + sa * sc.x + vv##X * sc.y; const f32x2 sa2 = (f32x2){sa, sa}, vv2 = (f32x2){vv##X, vv##X}; \
                        S0 = S0 * (f32x2){wA##X[0], wA##X[1]} + (f32x2){bA##X[0], bA##X[1]} * sa2 + (f32x2){kA##X[0], kA##X[1]} * vv2; \
                        S1 = S1 * (f32x2){wA##X[2], wA##X[3]} + (f32x2){bA##X[2], bA##X[3]} * sa2 + (f32x2){kA##X[2], kA##X[3]} * vv2; \
                        S2 = S2 * (f32x2){wB##X[0], wB##X[1]} + (f32x2){bB##X[0], bB##X[1]} * sa2 + (f32x2){kB##X[0], kB##X[1]} * vv2; \
                        S3 = S3 * (f32x2){wB##X[2], wB##X[3]} + (f32x2){bB##X[2], bB##X[3]} * sa2 + (f32x2){kB##X[2], kB##X[3]} * vv2; \
                        YBp[(t_) * ystr] = y; }
                    { SCAN_LOAD(a, 0)
#pragma unroll 1
                      for (int t = 0; t < TC; t += 2) {
                          SCAN_LOAD(b, t + 1)
                          __builtin_amdgcn_sched_barrier(0);
                          SCAN_STEP(a, t)
                          __builtin_amdgcn_sched_barrier(0);
                          { const LAS float* pn = V + (t + 2) * 64;
                            nkAa = *(const LAS f32x4*)(pn); nkBa = *(const LAS f32x4*)(pn + 4); wrAa = *(const LAS f32x4*)(pn + 1 * TC * 64); wrBa = *(const LAS f32x4*)(pn + 1 * TC * 64 + 4);
                            wAa = *(const LAS f32x4*)(pn + 2 * TC * 64); wBa = *(const LAS f32x4*)(pn + 2 * TC * 64 + 4); bAa = *(const LAS f32x4*)(pn + 3 * TC * 64); bBa = *(const LAS f32x4*)(pn + 3 * TC * 64 + 4);
                            kAa = *(const LAS f32x4*)(pn + 4 * TC * 64); kBa = *(const LAS f32x4*)(pn + 4 * TC * 64 + 4); vva = Vv[(t + 2) * 64]; sca = *(const LAS f32x2*)(SCp + 2 * (t + 2)); }
                          __builtin_amdgcn_sched_barrier(0);
                          SCAN_STEP(b, t + 1)
                          __builtin_amdgcn_sched_barrier(0);
                      } }
#undef SCAN_LOAD
#undef SCAN_STEP
                }
                __syncthreads();
            }
            if (producer) storeY(T / TC - 1, 1);
            else { float* sp = out + O_PRWKV + (((size_t)b * 16 + h) * 64 + srow) * 64 + 8 * kq;
                   *(f32x4*)(sp) = (f32x4){S0.x, S0.y, S1.x, S1.y}; *(f32x4*)(sp + 4) = (f32x4){S2.x, S2.y, S3.x, S3.y}; }
            __syncthreads();
        }
        if (fin) {
            LAS float* V1 = (LAS float*)(lds + wave * 2048);
            const int cgq = lane & 15;
            for (int un = gw; un < NS * 16; un += ngw) {
                const int i = un >> 4, h = un & 15, chb = h * 64 + 4 * cgq; const size_t row = (size_t)MP + i;
                const bf16_t* base = PR + row * RP + chb; const float* sb = state_shift + (size_t)i * RP + chb;
                const f32x4 pr = unpack4(*(const u32x2*)(base)), pk = unpack4(*(const u32x2*)(base + 1024)), pv = unpack4(*(const u32x2*)(base + 2048));
                const f32x4 r = pr + (*(const f32x4*)(sb) - pr) * *(const f32x4*)(shift_mu + chb), k = pk + (*(const f32x4*)(sb + 1024) - pk) * *(const f32x4*)(shift_mu + 1024 + chb),
                            v = pv + (*(const f32x4*)(sb + 2048) - pv) * *(const f32x4*)(shift_mu + 2048 + chb);
                const f32x4 e = unpack4(*(const u32x2*)(WD + row * D + chb)), a = unpack4(*(const u32x2*)(AA + row * D + chb));
                const f32x4 w = (f32x4){__expf(-e[0]), __expf(-e[1]), __expf(-e[2]), __expf(-e[3])};
                f32x4 kk = k * *(const f32x4*)(k_k + chb); const float n2 = red16(dot4(kk, kk)); kk = kk * (1.0f / fmaxf(sqrtf(n2), 1e-12f));
                const f32x4 kp = k * (1.0f + (a - 1.0f) * *(const f32x4*)(k_a + chb)), bv = kk * a, wrv = w * r;
                const float br = red16(dot4(bv, r)), kr = red16(dot4(kp, r));
                if (lane < 16) *(LAS f32x4*)(V1 + 320 + 4 * cgq) = v;
                asm volatile("s_waitcnt lgkmcnt(0)" ::: "memory");
                const f32x4 nk = -kk;
                const size_t sbase = ((size_t)i * 16 + h) * 4096;
#pragma unroll 4
                for (int rg = 0; rg < 16; ++rg) {
                    const int srow = 4 * rg + (lane >> 4);
                    f32x4 S = *(const f32x4*)(state_rwkv + sbase + srow * 64 + 4 * cgq);
                    const float vv = V1[320 + srow];
                    const float sa = red16(dot4(S, nk)), z = red16(dot4(S, wrv));
                    const float y = z + sa * br + vv * kr;
                    S = S * w + bv * sa + kp * vv;
                    *(f32x4*)(out + O_SRWKV + sbase + srow * 64 + 4 * cgq) = S;
                    if (cgq == 0) Y[row * D + h * 64 + srow] = y;
                }
                asm volatile("s_waitcnt lgkmcnt(0)" ::: "memory");
            }
        }
        __syncthreads();
        if (fin) {
            LAS f32x2* sA = (LAS f32x2*)lds; LAS f32x2* sB = (LAS f32x2*)(lds + 4096);
            for (int unit = bx; unit < 128; unit += G) {
                const int b = unit >> 4, l32 = tid & 31, ch = (unit & 15) * 64 + 2 * l32, seg = tid >> 5, t0 = seg * 128;
                const f32x2 lam = *(const f32x2*)(lru_lambda + ch); const float sp0 = softplus_(-lam.x), sp1 = softplus_(-lam.y);
                const size_t base = ((size_t)b * T + t0) * D + ch;
                float A0 = 1.f, B0 = 0.f, A1 = 1.f, B1 = 0.f;
#pragma unroll 8
                for (int t = 0; t < 128; ++t) { const size_t o = base + (size_t)t * D;
                    const unsigned gr = *(const unsigned*)(GR + o), gi = *(const unsigned*)(GI + o), xc = *(const unsigned*)(XC + o);
                    const float la0 = -8.0f * __uint_as_float(gr << 16) * sp0, la1 = -8.0f * __uint_as_float(gr & 0xffff0000u) * sp1;
                    const float a0 = __expf(la0), a1 = __expf(la1);
                    const float b0 = sqrtf(fmaxf(1.0f - a0 * a0, 0.f)) * __uint_as_float(gi << 16) * __uint_as_float(xc << 16);
                    const float b1 = sqrtf(fmaxf(1.0f - a1 * a1, 0.f)) * __uint_as_float(gi & 0xffff0000u) * __uint_as_float(xc & 0xffff0000u);
                    A0 *= a0; B0 = a0 * B0 + b0; A1 *= a1; B1 = a1 * B1 + b1; }
                sA[seg * 32 + l32] = (f32x2){A0, A1}; sB[seg * 32 + l32] = (f32x2){B0, B1};
                __syncthreads();
                float h0 = 0.f, h1 = 0.f;
                for (int s2 = 0; s2 < seg; ++s2) { const f32x2 a = sA[s2 * 32 + l32], bb = sB[s2 * 32 + l32]; h0 = a.x * h0 + bb.x; h1 = a.y * h1 + bb.y; }
#pragma unroll 8
                for (int t = 0; t < 128; ++t) { const size_t o = base + (size_t)t * D;
                    const unsigned gr = *(const unsigned*)(GR + o), gi = *(const unsigned*)(GI + o), xc = *(const unsigned*)(XC + o), gg = *(const unsigned*)(GG + o);
                    const float la0 = -8.0f * __uint_as_float(gr << 16) * sp0, la1 = -8.0f * __uint_as_float(gr & 0xffff0000u) * sp1;
                    const float a0 = __expf(la0), a1 = __expf(la1);
                    const float b0 = sqrtf(fmaxf(1.0f - a0 * a0, 0.f)) * __uint_as_float(gi << 16) * __uint_as_float(xc << 16);
                    const float b1 = sqrtf(fmaxf(1.0f - a1 * a1, 0.f)) * __uint_as_float(gi & 0xffff0000u) * __uint_as_float(xc & 0xffff0000u);
                    h0 = a0 * h0 + b0; h1 = a1 * h1 + b1;
                    *(unsigned*)(LO + o) = cvt_pk_bf16(h0 * __uint_as_float(gg << 16), h1 * __uint_as_float(gg & 0xffff0000u)); }
                if (seg == 15) *(f32x2*)(out + O_PLRU + (size_t)b * D + ch) = (f32x2){h0, h1};
                __syncthreads();
            }
            for (int i = gt; i < NS * D; i += ngt) { const int ch = i & (D - 1); const size_t o = (size_t)MP * D + i;
                const float sp = softplus_(-lru_lambda[ch]);
                const float gr = bf2f(GR[o]), gi = bf2f(GI[o]), xc = bf2f(XC[o]), gg = bf2f(GG[o]);
                const float la = -8.0f * gr * sp, a = __expf(la), bb = sqrtf(fmaxf(-expm1f(2.0f * la), 0.f)) * gi * xc;
                const float hst = a * state_lru[i] + bb; out[O_SLRU + i] = hst; LO[o] = f2bf(hst * gg); }
        }
    } break;
    case 8: if (PHSEL(8)) { PH_IDS
        const float *state_shift = INP(6), *shift_mu = INP(16), *k_a = INP(23), *r_k = INP(24), *gn_g = INP(25), *gn_b = INP(26);
        for (int row = gw; row < MT; row += ngw) {
            const bool smp = row >= MP; const int t = row & (T - 1), si = row - MP;
#pragma unroll
            for (int j = 0; j < 4; ++j) { const int c = 256 * j + 4 * lane;
                const bf16_t* base = PR + (size_t)row * RP + c;
                const f32x4 pr = unpack4(*(const u32x2*)(base)), pk = unpack4(*(const u32x2*)(base + 1024)), pv = unpack4(*(const u32x2*)(base + 2048));
                f32x4 qr = (f32x4){0.f, 0.f, 0.f, 0.f}, qk = qr, qv = qr;
                if (smp) { const float* sb = state_shift + (size_t)si * RP + c; qr = *(const f32x4*)(sb); qk = *(const f32x4*)(sb + 1024); qv = *(const f32x4*)(sb + 2048); }
                else if (t > 0) { qr = unpack4(*(const u32x2*)(base - RP)); qk = unpack4(*(const u32x2*)(base - RP + 1024)); qv = unpack4(*(const u32x2*)(base - RP + 2048)); }
                const f32x4 r = pr + (qr - pr) * *(const f32x4*)(shift_mu + c), k = pk + (qk - pk) * *(const f32x4*)(shift_mu + 1024 + c), v = pv + (qv - pv) * *(const f32x4*)(shift_mu + 2048 + c);
                const f32x4 a = unpack4(*(const u32x2*)(AA + (size_t)row * D + c));
                const f32x4 kp = k * (1.0f + (a - 1.0f) * *(const f32x4*)(k_a + c));
                const float bon = red16(dot4(r * kp, *(const f32x4*)(r_k + c)));
                const f32x4 y = *(const f32x4*)(Y + (size_t)row * D + c);
                const float mean = red16((y.x + y.y) + (y.z + y.w)) * (1.0f / 64.0f);
                const f32x4 dy = y - mean; const float var = red16(dot4(dy, dy)) * (1.0f / 64.0f);
                const f32x4 yn = dy * (1.0f / sqrtf(var + GN_EPS)) * *(const f32x4*)(gn_g + c) + *(const f32x4*)(gn_b + c);
                const f32x4 gg = unpack4(*(const u32x2*)(GB + (size_t)row * D + c)), s0 = unpack4(*(const u32x2*)(SG0 + (size_t)row * D + c)), lo_ = unpack4(*(const u32x2*)(LO + (size_t)row * D + c));
                const f32x4 mg = s0 * ((yn + v * bon) * gg) + lo_;
                *(u32x2*)(MB + (size_t)row * D + c) = pack4(mg); }
        }
        __syncthreads();
        { LAS float* scr = (LAS float*)(lds + wave * 16384);
          constexpr int I_WI = 16 * (2 * FF / 32), I_WO = (FF / 64) * 32;
          for (int it = gw; it < I_WI + I_WO; it += ngw) { if (it < I_WI) transpose_item(INP(13), D, 2 * FF, WI, 1, scr, it, lane); else transpose_item(INP(14), FF, D, WO, 0, scr, it - I_WI, lane); } }
    } break;
    case 9: case 14: if (PHSEL(9)) { PH_IDS
        const bf16_t* Am = ph == 9 ? MB : OB; const bf16_t* Wt = ph == 9 ? WMIX : WOX;
        { pg8::Gemm g{Am, Wt, D, D, D}; pg8::Sched S; S.init(MP / 256, D / 256, G, bx, 0, D, D); pg8::EpiResid E{H, PRE, 1.0f}; pg8::gemm_phase(lds, g, S, E); }
        skinny<false>(Am, D, Wt, D, D, 0, D / 256, 0, bx, G, tid, [&](int row, int tile, int cin, f32x4 a, f32x4) {
            const size_t off = (size_t)row * D + tile * 256 + cin; *(f32x4*)(PRE + off) = *(const f32x4*)(H + off) * DN_ALPHA + a; });
    } break;
    case 11: if (PHSEL(11)) { PH_IDS
        const float qs = 0.0625f * 1.4426950408889634f;
        { pg8::Gemm g{HB, WQ, D, D, D}; pg8::Sched S; S.init(MP / 256, D / 256, G, bx, 0, D, D); pg8::EpiBf16 E{QB, D, qs}; pg8::gemm_phase(lds, g, S, E); }
        skinny<false>(HB, D, WQ, D, D, 0, D / 256, 0, bx, G, tid, [&](int row, int tile, int cin, f32x4 a, f32x4) { *(u32x2*)(QB + (size_t)row * D + tile * 256 + cin) = pack4(a * qs); });
    } break;
    case 12: if (PHSEL(12)) { PH_IDS
        const float *cache_k = INP(3), *cache_v = INP(4);
        { pg8::Gemm g{QB, KB, D, D, 256}; pg8::Sched S; S.init(MP / 256, 4, G, bx, 2, D, D); pg8::EpiSoftmax E{PB}; pg8::gemm_phase(lds, g, S, E); }
        __syncthreads();
        LAS float* sS = (LAS float*)lds;
        LAS float* sO = (LAS float*)(lds + 4096);
        for (int un = bx; un < NS * 4; un += G) {
            const int i = un >> 2, h = un & 3;
            const f32x4 q = unpack4(*(const u32x2*)(QB + (size_t)(MP + i) * D + h * 256 + 4 * lane));
            const float* kb = cache_k + ((size_t)i * 256 * 4 + h) * 256 + 4 * lane;
            const float* vb = cache_v + ((size_t)i * 256 * 4 + h) * 256 + 4 * lane;
#pragma unroll 8
            for (int mm = 0; mm < 32; ++mm) { const int m = wave * 32 + mm; const f32x4 kx = *(const f32x4*)(kb + (size_t)m * 1024);
                const float s = wave_sum(dot4(q, kx)); if (lane == 0) sS[m] = s; }
            __syncthreads();
            float mx = -3.0e38f;
#pragma unroll
            for (int j = 0; j < 4; ++j) mx = fmaxf(mx, sS[lane + 64 * j]);
            mx = wave_max(mx);
            float sum = 0.f;
#pragma unroll
            for (int j = 0; j < 4; ++j) sum += __builtin_amdgcn_exp2f(sS[lane + 64 * j] - mx);
            sum = wave_sum(sum); const float inv = 1.0f / sum;
            f32x4 o = (f32x4){0.f, 0.f, 0.f, 0.f};
#pragma unroll 8
            for (int mm = 0; mm < 32; ++mm) { const int m = wave * 32 + mm; const f32x4 vx = *(const f32x4*)(vb + (size_t)m * 1024);
                const float p = __builtin_amdgcn_exp2f(sS[m] - mx) * inv; o = o + vx * p; }
            *(LAS f32x4*)(sO + wave * 256 + 4 * lane) = o;
            __syncthreads();
            if (tid < 256) { float acc = 0.f;
#pragma unroll
                for (int w8 = 0; w8 < 8; ++w8) acc += sO[w8 * 256 + tid];
                OB[(size_t)(MP + i) * D + h * 256 + tid] = f2bf(acc); }
            __syncthreads();
        }
    } break;
    case 13: if (PHSEL(13)) { PH_IDS pg8::Gemm g{PB, VT, D, NB * 256, 256}; pg8::Sched S; S.init(MP / 256, 4, G, bx, 3, D, NB * 256); pg8::EpiBf16 E{OB, D, 1.0f}; pg8::gemm_phase(lds, g, S, E); } break;
    default: break;
    }
}

__global__ void __launch_bounds__(NTHR, 2) mega(Args args) {
    extern __shared__ __attribute__((aligned(16))) unsigned char lds_raw[];
    LAS unsigned char* lds = (LAS unsigned char*)lds_raw;
    cg::grid_group grid = cg::this_grid();
    const int G = gridDim.x, bx = blockIdx.x;
    const int lo = args.ph_lo, hi = args.ph_hi;
    unsigned* const bar = (unsigned*)args.ws;
    volatile LAS unsigned* const bst = (volatile LAS unsigned*)(lds + 131072 + 64);
    if (threadIdx.x < 2) bst[threadIdx.x] = 0u;
    if (threadIdx.x == 0) (void)xb_add(&bar[XB_XCNT(xb_xcc_id())], 1u);
    grid.sync();
#ifndef DUPK
#define DUPK -1
#endif
#define GSYNC() xcd_barrier(bar, bst)
#define RUN(k) if (lo <= (k) && (k) < hi) { if ((k) == DUPK) { run_phase<k>(args, lds, G, bx, false); GSYNC(); } run_phase<k>(args, lds, G, bx); if ((k) + 1 < hi) GSYNC(); }
    RUN(0) RUN(1) RUN(2) RUN(3) RUN(4) RUN(5) RUN(6) RUN(7) RUN(8) RUN(9) RUN(10) RUN(11) RUN(12) RUN(13) RUN(14) RUN(15) RUN(16) RUN(17) RUN(18)
#undef RUN
}

#ifndef N_LAUNCH_PER_PHASE
#define N_LAUNCH_PER_PHASE 0
#endif
extern "C" void kernel_launch(void* const* d_in, const int* in_sizes, int n_in, void* d_out, int out_size, void* d_ws, size_t ws_size, hipStream_t stream) {
    static int grid = 0;
    if (grid == 0) {
        if (n_in != 39 || out_size != (int)O_TOTAL || ws_size < WS_END) { fprintf(stderr, "kernel_launch: unexpected shapes (n_in %d out %d ws %zu)\n", n_in, out_size, ws_size); grid = -1; return; }
        int dev = 0, cus = 0, per_cu = 0;
        hipGetDevice(&dev); hipDeviceGetAttribute(&cus, hipDeviceAttributeMultiprocessorCount, dev);
        hipFuncSetAttribute((const void*)mega, hipFuncAttributeMaxDynamicSharedMemorySize, LDS_BYTES);
        hipOccupancyMaxActiveBlocksPerMultiprocessor(&per_cu, (const void*)mega, NTHR, LDS_BYTES);
        if (per_cu < 1) { fprintf(stderr, "kernel_launch: occupancy query says 0 blocks per CU\n"); grid = -1; return; }
        grid = cus;
    }
    if (grid < 0) return;
    if (hipMemsetAsync(d_ws, 0, 65536, stream) != hipSuccess) { fprintf(stderr, "kernel_launch: memset of control words failed\n"); return; }
    Args a{};
    for (int i = 0; i < 39; ++i) a.in[i] = (const float*)d_in[i];
    a.out = (float*)d_out; a.ws = (unsigned char*)d_ws;
#if N_LAUNCH_PER_PHASE
    for (int p = 0; p < 19; ++p) { a.ph_lo = p; a.ph_hi = p + 1; void* kargs[] = {&a};
        hipLaunchCooperativeKernel((const void*)mega, dim3(grid), dim3(NTHR), kargs, LDS_BYTES, stream); }
#else
    a.ph_lo = 0; a.ph_hi = 19; void* kargs[] = {&a};
    hipError_t e = hipLaunchCooperativeKernel((const void*)mega, dim3(grid), dim3(NTHR), kargs, LDS_BYTES, stream);
    if (e != hipSuccess) fprintf(stderr, "cooperative launch failed: %s (grid %d)\n", hipGetErrorString(e), grid);
#endif
}
```

```cpp
#include <hip/hip_runtime.h>
#include <hip/hip_cooperative_groups.h>
#include <cstdio>
#include <cstdint>
namespace cg = cooperative_groups;

#define LAS __attribute__((address_space(3)))
typedef unsigned short bf16_t;
typedef short bf16x8 __attribute__((ext_vector_type(8)));
typedef float f32x4 __attribute__((ext_vector_type(4)));
typedef float f32x2 __attribute__((ext_vector_type(2)));
typedef unsigned u32x4 __attribute__((ext_vector_type(4)));
typedef unsigned u32x2 __attribute__((ext_vector_type(2)));

constexpr int D = 1024, T = 2048, NB = 8, MP = NB * T, NS = 128, MT = MP + NS, FF = 2816, RP = 3328, PW = 7424;
constexpr int NWAVES = 8, NTHR = 512;
constexpr float DN_ALPHA = 1.189207115002721f;
constexpr float LN_EPS = 1e-5f, GN_EPS = 64e-5f;

constexpr size_t MiB = 1u << 20;
constexpr size_t WS_WI = 1 * MiB, WS_WO = 12 * MiB, WS_WIN = 19 * MiB, WS_WMIX = 34 * MiB, WS_WQ = 36 * MiB, WS_WOX = 38 * MiB, WS_WKV = 40 * MiB,
                 WS_LORAT = 44 * MiB, WS_LRUT = 46 * MiB, WS_MEMB = 47 * MiB, WS_KB = 51 * MiB, WS_VT = 55 * MiB, WS_HB = 60 * MiB, WS_PRE = 93 * MiB, WS_XC = 125 * MiB + MiB / 2,
                 WS_PR = 158 * MiB, WS_PL = 263 * MiB, WS_GG = 296 * MiB, WS_SG0 = 329 * MiB, WS_GI = 362 * MiB, WS_WD = 395 * MiB, WS_AA = 428 * MiB,
                 WS_G = 461 * MiB, WS_L = 494 * MiB, WS_END = 503 * MiB;
static_assert(WS_G - WS_AA == WS_AA - WS_WD, "WD/AA/G spacing");
static_assert((size_t)MT * RP * 2 <= 105 * MiB && (size_t)MT * D * 2 <= 33 * MiB && (size_t)MT * D * 4 <= 65 * MiB && (size_t)MT * 256 * 2 <= 9 * MiB, "ws map");
constexpr size_t O_YP = 0, O_YS = 16777216, O_PMK = 16908288, O_PMV = 19005440, O_PRWKV = 21102592, O_PSHIFT = 21626880, O_PLRU = 21653504,
                 O_PCONV = 21661696, O_SRWKV = 21686272, O_SSHIFT = 30074880, O_SLRU = 30500864, O_SCONV = 30631936, O_TOTAL = 31025152;

constexpr int LDS_BYTES = 139264;

typedef __bf16 bf16x2_t __attribute__((ext_vector_type(2)));
__device__ __forceinline__ unsigned cvt_pk_bf16(float lo, float hi) { const f32x2 v = {lo, hi}; return __builtin_bit_cast(unsigned, __builtin_convertvector(v, bf16x2_t)); }
__device__ __forceinline__ bf16_t f2bf(float f) { return (bf16_t)(cvt_pk_bf16(f, 0.f) & 0xffffu); }
__device__ __forceinline__ float bf2f(bf16_t h) { return __uint_as_float(((unsigned)h) << 16); }
__device__ __forceinline__ f32x4 unpack4(u32x2 u) { return (f32x4){__uint_as_float(u.x << 16), __uint_as_float(u.x & 0xffff0000u), __uint_as_float(u.y << 16), __uint_as_float(u.y & 0xffff0000u)}; }
__device__ __forceinline__ u32x2 pack4(f32x4 v) { u32x2 r; r.x = cvt_pk_bf16(v.x, v.y); r.y = cvt_pk_bf16(v.z, v.w); return r; }
__device__ __forceinline__ float sigm(float x) { return 1.0f / (1.0f + __expf(-x)); }
__device__ __forceinline__ float silu(float x) { return x * sigm(x); }
__device__ __forceinline__ float tanh_(float x) { float e = __expf(2.0f * x); return 1.0f - 2.0f / (e + 1.0f); }
__device__ __forceinline__ float gelu_t(float x) { float u = 0.7978845608028654f * (x + 0.044715f * x * x * x); return 0.5f * x * (1.0f + tanh_(u)); }
__device__ __forceinline__ float softplus_(float x) { return x > 20.f ? x : log1pf(expf(x)); }
__device__ __forceinline__ float decay_e(float pre) { return 0.6065306597126334f * sigm(pre); }
template <int CTRL> __device__ __forceinline__ float dppf(float x) { return __builtin_bit_cast(float, __builtin_amdgcn_update_dpp(0, __builtin_bit_cast(int, x), CTRL, 0xf, 0xf, true)); }
__device__ __forceinline__ float red16(float x) {
    x += dppf<0xB1>(x); x += dppf<0x4E>(x); x += dppf<0x141>(x); x += dppf<0x140>(x); return x;
}
__device__ __forceinline__ int opaque(int x) { asm volatile("" : "+v"(x)); return x; }
__device__ __forceinline__ float dot4(f32x4 a, f32x4 b) { return (a.x * b.x + a.y * b.y) + (a.z * b.z + a.w * b.w); }
__device__ __forceinline__ float wave_sum(float v) {
#pragma unroll
    for (int o = 1; o < 64; o <<= 1) v += __shfl_xor(v, o);
    return v;
}
__device__ __forceinline__ float wave_max(float v) {
#pragma unroll
    for (int o = 1; o < 64; o <<= 1) v = fmaxf(v, __shfl_xor(v, o));
    return v;
}

namespace pg8 {
constexpr int BM = 256, BK = 64, HALF = 128, HTB = HALF * BK * 2, STAGE_BYTES = 8 * HTB, NXCD = 8, WGM = 8;
__host__ __device__ __forceinline__ int lds_byte(int r, int c) { const int st = (r >> 4) * 2 + (c >> 5), rr = r & 15, cc = c & 31, ob = rr * 64 + cc * 2; return st * 1024 + (ob ^ (((ob >> 9) & 1) << 5)); }
__host__ __device__ __forceinline__ void stage_rc(int b, int& R, int& C) { const int st = b / 1024, sb = b % 1024, swz = sb ^ (((sb >> 9) & 1) << 5); R = (st >> 1) * 16 + swz / 64; C = (st & 1) * 32 + (swz % 64) / 2; }
__host__ __device__ __forceinline__ int perm32(int rho) { const int n = rho >> 4, i = rho & 15; return 8 * (i >> 2) + 4 * n + (i & 3); }

struct Unit { int pm, pn; };
struct Gemm { const bf16_t* A; const bf16_t* Bt; int lda, ldb, K; };

struct Sched {
    int nM, nN, nwg, G, c, mode;
    long lda, ldb;
    __device__ void init(int nM_, int nN_, int G_, int c_, int mode_, int lda_, int ldb_) { nM = nM_; nN = nN_; nwg = nM * nN; G = G_; c = c_; mode = mode_; lda = lda_; ldb = ldb_; }
    __device__ bool next(int i, Unit& u) const {
        const int L = i * G + c; if (L >= nwg) return false;
        int wgid = L; { const int q = nwg / NXCD, r = nwg % NXCD, xcd = wgid % NXCD, off = wgid / NXCD; wgid = (xcd < r ? xcd * (q + 1) : r * (q + 1) + (xcd - r) * q) + off; }
        const int nig = WGM * nN, gid = wgid / nig, fm = gid * WGM, gsz = (nM - fm) < WGM ? (nM - fm) : WGM;
        u.pm = fm + ((wgid % nig) % gsz); u.pn = (wgid % nig) / gsz; return true;
    }
    __device__ __forceinline__ long aoff(const Unit& u) const {
        long o = (long)u.pm * 256 * lda;
        if (mode == 1) o += 256 * (u.pn >> 1); else if (mode >= 2) o += u.pn * 256;
        return o;
    }
    __device__ __forceinline__ long boff(const Unit& u) const {
        if (mode == 2) return (long)(u.pm >> 3) * 256 * ldb + u.pn * 256;
        if (mode == 3) return (long)u.pn * 256 * ldb + (u.pm >> 3) * 256;
        return (long)u.pn * 256 * ldb;
    }
};

template <class Epi>
__device__ __forceinline__ void gemm_phase(LAS unsigned char* lds, const Gemm g, const Sched& S, const Epi& E) {
    const int tid = opaque(threadIdx.x), wid = __builtin_amdgcn_readfirstlane(tid >> 6), lane = tid & 63, wr = wid >> 2, wc = wid & 3, fr = lane & 15, fq = lane >> 4;
    const int K = g.K, nt = K / BK;
    unsigned voffA[2], voffB[2];
#pragma unroll
    for (int i = 0; i < 2; ++i) { int R, C; stage_rc(tid * 16 + i * 8192, R, C); const int Rb = Epi::PERM ? ((R & ~31) + perm32(R & 31)) : R;
        voffA[i] = (unsigned)(R * g.lda + C) * 2u; voffB[i] = (unsigned)(Rb * g.ldb + C) * 2u; }
    const size_t kstep = (size_t)(BK * 2);
    const size_t hstepA = (size_t)HALF * g.lda * 2, hstepB = (size_t)HALF * g.ldb * 2;
    const unsigned ldsw = (unsigned)wid * 1024u;
    const int aoff = lds_byte(wr * 64 + fr, fq * 8), boff = lds_byte(wc * 32 + fr, fq * 8);
#define PG8_SA(b, h) (((b) * 2 + (h)) * HTB)
#define PG8_SB(b, h) ((4 + (b) * 2 + (h)) * HTB)
#define PG8_STAGE(bufoff, gbase, voff) do { _Pragma("unroll") for (int _i = 0; _i < 2; ++_i) \
        __builtin_amdgcn_global_load_lds((const unsigned*)((const char*)(gbase) + (voff)[_i]), (LAS unsigned*)(lds + (bufoff) + ldsw + _i * 8192), 16, 0, 0); } while (0)
#define PG8_LDA(dst, b, h) do { _Pragma("unroll") for (int m = 0; m < 4; ++m) _Pragma("unroll") for (int k = 0; k < 2; ++k) dst[m][k] = *(const LAS bf16x8*)(lds + PG8_SA(b, h) + aoff + m * 2048 + k * 1024); } while (0)
#define PG8_LDB(dst, b, h) do { _Pragma("unroll") for (int n = 0; n < 2; ++n) _Pragma("unroll") for (int k = 0; k < 2; ++k) dst[n][k] = *(const LAS bf16x8*)(lds + PG8_SB(b, h) + boff + n * 2048 + k * 1024); } while (0)
#define PG8_MMA(ai, bj, At, Bt) do { __builtin_amdgcn_s_setprio(1); _Pragma("unroll") for (int m = 0; m < 4; ++m) _Pragma("unroll") for (int n = 0; n < 2; ++n) _Pragma("unroll") for (int k = 0; k < 2; ++k) \
        acc[ai][bj][m][n] = __builtin_amdgcn_mfma_f32_16x16x32_bf16(Bt[n][k], At[m][k], acc[ai][bj][m][n], 0, 0, 0); __builtin_amdgcn_s_setprio(0); } while (0)
#define PG8_WAIT_V(n) asm volatile("s_waitcnt vmcnt(" #n ")" ::: "memory")
#define PG8_WAIT_L(n) asm volatile("s_waitcnt lgkmcnt(" #n ")" ::: "memory")
#define PG8_BAR __builtin_amdgcn_s_barrier()
#define PG8_SCHED __builtin_amdgcn_sched_barrier(0)
    Unit cur, nxt; int ui = 0;
    if (!S.next(0, cur)) return;
    f32x4 acc[2][2][4][2];
#pragma unroll
    for (int a = 0; a < 2; ++a)
#pragma unroll
        for (int b = 0; b < 2; ++b)
#pragma unroll
            for (int m = 0; m < 4; ++m)
#pragma unroll
                for (int n = 0; n < 2; ++n) acc[a][b][m][n] = (f32x4){0.f, 0.f, 0.f, 0.f};
    bf16x8 At[4][2], B0[2][2], B1[2][2];
    const char* cA = (const char*)g.A + (size_t)S.aoff(cur) * 2; const char* cB = (const char*)g.Bt + (size_t)S.boff(cur) * 2;
    PG8_STAGE(PG8_SB(0, 0), cB, voffB); PG8_STAGE(PG8_SB(0, 1), cB + hstepB, voffB); PG8_STAGE(PG8_SA(0, 0), cA, voffA); PG8_STAGE(PG8_SA(0, 1), cA + hstepA, voffA);
    if (wr == 1) PG8_BAR;
    PG8_WAIT_V(2); PG8_BAR;
    PG8_STAGE(PG8_SB(1, 0), cB + kstep, voffB); PG8_STAGE(PG8_SA(1, 0), cA + kstep, voffA); PG8_STAGE(PG8_SB(1, 1), cB + hstepB + kstep, voffB);
    PG8_WAIT_V(6); PG8_BAR;
    for (;;) {
        const bool has_next = S.next(ui + 1, nxt);
        const char* nA = has_next ? (const char*)g.A + (size_t)S.aoff(nxt) * 2 : cA; const char* nB = has_next ? (const char*)g.Bt + (size_t)S.boff(nxt) * 2 : cB;
        _Pragma("nounroll")
        for (int t = 0; t < nt; t += 2) {
            const bool last = (t == nt - 2);
            const char* a1 = cA + (size_t)(t + 1) * kstep;
            const char* a2 = last ? nA : cA + (size_t)(t + 2) * kstep; const char* b2 = last ? nB : cB + (size_t)(t + 2) * kstep;
            const char* a3 = a2 + kstep; const char* b3 = b2 + kstep;
            PG8_LDB(B0, 0, 0); PG8_LDB(B1, 0, 1); PG8_SCHED; PG8_LDA(At, 0, 0); PG8_STAGE(PG8_SA(1, 1), a1 + hstepA, voffA);
            PG8_WAIT_V(8); PG8_WAIT_L(0); PG8_BAR; PG8_MMA(0, 0, At, B0); PG8_MMA(0, 1, At, B1); PG8_BAR; PG8_SCHED;
            PG8_LDA(At, 0, 1); PG8_STAGE(PG8_SB(0, 0), b2, voffB); PG8_STAGE(PG8_SB(0, 1), b2 + hstepB, voffB); PG8_STAGE(PG8_SA(0, 0), a2, voffA);
            PG8_WAIT_V(8); PG8_WAIT_L(0); PG8_BAR; PG8_MMA(1, 0, At, B0); PG8_MMA(1, 1, At, B1); PG8_BAR; PG8_SCHED;
            PG8_LDB(B0, 1, 0); PG8_LDB(B1, 1, 1); PG8_SCHED; PG8_LDA(At, 1, 0); PG8_STAGE(PG8_SA(0, 1), a2 + hstepA, voffA);
            PG8_WAIT_V(8); PG8_WAIT_L(0); PG8_BAR; PG8_MMA(0, 0, At, B0); PG8_MMA(0, 1, At, B1); PG8_BAR; PG8_SCHED;
            PG8_LDA(At, 1, 1); PG8_STAGE(PG8_SB(1, 0), b3, voffB); PG8_STAGE(PG8_SB(1, 1), b3 + hstepB, voffB); PG8_STAGE(PG8_SA(1, 0), a3, voffA);
            PG8_WAIT_V(8); PG8_WAIT_L(0); PG8_BAR; PG8_MMA(1, 0, At, B0); PG8_MMA(1, 1, At, B1); PG8_BAR; PG8_SCHED;
        }
        if (wr == 0) PG8_BAR;
        if constexpr (!Epi::AFTER_DRAIN) { E(acc, cur, wr, wc, fr, fq); }
        if (!has_next) break;
#pragma unroll
        for (int a = 0; a < 2; ++a)
#pragma unroll
            for (int b = 0; b < 2; ++b)
#pragma unroll
                for (int m = 0; m < 4; ++m)
#pragma unroll
                    for (int n = 0; n < 2; ++n) acc[a][b][m][n] = (f32x4){0.f, 0.f, 0.f, 0.f};
        cur = nxt; cA = nA; cB = nB; ++ui;
        if (wr == 1) PG8_BAR;
    }
    PG8_WAIT_V(0);
    PG8_BAR;
    if constexpr (Epi::AFTER_DRAIN) { E.fused(acc, cur, wr, wc, fr, fq, lds, wid, lane); }
#undef PG8_SA
#undef PG8_SB
#undef PG8_STAGE
#undef PG8_LDA
#undef PG8_LDB
#undef PG8_MMA
#undef PG8_WAIT_V
#undef PG8_WAIT_L
#undef PG8_BAR
#undef PG8_SCHED
}

#define EPI_ROWS(ai, m) (u.pm * BM + (ai) * HALF + wr * 64 + (m) * 16 + fr)
typedef const f32x4 (&AccRef)[2][2][4][2];

struct EpiSwiglu {
    static constexpr bool PERM = true, AFTER_DRAIN = false;
    bf16_t* O;
    __device__ __forceinline__ void operator()(AccRef acc, const Unit& u, int wr, int wc, int fr, int fq) const {
        const int col0 = u.pn * 128 + wc * 32 + 8 * fq;
#pragma unroll
        for (int ai = 0; ai < 2; ++ai)
#pragma unroll
            for (int m = 0; m < 4; ++m) {
                const f32x4 g0 = acc[ai][0][m][0], g1 = acc[ai][0][m][1], u0 = acc[ai][1][m][0], u1 = acc[ai][1][m][1];
                u32x4 w;
                w.x = cvt_pk_bf16(silu(g0[0]) * u0[0], silu(g0[1]) * u0[1]); w.y = cvt_pk_bf16(silu(g0[2]) * u0[2], silu(g0[3]) * u0[3]);
                w.z = cvt_pk_bf16(silu(g1[0]) * u1[0], silu(g1[1]) * u1[1]); w.w = cvt_pk_bf16(silu(g1[2]) * u1[2], silu(g1[3]) * u1[3]);
                *(u32x4*)(O + (size_t)EPI_ROWS(ai, m) * FF + col0) = w;
            }
    }
};
struct EpiBf16 {
    static constexpr bool PERM = true, AFTER_DRAIN = false;
    bf16_t* O; int ldc; float scale;
    __device__ __forceinline__ void operator()(AccRef acc, const Unit& u, int wr, int wc, int fr, int fq) const {
        const int col0 = u.pn * BM + wc * 32 + 8 * fq;
#pragma unroll
        for (int ai = 0; ai < 2; ++ai)
#pragma unroll
            for (int m = 0; m < 4; ++m) { bf16_t* rowp = O + (size_t)EPI_ROWS(ai, m) * ldc + col0;
#pragma unroll
                for (int bj = 0; bj < 2; ++bj) { const f32x4 v0 = acc[ai][bj][m][0] * scale, v1 = acc[ai][bj][m][1] * scale;
                    u32x4 w; w.x = cvt_pk_bf16(v0[0], v0[1]); w.y = cvt_pk_bf16(v0[2], v0[3]); w.z = cvt_pk_bf16(v1[0], v1[1]); w.w = cvt_pk_bf16(v1[2], v1[3]);
                    *(u32x4*)(rowp + bj * HALF) = w; } }
    }
};
struct EpiProj {
    static constexpr bool PERM = true, AFTER_DRAIN = false;
    bf16_t *PR, *PL, *GG, *SG0;
    __device__ __forceinline__ void operator()(AccRef acc, const Unit& u, int wr, int wc, int fr, int fq) const {
        const int pn = u.pn, cw = wc * 32 + 8 * fq;
        if (pn >= 17 && pn < 25) {
            const int col0 = (pn - 17) * 128 + cw;
#pragma unroll
            for (int ai = 0; ai < 2; ++ai)
#pragma unroll
                for (int m = 0; m < 4; ++m) {
                    const f32x4 g0 = acc[ai][0][m][0], g1 = acc[ai][0][m][1], s0 = acc[ai][1][m][0], s1 = acc[ai][1][m][1];
                    u32x4 w;
                    w.x = cvt_pk_bf16(gelu_t(g0[0]) * sigm(s0[0]), gelu_t(g0[1]) * sigm(s0[1])); w.y = cvt_pk_bf16(gelu_t(g0[2]) * sigm(s0[2]), gelu_t(g0[3]) * sigm(s0[3]));
                    w.z = cvt_pk_bf16(gelu_t(g1[0]) * sigm(s1[0]), gelu_t(g1[1]) * sigm(s1[1])); w.w = cvt_pk_bf16(gelu_t(g1[2]) * sigm(s1[2]), gelu_t(g1[3]) * sigm(s1[3]));
                    *(u32x4*)(GG + (size_t)EPI_ROWS(ai, m) * D + col0) = w;
                }
        } else {
            bf16_t* base; int ldc, colt; bool sg = false;
            if (pn < 13) { base = PR; ldc = RP; colt = pn * 256; } else { ldc = D; sg = pn >= 17; colt = ((pn - 13) & 3) * 256; base = sg ? SG0 : PL; }
#pragma unroll
            for (int ai = 0; ai < 2; ++ai)
#pragma unroll
                for (int m = 0; m < 4; ++m) { bf16_t* rowp = base + (size_t)EPI_ROWS(ai, m) * ldc + colt + cw;
#pragma unroll
                    for (int bj = 0; bj < 2; ++bj) { f32x4 v0 = acc[ai][bj][m][0], v1 = acc[ai][bj][m][1];
                        if (sg) { v0 = (f32x4){sigm(v0[0]), sigm(v0[1]), sigm(v0[2]), sigm(v0[3])}; v1 = (f32x4){sigm(v1[0]), sigm(v1[1]), sigm(v1[2]), sigm(v1[3])}; }
                        u32x4 w; w.x = cvt_pk_bf16(v0[0], v0[1]); w.y = cvt_pk_bf16(v0[2], v0[3]); w.z = cvt_pk_bf16(v1[0], v1[1]); w.w = cvt_pk_bf16(v1[2], v1[3]);
                        *(u32x4*)(rowp + bj * HALF) = w; } }
        }
    }
};
struct EpiResid {
    static constexpr bool PERM = true, AFTER_DRAIN = false;
    const bf16_t* base; bf16_t* out; float s;
    __device__ __forceinline__ void operator()(AccRef acc, const Unit& u, int wr, int wc, int fr, int fq) const {
        const int col0 = u.pn * BM + wc * 32 + 8 * fq;
#pragma unroll
        for (int ai = 0; ai < 2; ++ai)
#pragma unroll
            for (int m = 0; m < 4; ++m) { const size_t off = (size_t)EPI_ROWS(ai, m) * D + col0;
#pragma unroll
                for (int bj = 0; bj < 2; ++bj) { const u32x4 bb = *(const u32x4*)(base + off + bj * HALF);
                    const f32x4 b0 = unpack4((u32x2){bb.x, bb.y}), b1 = unpack4((u32x2){bb.z, bb.w});
                    const f32x4 v0 = b0 * DN_ALPHA + acc[ai][bj][m][0] * s, v1 = b1 * DN_ALPHA + acc[ai][bj][m][1] * s;
                    u32x4 w; w.x = cvt_pk_bf16(v0[0], v0[1]); w.y = cvt_pk_bf16(v0[2], v0[3]); w.z = cvt_pk_bf16(v1[0], v1[1]); w.w = cvt_pk_bf16(v1[2], v1[3]);
                    *(u32x4*)(out + off + bj * HALF) = w; } }
    }
};
struct EpiKV {
    static constexpr bool PERM = false, AFTER_DRAIN = false;
    float *ok, *ov; bf16_t* KB;
    __device__ __forceinline__ void operator()(AccRef acc, const Unit& u, int wr, int wc, int fr, int fq) const {
        const bool isk = u.pn < 4; float* o = isk ? ok : ov; const int col0 = (u.pn & 3) * BM + wc * 32 + 4 * fq;
#pragma unroll
        for (int ai = 0; ai < 2; ++ai)
#pragma unroll
            for (int m = 0; m < 4; ++m) { const size_t off = (size_t)EPI_ROWS(ai, m) * D + col0;
#pragma unroll
                for (int bj = 0; bj < 2; ++bj)
#pragma unroll
                    for (int n = 0; n < 2; ++n) { const f32x4 v = acc[ai][bj][m][n]; *(f32x4*)(o + off + bj * HALF + n * 16) = v;
                        if (isk) *(u32x2*)(KB + off + bj * HALF + n * 16) = pack4(v); } }
    }
};
struct EpiLora {
    static constexpr bool PERM = true, AFTER_DRAIN = false;
    bf16_t *WD, *AA, *G; const float *w0, *a0;
    __device__ __forceinline__ void operator()(AccRef acc, const Unit& u, int wr, int wc, int fr, int fq) const {
        const int kind = u.pn >> 2, colt = (u.pn & 3) * 256 + wc * 32 + 8 * fq;
        bf16_t* base = WD + (size_t)kind * ((WS_AA - WS_WD) / 2);
        const float* bias = kind == 0 ? w0 : a0;
#pragma unroll
        for (int bj = 0; bj < 2; ++bj) {
            f32x4 b0 = (f32x4){0.f, 0.f, 0.f, 0.f}, b1 = b0;
            if (kind < 2) { b0 = *(const f32x4*)(bias + colt + bj * HALF); b1 = *(const f32x4*)(bias + colt + bj * HALF + 4); }
#pragma unroll
            for (int ai = 0; ai < 2; ++ai)
#pragma unroll
                for (int m = 0; m < 4; ++m) { f32x4 v0 = acc[ai][bj][m][0] + b0, v1 = acc[ai][bj][m][1] + b1;
                    if (kind == 0) { v0 = (f32x4){decay_e(v0[0]), decay_e(v0[1]), decay_e(v0[2]), decay_e(v0[3])}; v1 = (f32x4){decay_e(v1[0]), decay_e(v1[1]), decay_e(v1[2]), decay_e(v1[3])}; }
                    else if (kind == 1) { v0 = (f32x4){sigm(v0[0]), sigm(v0[1]), sigm(v0[2]), sigm(v0[3])}; v1 = (f32x4){sigm(v1[0]), sigm(v1[1]), sigm(v1[2]), sigm(v1[3])}; }
                    u32x4 w; w.x = cvt_pk_bf16(v0[0], v0[1]); w.y = cvt_pk_bf16(v0[2], v0[3]); w.z = cvt_pk_bf16(v1[0], v1[1]); w.w = cvt_pk_bf16(v1[2], v1[3]);
                    *(u32x4*)(base + (size_t)EPI_ROWS(ai, m) * D + colt + bj * HALF) = w; }
        }
    }
};
struct EpiLru {
    static constexpr bool PERM = true, AFTER_DRAIN = false;
    bf16_t *GR, *GI; const float *br, *bi;
    __device__ __forceinline__ void operator()(AccRef acc, const Unit& u, int wr, int wc, int fr, int fq) const {
        const int col0 = u.pn * 128 + wc * 32 + 8 * fq;
#pragma unroll
        for (int bj = 0; bj < 2; ++bj) {
            const float* bias = bj ? bi : br; bf16_t* base = bj ? GI : GR;
            const f32x4 b0 = *(const f32x4*)(bias + col0), b1 = *(const f32x4*)(bias + col0 + 4);
#pragma unroll
            for (int ai = 0; ai < 2; ++ai)
#pragma unroll
                for (int m = 0; m < 4; ++m) { const f32x4 v0 = acc[ai][bj][m][0] + b0, v1 = acc[ai][bj][m][1] + b1;
                    u32x4 w; w.x = cvt_pk_bf16(sigm(v0[0]), sigm(v0[1])); w.y = cvt_pk_bf16(sigm(v0[2]), sigm(v0[3])); w.z = cvt_pk_bf16(sigm(v1[0]), sigm(v1[1])); w.w = cvt_pk_bf16(sigm(v1[2]), sigm(v1[3]));
                    *(u32x4*)(base + (size_t)EPI_ROWS(ai, m) * D + col0) = w; }
        }
    }
};
struct EpiSoftmax {
    static constexpr bool PERM = true, AFTER_DRAIN = true;
    bf16_t* P;
    __device__ __forceinline__ void fused(f32x4 (&acc)[2][2][4][2], const Unit& u, int wr, int wc, int fr, int fq, LAS unsigned char* lds, int wid, int lane) const {
        LAS float* MX = (LAS float*)lds;
        LAS float* SM = (LAS float*)(lds + 4096);
#pragma unroll
        for (int ai = 0; ai < 2; ++ai)
#pragma unroll
            for (int m = 0; m < 4; ++m) {
                float mx = -3.0e38f;
#pragma unroll
                for (int bj = 0; bj < 2; ++bj)
#pragma unroll
                    for (int n = 0; n < 2; ++n) { const f32x4 x = acc[ai][bj][m][n]; mx = fmaxf(mx, fmaxf(fmaxf(x[0], x[1]), fmaxf(x[2], x[3]))); }
                mx = fmaxf(mx, __shfl_xor(mx, 16)); mx = fmaxf(mx, __shfl_xor(mx, 32));
                if (fq == 0) MX[(ai * HALF + wr * 64 + m * 16 + fr) * 4 + wc] = mx;
            }
        __syncthreads();
#pragma unroll
        for (int ai = 0; ai < 2; ++ai)
#pragma unroll
            for (int m = 0; m < 4; ++m) {
                const int rl = ai * HALF + wr * 64 + m * 16 + fr;
                const f32x4 mm = *(const LAS f32x4*)(MX + rl * 4);
                const float mx = fmaxf(fmaxf(mm[0], mm[1]), fmaxf(mm[2], mm[3]));
                float s = 0.f;
#pragma unroll
                for (int bj = 0; bj < 2; ++bj)
#pragma unroll
                    for (int n = 0; n < 2; ++n) { f32x4 x = acc[ai][bj][m][n];
                        x = (f32x4){__builtin_amdgcn_exp2f(x[0] - mx), __builtin_amdgcn_exp2f(x[1] - mx), __builtin_amdgcn_exp2f(x[2] - mx), __builtin_amdgcn_exp2f(x[3] - mx)};
                        acc[ai][bj][m][n] = x; s += (x[0] + x[1]) + (x[2] + x[3]); }
                s += __shfl_xor(s, 16); s += __shfl_xor(s, 32);
                if (fq == 0) SM[rl * 4 + wc] = s;
            }
        __syncthreads();
        const int col0 = u.pn * BM + wc * 32 + 8 * fq;
#pragma unroll
        for (int ai = 0; ai < 2; ++ai)
#pragma unroll
            for (int m = 0; m < 4; ++m) {
                const int rl = ai * HALF + wr * 64 + m * 16 + fr;
                const f32x4 ss = *(const LAS f32x4*)(SM + rl * 4);
                const float inv = 1.0f / ((ss[0] + ss[1]) + (ss[2] + ss[3]));
                bf16_t* rowp = P + (size_t)(u.pm * BM + rl) * D + col0;
#pragma unroll
                for (int bj = 0; bj < 2; ++bj) { const f32x4 v0 = acc[ai][bj][m][0] * inv, v1 = acc[ai][bj][m][1] * inv;
                    u32x4 w; w.x = cvt_pk_bf16(v0[0], v0[1]); w.y = cvt_pk_bf16(v0[2], v0[3]); w.z = cvt_pk_bf16(v1[0], v1[1]); w.w = cvt_pk_bf16(v1[2], v1[3]);
                    *(u32x4*)(rowp + bj * HALF) = w; }
            }
        __syncthreads();
    }
};
}

template <bool PAIR, class F>
__device__ __forceinline__ void skinny(const bf16_t* A, int lda, const bf16_t* Bt, int ldb, int K, int tile_lo, int tile_hi, int kmode, int bx, int G, int tid_, F f) {
    const int tid = opaque(tid_), lane = tid & 63, w = __builtin_amdgcn_readfirstlane(tid >> 6), fr = lane & 15, fq = lane >> 4;
    constexpr int GPT = PAIR ? 2 : 4;
    const int nunits = (tile_hi - tile_lo) * GPT * 4;
    for (int un = G - 1 - bx; un < nunits; un += G) {
        const int rbp = un & 3, cgrp = un >> 2, tile = tile_lo + cgrp / GPT, cgp = (cgrp % GPT) * 4 + (w & 3), rb = rbp * 2 + (w >> 2);
        const int n0 = tile * 256 + cgp * 16, row = MP + rb * 16 + fr;
        const bf16_t* ap = A + (size_t)row * lda + (kmode ? 256 * (tile >> 1) : 0) + fq * 8;
        const bf16_t* bp = Bt + (size_t)(n0 + fr) * ldb + fq * 8;
        f32x4 acc0 = (f32x4){0.f, 0.f, 0.f, 0.f}, acc1 = acc0;
        for (int k0 = 0; k0 < K; k0 += 256) {
#pragma unroll
            for (int kk = 0; kk < 256; kk += 32) {
                const bf16x8 a = *(const bf16x8*)(ap + k0 + kk), b = *(const bf16x8*)(bp + k0 + kk);
                acc0 = __builtin_amdgcn_mfma_f32_16x16x32_bf16(b, a, acc0, 0, 0, 0);
                if (PAIR) { const bf16x8 b2 = *(const bf16x8*)(bp + (size_t)128 * ldb + k0 + kk); acc1 = __builtin_amdgcn_mfma_f32_16x16x32_bf16(b2, a, acc1, 0, 0, 0); }
            }
        }
        f(row, tile, cgp * 16 + 4 * fq, acc0, acc1);
    }
}

__device__ __forceinline__ int map_row(int mapmode, int n) {
    if (mapmode == 1) { if (n < FF) return 256 * (n / 128) + (n % 128); const int q = n - FF; return 256 * (q / 128) + 128 + (q % 128); }
    if (mapmode == 2) { if (n < 4352) return n; if (n < 5376) { const int q = n - 4352; return 256 * (17 + q / 128) + (q % 128); }
                        if (n < 6400) return 256 * 25 + (n - 5376); const int q = n - 6400; return 256 * (17 + q / 128) + 128 + (q % 128); }
    return n;
}
__device__ __forceinline__ void transpose_item(const float* W, int K, int N, bf16_t* WT, int mapmode, LAS float* scr, int item, int lane) {
    const int nblk = N / 32, kb = item / nblk, nb = item % nblk, k0 = 64 * kb, n0 = 32 * nb;
#pragma unroll 8
    for (int i = 0; i < 32; ++i) { const int kk = 2 * i + (lane >> 5); scr[kk * 33 + (lane & 31)] = W[(size_t)(k0 + kk) * N + n0 + (lane & 31)]; }
    asm volatile("s_waitcnt lgkmcnt(0)" ::: "memory");
    const int c = lane & 7, d0 = map_row(mapmode, n0);
#pragma unroll
    for (int j = 0; j < 4; ++j) { const int n = (lane >> 3) + 8 * j; const LAS float* s = scr + (8 * c) * 33 + n;
        u32x4 o; o.x = cvt_pk_bf16(s[0 * 33], s[1 * 33]); o.y = cvt_pk_bf16(s[2 * 33], s[3 * 33]); o.z = cvt_pk_bf16(s[4 * 33], s[5 * 33]); o.w = cvt_pk_bf16(s[6 * 33], s[7 * 33]);
        *(u32x4*)(WT + (size_t)(d0 + n) * K + k0 + 8 * c) = o; }
    asm volatile("s_waitcnt lgkmcnt(0)" ::: "memory");
}

struct Args { const float* in[39]; float* out; unsigned char* ws; int ph_lo, ph_hi; };

__device__ __forceinline__ void ln_pass(const bf16_t* PRE, const float* g, const float* b, float* Hf, bf16_t* HB, int gw, int ngw, int lane) {
    f32x4 gv[4], bv[4];
#pragma unroll
    for (int j = 0; j < 4; ++j) { gv[j] = *(const f32x4*)(g + 256 * j + 4 * lane); bv[j] = *(const f32x4*)(b + 256 * j + 4 * lane); }
    int row = gw;
    u32x2 q[4], qn[4];
    if (row < MT) {
#pragma unroll
        for (int j = 0; j < 4; ++j) q[j] = *(const u32x2*)(PRE + (size_t)row * D + 4 * lane + 256 * j);
    }
    while (row < MT) {
        const int nrow = row + ngw;
        if (nrow < MT) {
#pragma unroll
            for (int j = 0; j < 4; ++j) qn[j] = *(const u32x2*)(PRE + (size_t)nrow * D + 4 * lane + 256 * j);
        }
        f32x4 v[4]; float s = 0.f;
#pragma unroll
        for (int j = 0; j < 4; ++j) { v[j] = unpack4(q[j]); s += (v[j].x + v[j].y) + (v[j].z + v[j].w); }
        const float mean = wave_sum(s) * (1.f / D); float s2 = 0.f;
#pragma unroll
        for (int j = 0; j < 4; ++j) { v[j] = v[j] - mean; s2 += (v[j].x * v[j].x + v[j].y * v[j].y) + (v[j].z * v[j].z + v[j].w * v[j].w); }
        const float rstd = 1.0f / sqrtf(wave_sum(s2) * (1.f / D) + LN_EPS);
#pragma unroll
        for (int j = 0; j < 4; ++j) { const f32x4 o = v[j] * rstd * gv[j] + bv[j];
            if (Hf) *(f32x4*)(Hf + (size_t)row * D + 256 * j + 4 * lane) = o;
            if (HB) *(u32x2*)(HB + (size_t)row * D + 256 * j + 4 * lane) = pack4(o); }
#pragma unroll
        for (int j = 0; j < 4; ++j) q[j] = qn[j];
        row = nrow;
    }
}

#define XB_TMO      128
#define XB_XCNT(j)  (256  + 64 * (j))
#define XB_XSUB(j)  (1280 + 64 * (j))
#define XB_XGEN(j)  (2304 + 64 * (j))
#define XB_TOP      3328
#define XB_TOPGEN   3392
#define XCD_BAR_WORDS 3456
#define XB_SPIN_CAP (1u << 22)
__device__ __forceinline__ unsigned xb_ld(unsigned* p)              { return __hip_atomic_load(p, __ATOMIC_RELAXED, __HIP_MEMORY_SCOPE_AGENT); }
__device__ __forceinline__ unsigned xb_add(unsigned* p, unsigned v) { return __hip_atomic_fetch_add(p, v, __ATOMIC_RELAXED, __HIP_MEMORY_SCOPE_AGENT); }
__device__ __forceinline__ unsigned xb_xcc_id() { return (unsigned)__builtin_amdgcn_s_getreg((3 << 11) | 20) & 0xFu; }
#define XB_SPIN(cond, bar) do { unsigned _sp = 0; while (cond) { __builtin_amdgcn_s_sleep(1); \
    if ((++_sp & 255u) == 0u) { if (xb_ld(&(bar)[XB_TMO])) break; if (_sp > XB_SPIN_CAP) { atomicAdd(&(bar)[XB_TMO], 1u); break; } } } } while (0)
__device__ __forceinline__ void xcd_barrier_complete(unsigned* bar, unsigned x, unsigned& nloc, unsigned& nx) {
    const unsigned G = gridDim.x;
    unsigned sum, cnt, mine, sp = 0u;
    for (;;) {
        sum = 0u; cnt = 0u; mine = 0u;
#pragma unroll
        for (unsigned j = 0; j < 16; ++j) { const unsigned c = xb_ld(&bar[XB_XCNT(j)]); sum += c; cnt += (c > 0u) ? 1u : 0u; mine = (j == x) ? c : mine; }
        if (sum == G) break;
        __builtin_amdgcn_s_sleep(1);
        if ((++sp & 255u) == 0u) { if (xb_ld(&bar[XB_TMO])) break; if (sp > XB_SPIN_CAP) { atomicAdd(&bar[XB_TMO], 1u); break; } }
    }
    nloc = mine > 0u ? mine : 1u; nx = cnt > 0u ? cnt : 1u;
}
__device__ __forceinline__ void xcd_barrier(unsigned* bar, volatile LAS unsigned* st) {
    asm volatile("s_waitcnt vmcnt(0) lgkmcnt(0)" ::: "memory");
    __syncthreads();
    if (threadIdx.x == 0) {
        __builtin_amdgcn_s_waitcnt(0);
        const unsigned x = xb_xcc_id();
        unsigned nloc = st[0], nx = st[1];
        if (nloc == 0u) { xcd_barrier_complete(bar, x, nloc, nx); st[0] = nloc; st[1] = nx; }
        const unsigned old = xb_add(&bar[XB_XSUB(x)], 1u);
        const unsigned gen = old / nloc;
        if (old + 1u == (gen + 1u) * nloc) {
            __builtin_amdgcn_fence(__ATOMIC_RELEASE, "agent");
            asm volatile("s_waitcnt vmcnt(0)" ::: "memory");
            const unsigned og = xb_add(&bar[XB_TOP], 1u);
            const unsigned tg = og / nx;
            if (og + 1u == (tg + 1u) * nx) xb_add(&bar[XB_TOPGEN], 1u);
            else XB_SPIN(xb_ld(&bar[XB_TOPGEN]) == tg, bar);
            __builtin_amdgcn_fence(__ATOMIC_ACQUIRE, "agent");
            xb_add(&bar[XB_XGEN(x)], 1u);
            asm volatile("s_waitcnt vmcnt(0)" ::: "memory");
        } else {
            XB_SPIN(xb_ld(&bar[XB_XGEN(x)]) == gen, bar);
            __builtin_amdgcn_fence(__ATOMIC_ACQUIRE, "agent");
            asm volatile("s_waitcnt vmcnt(0)" ::: "memory");
        }
    }
    __syncthreads();
}

#define PH_IDS const int tid = opaque(threadIdx.x), lane = tid & 63, wave = __builtin_amdgcn_readfirstlane(tid >> 6), gw = bx * NWAVES + wave, gt = bx * NTHR + tid; (void)lane; (void)gw; (void)gt; PH_PTRS
#define PH_PTRS \
    unsigned char* ws = args.ws; float* out = args.out; \
    bf16_t *WI = (bf16_t*)(ws + WS_WI), *WO = (bf16_t*)(ws + WS_WO), *WIN = (bf16_t*)(ws + WS_WIN), *WMIX = (bf16_t*)(ws + WS_WMIX), *WQ = (bf16_t*)(ws + WS_WQ), *WOX = (bf16_t*)(ws + WS_WOX), \
           *WKV = (bf16_t*)(ws + WS_WKV), *LORAT = (bf16_t*)(ws + WS_LORAT), *LRUT = (bf16_t*)(ws + WS_LRUT), *MEMB = (bf16_t*)(ws + WS_MEMB), *KB = (bf16_t*)(ws + WS_KB), *VT = (bf16_t*)(ws + WS_VT), \
           *HB = (bf16_t*)(ws + WS_HB), *PR = (bf16_t*)(ws + WS_PR), *PL = (bf16_t*)(ws + WS_PL), *GG = (bf16_t*)(ws + WS_GG), *SG0 = (bf16_t*)(ws + WS_SG0), *GI = (bf16_t*)(ws + WS_GI), \
           *WD = (bf16_t*)(ws + WS_WD), *AA = (bf16_t*)(ws + WS_AA), *GB = (bf16_t*)(ws + WS_G), *LB = (bf16_t*)(ws + WS_L); \
    bf16_t *ACT = PR, *XC = (bf16_t*)(ws + WS_XC), *MB = XC, *GR = PL, *LO = GI, *QB = PL, *PB = GG, *OB = SG0; \
    bf16_t *PRE = (bf16_t*)(ws + WS_PRE), *Y = PRE; float* H = out; \
    (void)WI; (void)WO; (void)WIN; (void)WMIX; (void)WQ; (void)WOX; (void)WKV; (void)LORAT; (void)LRUT; (void)MEMB; (void)KB; (void)VT; (void)HB; (void)PR; (void)PL; (void)GG; (void)SG0; (void)GI; \
    (void)WD; (void)AA; (void)GB; (void)LB; (void)ACT; (void)XC; (void)MB; (void)GR; (void)LO; (void)QB; (void)PB; (void)OB; (void)PRE; (void)Y; (void)H;
#define INP(k) (args.in[k])
#ifndef PHSEL
#define PHSEL(k) true
#endif
template <int ph>
__device__ __forceinline__ void run_phase(const Args& args, LAS unsigned char* lds, const int G, const int bx, const bool fin = true) {
    const int ngw = G * NWAVES, ngt = G * NTHR; (void)ngw; (void)ngt;
    switch (ph) {
    case 0: if (PHSEL(0)) { PH_IDS
        const float *x_prompt = INP(0), *x_sample = INP(1), *mem_prompt = INP(2), *decay_w2 = INP(18), *aaa_a2 = INP(20), *gate_g2 = INP(21), *lru_wr = INP(29), *lru_wi = INP(31);
        LAS float* scr = (LAS float*)(lds + wave * 16384);
        constexpr int I_WI = 16 * (2 * FF / 32), I_WO = (FF / 64) * 32, I_WIN = 16 * (PW / 32), I_SQ = 16 * 32;
        constexpr int NIT = I_WI + I_WO + I_WIN + 5 * I_SQ;
        for (int it = gw; it < NIT; it += ngw) {
            int r = it;
            if (r < I_WI) { transpose_item(INP(11), D, 2 * FF, WI, 1, scr, r, lane); continue; } r -= I_WI;
            if (r < I_WO) { transpose_item(INP(12), FF, D, WO, 0, scr, r, lane); continue; } r -= I_WO;
            if (r < I_WIN) { transpose_item(INP(15), D, PW, WIN, 2, scr, r, lane); continue; } r -= I_WIN;
            if (r < I_SQ) { transpose_item(INP(34), D, D, WMIX, 0, scr, r, lane); continue; } r -= I_SQ;
            if (r < I_SQ) { transpose_item(INP(35), D, D, WQ, 0, scr, r, lane); continue; } r -= I_SQ;
            if (r < I_SQ) { transpose_item(INP(36), D, D, WKV, 0, scr, r, lane); continue; } r -= I_SQ;
            if (r < I_SQ) { transpose_item(INP(37), D, D, WKV + (size_t)D * D, 0, scr, r, lane); continue; } r -= I_SQ;
            transpose_item(INP(38), D, D, WOX, 0, scr, r, lane);
        }
        for (int i = gt; i < 3072 * 256; i += ngt) { const int n = i >> 8, k = i & 255; float v = 0.f;
            if (n < 1024) { if (k < 64) v = decay_w2[k * 1024 + n]; } else if (n < 2048) { if (k >= 64 && k < 128) v = aaa_a2[(k - 64) * 1024 + (n - 1024)]; } else { if (k >= 128) v = gate_g2[(k - 128) * 1024 + (n - 2048)]; }
            LORAT[i] = f2bf(v); }
        for (int i = gt; i < 2048 * 256; i += ngt) { const int n = i >> 8, k = i & 255; const int q = n >> 8, bj = (n >> 7) & 1, j = n & 127;
            const int c = 128 * q + j, nb = c >> 6, d = c & 63; const int cin = 256 * (q >> 1) + k; float v = 0.f;
            if ((cin >> 6) == nb) v = (bj ? lru_wi : lru_wr)[(nb * 64 + (cin & 63)) * 64 + d];
            LRUT[i] = f2bf(v); }
        for (int i = gt; i < MT * D / 4; i += ngt) { const f32x4 v = (i < MP * D / 4) ? ((const f32x4*)x_prompt)[i] : ((const f32x4*)x_sample)[i - MP * D / 4];
            ((u32x2*)HB)[i] = pack4(v); }
        for (int i = gt; i < NB * 256 * D / 4; i += ngt) ((u32x2*)MEMB)[i] = pack4(((const f32x4*)mem_prompt)[i]);
    } break;

    case 1: case 16: if (PHSEL(1)) { PH_IDS
        { pg8::Gemm g{HB, WI, D, D, D}; pg8::Sched S; S.init(MP / 256, 2 * FF / 256, G, bx, 0, D, D); pg8::EpiSwiglu E{ACT}; pg8::gemm_phase(lds, g, S, E); }
        skinny<true>(HB, D, WI, D, D, 0, 2 * FF / 256, 0, bx, G, tid, [&](int row, int tile, int cin, f32x4 a, f32x4 b) {
            f32x4 o = (f32x4){silu(a[0]) * b[0], silu(a[1]) * b[1], silu(a[2]) * b[2], silu(a[3]) * b[3]};
            *(u32x2*)(ACT + (size_t)row * FF + tile * 128 + cin) = pack4(o); });
        if (ph == 1) {
        { pg8::Gemm g{MEMB, WKV, D, D, D}; pg8::Sched S; S.init(8, 8, G, G - 1 - bx, 0, D, D); pg8::EpiKV E{out + O_PMK, out + O_PMV, KB}; pg8::gemm_phase(lds, g, S, E); }
        { pg8::Gemm g{WKV + (size_t)D * D, MEMB, D, D, D}; pg8::Sched S; S.init(4, 8, G, (2 * G - 65 - bx) % G, 0, D, D); pg8::EpiBf16 E{VT, NB * 256, 1.0f}; pg8::gemm_phase(lds, g, S, E); }
        }
    } break;
    case 2: case 17: if (PHSEL(2)) { PH_IDS
        { pg8::Gemm g{ACT, WO, FF, FF, FF}; pg8::Sched S; S.init(MP / 256, D / 256, G, bx, 0, FF, FF); pg8::EpiResid E{HB, PRE, 0.5f}; pg8::gemm_phase(lds, g, S, E); }
        skinny<false>(ACT, FF, WO, FF, FF, 0, D / 256, 0, bx, G, tid, [&](int row, int tile, int cin, f32x4 a, f32x4) {
            const size_t off = (size_t)row * D + tile * 256 + cin; *(u32x2*)(PRE + off) = pack4(unpack4(*(const u32x2*)(HB + off)) * DN_ALPHA + a * 0.5f); });
    } break;
    case 3: case 10: case 15: case 18: if (PHSEL(3)) { PH_IDS
        const float *ln_g = INP(9), *ln_b = INP(10);
        const int li = ph == 3 ? 0 : (ph == 10 ? 1 : (ph == 15 ? 2 : 3));
        ln_pass(PRE, ln_g + li * D, ln_b + li * D, ph == 18 ? H : (float*)nullptr, ph == 18 ? (bf16_t*)nullptr : HB, gw, ngw, lane);
    } break;
    case 4: if (PHSEL(4)) { PH_IDS
        { pg8::Gemm g{HB, WIN, D, D, D}; pg8::Sched S; S.init(MP / 256, PW / 256, G, bx, 0, D, D); pg8::EpiProj E{PR, PL, GG, SG0}; pg8::gemm_phase(lds, g, S, E); }
        skinny<false>(HB, D, WIN, D, D, 0, 17, 0, bx, G, tid, [&](int row, int tile, int cin, f32x4 a, f32x4) {
            if (tile < 13) *(u32x2*)(PR + (size_t)row * RP + tile * 256 + cin) = pack4(a); else *(u32x2*)(PL + (size_t)row * D + (tile - 13) * 256 + cin) = pack4(a); });
        skinny<false>(HB, D, WIN, D, D, 25, 29, 0, bx, G, tid, [&](int row, int tile, int cin, f32x4 a, f32x4) {
            *(u32x2*)(SG0 + (size_t)row * D + (tile - 25) * 256 + cin) = pack4((f32x4){sigm(a[0]), sigm(a[1]), sigm(a[2]), sigm(a[3])}); });
        skinny<true>(HB, D, WIN, D, D, 17, 25, 0, bx, G, tid, [&](int row, int tile, int cin, f32x4 a, f32x4 b) {
            *(u32x2*)(GG + (size_t)row * D + (tile - 17) * 128 + cin) = pack4((f32x4){gelu_t(a[0]) * sigm(b[0]), gelu_t(a[1]) * sigm(b[1]), gelu_t(a[2]) * sigm(b[2]), gelu_t(a[3]) * sigm(b[3])}); });
    } break;
    case 5: if (PHSEL(5)) { PH_IDS
        const float *state_shift = INP(6), *state_conv = INP(8), *shift_mu = INP(16), *conv_w = INP(27), *conv_b = INP(28);
        for (int row = gw; row < MT; row += ngw) {
            const bool smp = row >= MP; const int t = row & (T - 1), b = row >> 11, si = row - MP;
            { const int c = 3072 + 4 * lane; const f32x4 p = unpack4(*(const u32x2*)(PR + (size_t)row * RP + c));
              f32x4 pv = (f32x4){0.f, 0.f, 0.f, 0.f};
              if (smp) pv = *(const f32x4*)(state_shift + (size_t)si * RP + c); else if (t > 0) pv = unpack4(*(const u32x2*)(PR + (size_t)(row - 1) * RP + c));
              const f32x4 mu = *(const f32x4*)(shift_mu + c); f32x4 xs = p + (pv - p) * mu;
              if (lane < 16) xs = (f32x4){tanh_(xs[0]), tanh_(xs[1]), tanh_(xs[2]), tanh_(xs[3])}; else if (lane >= 32) xs = (f32x4){sigm(xs[0]), sigm(xs[1]), sigm(xs[2]), sigm(xs[3])};
              *(u32x2*)(LB + (size_t)row * 256 + 4 * lane) = pack4(xs); }
#pragma unroll
            for (int j = 0; j < 4; ++j) { const int c = 256 * j + 4 * lane;
                const f32x4 p3 = unpack4(*(const u32x2*)(PL + (size_t)row * D + c));
                f32x4 p0 = (f32x4){0.f, 0.f, 0.f, 0.f}, p1 = p0, p2 = p0;
                if (smp) { p0 = *(const f32x4*)(state_conv + ((size_t)si * 3 + 0) * D + c); p1 = *(const f32x4*)(state_conv + ((size_t)si * 3 + 1) * D + c); p2 = *(const f32x4*)(state_conv + ((size_t)si * 3 + 2) * D + c); }
                else { if (t >= 3) p0 = unpack4(*(const u32x2*)(PL + (size_t)(row - 3) * D + c)); if (t >= 2) p1 = unpack4(*(const u32x2*)(PL + (size_t)(row - 2) * D + c)); if (t >= 1) p2 = unpack4(*(const u32x2*)(PL + (size_t)(row - 1) * D + c)); }
                const f32x4 xc = *(const f32x4*)(conv_b + c) + *(const f32x4*)(conv_w + c) * p0 + *(const f32x4*)(conv_w + D + c) * p1 + *(const f32x4*)(conv_w + 2 * D + c) * p2 + *(const f32x4*)(conv_w + 3 * D + c) * p3;
                *(u32x2*)(XC + (size_t)row * D + c) = pack4(xc);
                if (smp) { *(f32x4*)(out + O_SCONV + ((size_t)si * 3 + 0) * D + c) = p1; *(f32x4*)(out + O_SCONV + ((size_t)si * 3 + 1) * D + c) = p2; *(f32x4*)(out + O_SCONV + ((size_t)si * 3 + 2) * D + c) = p3; }
                else if (t >= T - 3) *(f32x4*)(out + O_PCONV + ((size_t)b * 3 + (t - (T - 3))) * D + c) = p3; }
            if (smp || t == T - 1) { float* dst = smp ? out + O_SSHIFT + (size_t)si * RP : out + O_PSHIFT + (size_t)b * RP;
                for (int c = 4 * lane; c < RP; c += 256) *(f32x4*)(dst + c) = unpack4(*(const u32x2*)(PR + (size_t)row * RP + c)); }
        }
    } break;
    case 6: if (PHSEL(6)) { PH_IDS
        const float *decay_w0 = INP(17), *aaa_a0 = INP(19), *lru_br = INP(30), *lru_bi = INP(32);
        { pg8::Gemm g{LB, LORAT, 256, 256, 256}; pg8::Sched S; S.init(MP / 256, 12, G, bx, 0, 256, 256); pg8::EpiLora E{WD, AA, GB, decay_w0, aaa_a0}; pg8::gemm_phase(lds, g, S, E); }
        { pg8::Gemm g{XC, LRUT, D, 256, 256}; pg8::Sched S; S.init(MP / 256, 8, G, bx, 1, D, 256); pg8::EpiLru E{GR, GI, lru_br, lru_bi}; pg8::gemm_phase(lds, g, S, E); }
        skinny<false>(LB, 256, LORAT, 256, 256, 0, 12, 0, bx, G, tid, [&](int row, int tile, int cin, f32x4 a, f32x4) {
            const int kind = tile >> 2, c = (tile & 3) * 256 + cin; f32x4 o = a;
            if (kind == 0) { const f32x4 bb = *(const f32x4*)(decay_w0 + c); o = (f32x4){decay_e(a[0] + bb[0]), decay_e(a[1] + bb[1]), decay_e(a[2] + bb[2]), decay_e(a[3] + bb[3])}; }
            else if (kind == 1) { const f32x4 bb = *(const f32x4*)(aaa_a0 + c); o = (f32x4){sigm(a[0] + bb[0]), sigm(a[1] + bb[1]), sigm(a[2] + bb[2]), sigm(a[3] + bb[3])}; }
            bf16_t* base = WD + (size_t)kind * ((WS_AA - WS_WD) / 2); *(u32x2*)(base + (size_t)row * D + c) = pack4(o); });
        skinny<true>(XC, D, LRUT, 256, 256, 0, 8, 1, bx, G, tid, [&](int row, int tile, int cin, f32x4 a, f32x4 b) {
            const int c = tile * 128 + cin; const f32x4 b0 = *(const f32x4*)(lru_br + c), b1 = *(const f32x4*)(lru_bi + c);
            *(u32x2*)(GR + (size_t)row * D + c) = pack4((f32x4){sigm(a[0] + b0[0]), sigm(a[1] + b0[1]), sigm(a[2] + b0[2]), sigm(a[3] + b0[3])});
            *(u32x2*)(GI + (size_t)row * D + c) = pack4((f32x4){sigm(b[0] + b1[0]), sigm(b[1] + b1[1]), sigm(b[2] + b1[2]), sigm(b[3] + b1[3])}); });
    } break;
    case 7: if (PHSEL(7)) { PH_IDS
        const float *state_rwkv = INP(5), *state_shift = INP(6), *state_lru = INP(7), *shift_mu = INP(16), *k_k = INP(22), *k_a = INP(23), *lru_lambda = INP(33);
        constexpr int TC = 32, VB = 6 * TC * 64;
        LAS float* VECb = (LAS float*)lds;
        LAS float* SCb = (LAS float*)(lds + 2 * VB * 4);
        LAS float* YBb = (LAS float*)(lds + 2 * VB * 4 + 512);
        for (int unit = bx; unit < 256; unit += G) {
            const int b = unit >> 5, h = (unit >> 1) & 15, half = unit & 1;
            const bool producer = wave >= 4;
            const int ptid = tid & 255, tt0 = ptid >> 4, cgq = ptid & 15, chb = h * 64 + 4 * cgq;
            f32x4 mu_r, mu_k, mu_v, kkc, kac;
            u32x2 q_r[2], q_k[2], q_v[2], q_rp[2], q_kp[2], q_vp[2], q_e[2], q_a[2];
            auto issue = [&](int chunk) {
#pragma unroll
                for (int it = 0; it < 2; ++it) {
                    const int tg = chunk * TC + tt0 + 16 * it; const size_t row = (size_t)b * T + tg; const bf16_t* base = PR + row * RP + chb;
                    q_r[it] = *(const u32x2*)(base); q_k[it] = *(const u32x2*)(base + 1024); q_v[it] = *(const u32x2*)(base + 2048);
                    if (tg > 0) { q_rp[it] = *(const u32x2*)(base - RP); q_kp[it] = *(const u32x2*)(base - RP + 1024); q_vp[it] = *(const u32x2*)(base - RP + 2048); }
                    else { q_rp[it] = (u32x2){0u, 0u}; q_kp[it] = q_rp[it]; q_vp[it] = q_rp[it]; }
                    q_e[it] = *(const u32x2*)(WD + row * D + chb); q_a[it] = *(const u32x2*)(AA + row * D + chb);
                }
            };
            auto derive = [&](int buf) {
                LAS float* V = VECb + buf * VB;
#pragma unroll
                for (int it = 0; it < 2; ++it) {
                    const int tt = tt0 + 16 * it;
                    const f32x4 pr = unpack4(q_r[it]), pk = unpack4(q_k[it]), pv = unpack4(q_v[it]);
                    const f32x4 r = pr + (unpack4(q_rp[it]) - pr) * mu_r, k = pk + (unpack4(q_kp[it]) - pk) * mu_k, v = pv + (unpack4(q_vp[it]) - pv) * mu_v;
                    const f32x4 e = unpack4(q_e[it]), a = unpack4(q_a[it]);
                    const f32x4 w = (f32x4){__expf(-e[0]), __expf(-e[1]), __expf(-e[2]), __expf(-e[3])};
                    f32x4 kk = k * kkc; const float n2 = red16(dot4(kk, kk)); kk = kk * (1.0f / fmaxf(sqrtf(n2), 1e-12f));
                    const f32x4 kp = k * (1.0f + (a - 1.0f) * kac), bv = kk * a, wrv = w * r;
                    const float br = red16(dot4(bv, r)), kr = red16(dot4(kp, r));
                    const int o = tt * 64 + 4 * cgq;
                    *(LAS f32x4*)(V + 0 * TC * 64 + o) = -kk; *(LAS f32x4*)(V + 1 * TC * 64 + o) = wrv; *(LAS f32x4*)(V + 2 * TC * 64 + o) = w;
                    *(LAS f32x4*)(V + 3 * TC * 64 + o) = bv; *(LAS f32x4*)(V + 4 * TC * 64 + o) = kp; *(LAS f32x4*)(V + 5 * TC * 64 + o) = v;
                    if (cgq == 0) *(LAS f32x2*)(SCb + buf * TC * 2 + 2 * tt) = (f32x2){br, kr};
                }
            };
            auto storeY = [&](int chunk, int buf) {
                const int t2 = ptid >> 3, r4 = (ptid & 7) * 4;
                *(u32x2*)(Y + ((size_t)b * T + chunk * TC + t2) * D + h * 64 + 32 * half + r4) = pack4(*(const LAS f32x4*)(YBb + buf * TC * 32 + t2 * 32 + r4));
            };
            const int r8 = lane >> 3, kq = lane & 7, rowl = 8 * (wave & 3) + r8, srow = 32 * half + rowl;
            f32x2 S0 = (f32x2){0.f, 0.f}, S1 = S0, S2 = S0, S3 = S0;
            if (producer) {
                mu_r = *(const f32x4*)(shift_mu + chb); mu_k = *(const f32x4*)(shift_mu + 1024 + chb); mu_v = *(const f32x4*)(shift_mu + 2048 + chb);
                kkc = *(const f32x4*)(k_k + chb); kac = *(const f32x4*)(k_a + chb);
                issue(0); derive(0); issue(1);
            }
            __syncthreads();
            for (int chunk = 0; chunk < T / TC; ++chunk) {
                const int buf = chunk & 1;
                if (producer) {
                    if (chunk > 0) storeY(chunk - 1, buf ^ 1);
                    if (chunk + 1 < T / TC) { derive(buf ^ 1); if (chunk + 2 < T / TC) issue(chunk + 2); }
                } else {
                    const LAS float* V = VECb + buf * VB + 8 * kq; const LAS float* SCp = SCb + buf * TC * 2;
                    LAS float* YBp = (kq == 0) ? (YBb + buf * TC * 32 + rowl) : (YBb + 2 * TC * 32 + wave * 64 + lane); const int ystr = (kq == 0) ? 32 : 0;
                    const LAS float* Vv = VECb + buf * VB + 5 * TC * 64 + srow;
#define SCAN_LOAD(X, t_) const LAS float* p##X = V + (t_) * 64; \
                        f32x4 nkA##X = *(const LAS f32x4*)(p##X), nkB##X = *(const LAS f32x4*)(p##X + 4), wrA##X = *(const LAS f32x4*)(p##X + 1 * TC * 64), wrB##X = *(const LAS f32x4*)(p##X + 1 * TC * 64 + 4), \
                              wA##X = *(const LAS f32x4*)(p##X + 2 * TC * 64), wB##X = *(const LAS f32x4*)(p##X + 2 * TC * 64 + 4), bA##X = *(const LAS f32x4*)(p##X + 3 * TC * 64), bB##X = *(const LAS f32x4*)(p##X + 3 * TC * 64 + 4), \
                              kA##X = *(const LAS f32x4*)(p##X + 4 * TC * 64), kB##X = *(const LAS f32x4*)(p##X + 4 * TC * 64 + 4); float vv##X = Vv[(t_) * 64]; f32x2 sc##X = *(const LAS f32x2*)(SCp + 2 * (t_));
#define SCAN_STEP(X, t_) { const f32x2 sc = sc##X; \
                        f32x2 da = S0 * (f32x2){nkA##X[0], nkA##X[1]}, db = S1 * (f32x2){nkA##X[2], nkA##X[3]}; da = S2 * (f32x2){nkB##X[0], nkB##X[1]} + da; db = S3 * (f32x2){nkB##X[2], nkB##X[3]} + db; \
                        f32x2 dz = S0 * (f32x2){wrA##X[0], wrA##X[1]}, dy = S1 * (f32x2){wrA##X[2], wrA##X[3]}; dz = S2 * (f32x2){wrB##X[0], wrB##X[1]} + dz; dy = S3 * (f32x2){wrB##X[2], wrB##X[3]} + dy; \
                        da = da + db; dz = dz + dy; \
                        float sa = da.x + da.y, z = dz.x + dz.y; \
                          \
                        const f32x2 vv2 = (f32x2){vv##X, vv##X}; \
                        const f32x2 T0 = S0 * (f32x2){wA##X[0], wA##X[1]} + (f32x2){kA##X[0], kA##X[1]} * vv2, T1 = S1 * (f32x2){wA##X[2], wA##X[3]} + (f32x2){kA##X[2], kA##X[3]} * vv2, \
                                    T2 = S2 * (f32x2){wB##X[0], wB##X[1]} + (f32x2){kB##X[0], kB##X[1]} * vv2, T3 = S3 * (f32x2){wB##X[2], wB##X[3]} + (f32x2){kB##X[2], kB##X[3]} * vv2; \
                        const float yb = vv##X * sc.y; \
                        sa += dppf<0xB1>(sa); z += dppf<0xB1>(z); sa += dppf<0x4E>(sa); z += dppf<0x4E>(z); sa += dppf<0x141>(sa); z += dppf<0x141>(z); \
                        const f32x2 sa2 = (f32x2){sa, sa}; \
                        S0 = (f32x2){bA##X[0], bA##X[1]} * sa2 + T0; S1 = (f32x2){bA##X[2], bA##X[3]} * sa2 + T1; S2 = (f32x2){bB##X[0], bB##X[1]} * sa2 + T2; S3 = (f32x2){bB##X[2], bB##X[3]} * sa2 + T3; \
                        const float y = (z + yb) + sa * sc.x; \
                        YBp[(t_) * ystr] = y; }
                    { SCAN_LOAD(a, 0)
#pragma unroll 1
                      for (int t = 0; t < TC; t += 2) {
                          SCAN_LOAD(b, t + 1)
                          __builtin_amdgcn_sched_barrier(0);
                          SCAN_STEP(a, t)
                          __builtin_amdgcn_sched_barrier(0);
                          { const LAS float* pn = V + (t + 2) * 64;
                            nkAa = *(const LAS f32x4*)(pn); nkBa = *(const LAS f32x4*)(pn + 4); wrAa = *(const LAS f32x4*)(pn + 1 * TC * 64); wrBa = *(const LAS f32x4*)(pn + 1 * TC * 64 + 4);
                            wAa = *(const LAS f32x4*)(pn + 2 * TC * 64); wBa = *(const LAS f32x4*)(pn + 2 * TC * 64 + 4); bAa = *(const LAS f32x4*)(pn + 3 * TC * 64); bBa = *(const LAS f32x4*)(pn + 3 * TC * 64 + 4);
                            kAa = *(const LAS f32x4*)(pn + 4 * TC * 64); kBa = *(const LAS f32x4*)(pn + 4 * TC * 64 + 4); vva = Vv[(t + 2) * 64]; sca = *(const LAS f32x2*)(SCp + 2 * (t + 2)); }
                          __builtin_amdgcn_sched_barrier(0);
                          SCAN_STEP(b, t + 1)
                          __builtin_amdgcn_sched_barrier(0);
                      } }
#undef SCAN_LOAD
#undef SCAN_STEP
                }
                __syncthreads();
            }
            if (producer) storeY(T / TC - 1, 1);
            else { float* sp = out + O_PRWKV + (((size_t)b * 16 + h) * 64 + srow) * 64 + 8 * kq;
                   *(f32x4*)(sp) = (f32x4){S0.x, S0.y, S1.x, S1.y}; *(f32x4*)(sp + 4) = (f32x4){S2.x, S2.y, S3.x, S3.y}; }
            __syncthreads();
        }
        if (fin) {
            LAS float* V1 = (LAS float*)(lds + wave * 2048);
            const int cgq = lane & 15;
            for (int un = gw; un < NS * 16; un += ngw) {
                const int i = un >> 4, h = un & 15, chb = h * 64 + 4 * cgq; const size_t row = (size_t)MP + i;
                const bf16_t* base = PR + row * RP + chb; const float* sb = state_shift + (size_t)i * RP + chb;
                const f32x4 pr = unpack4(*(const u32x2*)(base)), pk = unpack4(*(const u32x2*)(base + 1024)), pv = unpack4(*(const u32x2*)(base + 2048));
                const f32x4 r = pr + (*(const f32x4*)(sb) - pr) * *(const f32x4*)(shift_mu + chb), k = pk + (*(const f32x4*)(sb + 1024) - pk) * *(const f32x4*)(shift_mu + 1024 + chb),
                            v = pv + (*(const f32x4*)(sb + 2048) - pv) * *(const f32x4*)(shift_mu + 2048 + chb);
                const f32x4 e = unpack4(*(const u32x2*)(WD + row * D + chb)), a = unpack4(*(const u32x2*)(AA + row * D + chb));
                const f32x4 w = (f32x4){__expf(-e[0]), __expf(-e[1]), __expf(-e[2]), __expf(-e[3])};
                f32x4 kk = k * *(const f32x4*)(k_k + chb); const float n2 = red16(dot4(kk, kk)); kk = kk * (1.0f / fmaxf(sqrtf(n2), 1e-12f));
                const f32x4 kp = k * (1.0f + (a - 1.0f) * *(const f32x4*)(k_a + chb)), bv = kk * a, wrv = w * r;
                const float br = red16(dot4(bv, r)), kr = red16(dot4(kp, r));
                if (lane < 16) *(LAS f32x4*)(V1 + 320 + 4 * cgq) = v;
                asm volatile("s_waitcnt lgkmcnt(0)" ::: "memory");
                const f32x4 nk = -kk;
                const size_t sbase = ((size_t)i * 16 + h) * 4096;
#pragma unroll 4
                for (int rg = 0; rg < 16; ++rg) {
                    const int srow = 4 * rg + (lane >> 4);
                    f32x4 S = *(const f32x4*)(state_rwkv + sbase + srow * 64 + 4 * cgq);
                    const float vv = V1[320 + srow];
                    const float sa = red16(dot4(S, nk)), z = red16(dot4(S, wrv));
                    const float y = z + sa * br + vv * kr;
                    S = S * w + bv * sa + kp * vv;
                    *(f32x4*)(out + O_SRWKV + sbase + srow * 64 + 4 * cgq) = S;
                    if (cgq == 0) Y[row * D + h * 64 + srow] = f2bf(y);
                }
                asm volatile("s_waitcnt lgkmcnt(0)" ::: "memory");
            }
        }
        __syncthreads();
        if (fin) {
            LAS f32x2* sA = (LAS f32x2*)lds; LAS f32x2* sB = (LAS f32x2*)(lds + 4096);
            for (int unit = bx; unit < 128; unit += G) {
                const int b = unit >> 4, l32 = tid & 31, ch = (unit & 15) * 64 + 2 * l32, seg = tid >> 5, t0 = seg * 128;
                const f32x2 lam = *(const f32x2*)(lru_lambda + ch); const float sp0 = softplus_(-lam.x), sp1 = softplus_(-lam.y);
                const size_t base = ((size_t)b * T + t0) * D + ch;
                float A0 = 1.f, B0 = 0.f, A1 = 1.f, B1 = 0.f;
#pragma unroll 8
                for (int t = 0; t < 128; ++t) { const size_t o = base + (size_t)t * D;
                    const unsigned gr = *(const unsigned*)(GR + o), gi = *(const unsigned*)(GI + o), xc = *(const unsigned*)(XC + o);
                    const float la0 = -8.0f * __uint_as_float(gr << 16) * sp0, la1 = -8.0f * __uint_as_float(gr & 0xffff0000u) * sp1;
                    const float a0 = __expf(la0), a1 = __expf(la1);
                    const float b0 = sqrtf(fmaxf(1.0f - a0 * a0, 0.f)) * __uint_as_float(gi << 16) * __uint_as_float(xc << 16);
                    const float b1 = sqrtf(fmaxf(1.0f - a1 * a1, 0.f)) * __uint_as_float(gi & 0xffff0000u) * __uint_as_float(xc & 0xffff0000u);
                    A0 *= a0; B0 = a0 * B0 + b0; A1 *= a1; B1 = a1 * B1 + b1; }
                sA[seg * 32 + l32] = (f32x2){A0, A1}; sB[seg * 32 + l32] = (f32x2){B0, B1};
                __syncthreads();
                float h0 = 0.f, h1 = 0.f;
                for (int s2 = 0; s2 < seg; ++s2) { const f32x2 a = sA[s2 * 32 + l32], bb = sB[s2 * 32 + l32]; h0 = a.x * h0 + bb.x; h1 = a.y * h1 + bb.y; }
#pragma unroll 8
                for (int t = 0; t < 128; ++t) { const size_t o = base + (size_t)t * D;
                    const unsigned gr = *(const unsigned*)(GR + o), gi = *(const unsigned*)(GI + o), xc = *(const unsigned*)(XC + o), gg = *(const unsigned*)(GG + o);
                    const float la0 = -8.0f * __uint_as_float(gr << 16) * sp0, la1 = -8.0f * __uint_as_float(gr & 0xffff0000u) * sp1;
                    const float a0 = __expf(la0), a1 = __expf(la1);
                    const float b0 = sqrtf(fmaxf(1.0f - a0 * a0, 0.f)) * __uint_as_float(gi << 16) * __uint_as_float(xc << 16);
                    const float b1 = sqrtf(fmaxf(1.0f - a1 * a1, 0.f)) * __uint_as_float(gi & 0xffff0000u) * __uint_as_float(xc & 0xffff0000u);
                    h0 = a0 * h0 + b0; h1 = a1 * h1 + b1;
                    *(unsigned*)(LO + o) = cvt_pk_bf16(h0 * __uint_as_float(gg << 16), h1 * __uint_as_float(gg & 0xffff0000u)); }
                if (seg == 15) *(f32x2*)(out + O_PLRU + (size_t)b * D + ch) = (f32x2){h0, h1};
                __syncthreads();
            }
            for (int i = gt; i < NS * D; i += ngt) { const int ch = i & (D - 1); const size_t o = (size_t)MP * D + i;
                const float sp = softplus_(-lru_lambda[ch]);
                const float gr = bf2f(GR[o]), gi = bf2f(GI[o]), xc = bf2f(XC[o]), gg = bf2f(GG[o]);
                const float la = -8.0f * gr * sp, a = __expf(la), bb = sqrtf(fmaxf(-expm1f(2.0f * la), 0.f)) * gi * xc;
                const float hst = a * state_lru[i] + bb; out[O_SLRU + i] = hst; LO[o] = f2bf(hst * gg); }
        }
    } break;
    case 8: if (PHSEL(8)) { PH_IDS
        const float *state_shift = INP(6), *shift_mu = INP(16), *k_a = INP(23), *r_k = INP(24), *gn_g = INP(25), *gn_b = INP(26);
        for (int row = gw; row < MT; row += ngw) {
            const bool smp = row >= MP; const int t = row & (T - 1), si = row - MP;
#pragma unroll
            for (int j = 0; j < 4; ++j) { const int c = 256 * j + 4 * lane;
                const bf16_t* base = PR + (size_t)row * RP + c;
                const f32x4 pr = unpack4(*(const u32x2*)(base)), pk = unpack4(*(const u32x2*)(base + 1024)), pv = unpack4(*(const u32x2*)(base + 2048));
                f32x4 qr = (f32x4){0.f, 0.f, 0.f, 0.f}, qk = qr, qv = qr;
                if (smp) { const float* sb = state_shift + (size_t)si * RP + c; qr = *(const f32x4*)(sb); qk = *(const f32x4*)(sb + 1024); qv = *(const f32x4*)(sb + 2048); }
                else if (t > 0) { qr = unpack4(*(const u32x2*)(base - RP)); qk = unpack4(*(const u32x2*)(base - RP + 1024)); qv = unpack4(*(const u32x2*)(base - RP + 2048)); }
                const f32x4 r = pr + (qr - pr) * *(const f32x4*)(shift_mu + c), k = pk + (qk - pk) * *(const f32x4*)(shift_mu + 1024 + c), v = pv + (qv - pv) * *(const f32x4*)(shift_mu + 2048 + c);
                const f32x4 a = unpack4(*(const u32x2*)(AA + (size_t)row * D + c));
                const f32x4 kp = k * (1.0f + (a - 1.0f) * *(const f32x4*)(k_a + c));
                const float bon = red16(dot4(r * kp, *(const f32x4*)(r_k + c)));
                const f32x4 y = unpack4(*(const u32x2*)(Y + (size_t)row * D + c));
                const float mean = red16((y.x + y.y) + (y.z + y.w)) * (1.0f / 64.0f);
                const f32x4 dy = y - mean; const float var = red16(dot4(dy, dy)) * (1.0f / 64.0f);
                const f32x4 yn = dy * (1.0f / sqrtf(var + GN_EPS)) * *(const f32x4*)(gn_g + c) + *(const f32x4*)(gn_b + c);
                const f32x4 gg = unpack4(*(const u32x2*)(GB + (size_t)row * D + c)), s0 = unpack4(*(const u32x2*)(SG0 + (size_t)row * D + c)), lo_ = unpack4(*(const u32x2*)(LO + (size_t)row * D + c));
                const f32x4 mg = s0 * ((yn + v * bon) * gg) + lo_;
                *(u32x2*)(MB + (size_t)row * D + c) = pack4(mg); }
        }
        __syncthreads();
        { LAS float* scr = (LAS float*)(lds + wave * 16384);
          constexpr int I_WI = 16 * (2 * FF / 32), I_WO = (FF / 64) * 32;
          for (int it = gw; it < I_WI + I_WO; it += ngw) { if (it < I_WI) transpose_item(INP(13), D, 2 * FF, WI, 1, scr, it, lane); else transpose_item(INP(14), FF, D, WO, 0, scr, it - I_WI, lane); } }
    } break;
    case 9: case 14: if (PHSEL(9)) { PH_IDS
        const bf16_t* Am = ph == 9 ? MB : OB; const bf16_t* Wt = ph == 9 ? WMIX : WOX;
        { pg8::Gemm g{Am, Wt, D, D, D}; pg8::Sched S; S.init(MP / 256, D / 256, G, bx, 0, D, D); pg8::EpiResid E{HB, PRE, 1.0f}; pg8::gemm_phase(lds, g, S, E); }
        skinny<false>(Am, D, Wt, D, D, 0, D / 256, 0, bx, G, tid, [&](int row, int tile, int cin, f32x4 a, f32x4) {
            const size_t off = (size_t)row * D + tile * 256 + cin; *(u32x2*)(PRE + off) = pack4(unpack4(*(const u32x2*)(HB + off)) * DN_ALPHA + a); });
    } break;
    case 11: if (PHSEL(11)) { PH_IDS
        const float qs = 0.0625f * 1.4426950408889634f;
        { pg8::Gemm g{HB, WQ, D, D, D}; pg8::Sched S; S.init(MP / 256, D / 256, G, bx, 0, D, D); pg8::EpiBf16 E{QB, D, qs}; pg8::gemm_phase(lds, g, S, E); }
        skinny<false>(HB, D, WQ, D, D, 0, D / 256, 0, bx, G, tid, [&](int row, int tile, int cin, f32x4 a, f32x4) { *(u32x2*)(QB + (size_t)row * D + tile * 256 + cin) = pack4(a * qs); });
    } break;
    case 12: if (PHSEL(12)) { PH_IDS
        const float *cache_k = INP(3), *cache_v = INP(4);
        { pg8::Gemm g{QB, KB, D, D, 256}; pg8::Sched S; S.init(MP / 256, 4, G, bx, 2, D, D); pg8::EpiSoftmax E{PB}; pg8::gemm_phase(lds, g, S, E); }
        __syncthreads();
        LAS float* sS = (LAS float*)lds;
        LAS float* sO = (LAS float*)(lds + 4096);
        for (int un = bx; un < NS * 4; un += G) {
            const int i = un >> 2, h = un & 3;
            const f32x4 q = unpack4(*(const u32x2*)(QB + (size_t)(MP + i) * D + h * 256 + 4 * lane));
            const float* kb = cache_k + ((size_t)i * 256 * 4 + h) * 256 + 4 * lane;
            const float* vb = cache_v + ((size_t)i * 256 * 4 + h) * 256 + 4 * lane;
#pragma unroll 8
            for (int mm = 0; mm < 32; ++mm) { const int m = wave * 32 + mm; const f32x4 kx = *(const f32x4*)(kb + (size_t)m * 1024);
                const float s = wave_sum(dot4(q, kx)); if (lane == 0) sS[m] = s; }
            __syncthreads();
            float mx = -3.0e38f;
#pragma unroll
            for (int j = 0; j < 4; ++j) mx = fmaxf(mx, sS[lane + 64 * j]);
            mx = wave_max(mx);
            float sum = 0.f;
#pragma unroll
            for (int j = 0; j < 4; ++j) sum += __builtin_amdgcn_exp2f(sS[lane + 64 * j] - mx);
            sum = wave_sum(sum); const float inv = 1.0f / sum;
            f32x4 o = (f32x4){0.f, 0.f, 0.f, 0.f};
#pragma unroll 8
            for (int mm = 0; mm < 32; ++mm) { const int m = wave * 32 + mm; const f32x4 vx = *(const f32x4*)(vb + (size_t)m * 1024);
                const float p = __builtin_amdgcn_exp2f(sS[m] - mx) * inv; o = o + vx * p; }
            *(LAS f32x4*)(sO + wave * 256 + 4 * lane) = o;
            __syncthreads();
            if (tid < 256) { float acc = 0.f;
#pragma unroll
                for (int w8 = 0; w8 < 8; ++w8) acc += sO[w8 * 256 + tid];
                OB[(size_t)(MP + i) * D + h * 256 + tid] = f2bf(acc); }
            __syncthreads();
        }
    } break;
    case 13: if (PHSEL(13)) { PH_IDS pg8::Gemm g{PB, VT, D, NB * 256, 256}; pg8::Sched S; S.init(MP / 256, 4, G, bx, 3, D, NB * 256); pg8::EpiBf16 E{OB, D, 1.0f}; pg8::gemm_phase(lds, g, S, E); } break;
    default: break;
    }
}

__global__ void __launch_bounds__(NTHR, 2) mega(Args args) {
    extern __shared__ __attribute__((aligned(16))) unsigned char lds_raw[];
    LAS unsigned char* lds = (LAS unsigned char*)lds_raw;
    cg::grid_group grid = cg::this_grid();
    const int G = gridDim.x, bx = blockIdx.x;
    const int lo = args.ph_lo, hi = args.ph_hi;
    unsigned* const bar = (unsigned*)args.ws;
    volatile LAS unsigned* const bst = (volatile LAS unsigned*)(lds + 131072 + 64);
    if (threadIdx.x < 2) bst[threadIdx.x] = 0u;
    if (threadIdx.x == 0) (void)xb_add(&bar[XB_XCNT(xb_xcc_id())], 1u);
    grid.sync();
#ifndef DUPK
#define DUPK -1
#endif
#define GSYNC() xcd_barrier(bar, bst)
#define RUN(k) if (lo <= (k) && (k) < hi) { if ((k) == DUPK) { run_phase<k>(args, lds, G, bx, false); GSYNC(); } run_phase<k>(args, lds, G, bx); if ((k) + 1 < hi) GSYNC(); }
    RUN(0) RUN(1) RUN(2) RUN(3) RUN(4) RUN(5) RUN(6) RUN(7) RUN(8) RUN(9) RUN(10) RUN(11) RUN(12) RUN(13) RUN(14) RUN(15) RUN(16) RUN(17) RUN(18)
#undef RUN
}

#ifndef N_LAUNCH_PER_PHASE
#define N_LAUNCH_PER_PHASE 0
#endif
extern "C" void kernel_launch(void* const* d_in, const int* in_sizes, int n_in, void* d_out, int out_size, void* d_ws, size_t ws_size, hipStream_t stream) {
    static int grid = 0;
    if (grid == 0) {
        if (n_in != 39 || out_size != (int)O_TOTAL || ws_size < WS_END) { fprintf(stderr, "kernel_launch: unexpected shapes (n_in %d out %d ws %zu)\n", n_in, out_size, ws_size); grid = -1; return; }
        int dev = 0, cus = 0, per_cu = 0;
        hipGetDevice(&dev); hipDeviceGetAttribute(&cus, hipDeviceAttributeMultiprocessorCount, dev);
        hipFuncSetAttribute((const void*)mega, hipFuncAttributeMaxDynamicSharedMemorySize, LDS_BYTES);
        hipOccupancyMaxActiveBlocksPerMultiprocessor(&per_cu, (const void*)mega, NTHR, LDS_BYTES);
        if (per_cu < 1) { fprintf(stderr, "kernel_launch: occupancy query says 0 blocks per CU\n"); grid = -1; return; }
        grid = cus;
    }
    if (grid < 0) return;
    if (hipMemsetAsync(d_ws, 0, 65536, stream) != hipSuccess) { fprintf(stderr, "kernel_launch: memset of control words failed\n"); return; }
    Args a{};
    for (int i = 0; i < 39; ++i) a.in[i] = (const float*)d_in[i];
    a.out = (float*)d_out; a.ws = (unsigned char*)d_ws;
#if N_LAUNCH_PER_PHASE
    for (int p = 0; p < 19; ++p) { a.ph_lo = p; a.ph_hi = p + 1; void* kargs[] = {&a};
        hipLaunchCooperativeKernel((const void*)mega, dim3(grid), dim3(NTHR), kargs, LDS_BYTES, stream); }
#else
    a.ph_lo = 0; a.ph_hi = 19; void* kargs[] = {&a};
    hipError_t e = hipLaunchCooperativeKernel((const void*)mega, dim3(grid), dim3(NTHR), kargs, LDS_BYTES, stream);
    if (e != hipSuccess) fprintf(stderr, "cooperative launch failed: %s (grid %d)\n", hipGetErrorString(e), grid);
#endif
}
```

```cpp
#include <hip/hip_runtime.h>
#include <hip/hip_cooperative_groups.h>
#include <cstdio>
#include <cstdint>
namespace cg = cooperative_groups;

#define LAS __attribute__((address_space(3)))
typedef unsigned short bf16_t;
typedef short bf16x8 __attribute__((ext_vector_type(8)));
typedef float f32x4 __attribute__((ext_vector_type(4)));
typedef float f32x2 __attribute__((ext_vector_type(2)));
typedef unsigned u32x4 __attribute__((ext_vector_type(4)));
typedef unsigned u32x2 __attribute__((ext_vector_type(2)));

constexpr int D = 1024, T = 2048, NB = 8, MP = NB * T, NS = 128, MT = MP + NS, FF = 2816, RP = 3328, PW = 7424;
constexpr int NWAVES = 8, NTHR = 512;
constexpr float DN_ALPHA = 1.189207115002721f;
constexpr float LN_EPS = 1e-5f, GN_EPS = 64e-5f;

constexpr size_t MiB = 1u << 20;
constexpr size_t WS_WI = 1 * MiB, WS_WO = 12 * MiB, WS_WIN = 19 * MiB, WS_WMIX = 34 * MiB, WS_WQ = 36 * MiB, WS_WOX = 38 * MiB, WS_WKV = 40 * MiB,
                 WS_LORAT = 44 * MiB, WS_LRUT = 46 * MiB, WS_MEMB = 47 * MiB, WS_KB = 51 * MiB, WS_VT = 55 * MiB, WS_HB = 60 * MiB, WS_PRE = 93 * MiB, WS_XC = 125 * MiB + MiB / 2,
                 WS_PR = 158 * MiB, WS_PL = 263 * MiB, WS_GG = 296 * MiB, WS_SG0 = 329 * MiB, WS_GI = 362 * MiB, WS_WD = 395 * MiB, WS_AA = 428 * MiB,
                 WS_G = 461 * MiB, WS_L = 494 * MiB, WS_END = 503 * MiB;
static_assert(WS_G - WS_AA == WS_AA - WS_WD, "WD/AA/G spacing");
static_assert((size_t)MT * RP * 2 <= 105 * MiB && (size_t)MT * D * 2 <= 33 * MiB && (size_t)MT * D * 4 <= 65 * MiB && (size_t)MT * 256 * 2 <= 9 * MiB, "ws map");
constexpr size_t O_YP = 0, O_YS = 16777216, O_PMK = 16908288, O_PMV = 19005440, O_PRWKV = 21102592, O_PSHIFT = 21626880, O_PLRU = 21653504,
                 O_PCONV = 21661696, O_SRWKV = 21686272, O_SSHIFT = 30074880, O_SLRU = 30500864, O_SCONV = 30631936, O_TOTAL = 31025152;

constexpr int LDS_BYTES = 139264;

typedef __bf16 bf16x2_t __attribute__((ext_vector_type(2)));
__device__ __forceinline__ unsigned cvt_pk_bf16(float lo, float hi) { const f32x2 v = {lo, hi}; return __builtin_bit_cast(unsigned, __builtin_convertvector(v, bf16x2_t)); }
__device__ __forceinline__ bf16_t f2bf(float f) { return (bf16_t)(cvt_pk_bf16(f, 0.f) & 0xffffu); }
__device__ __forceinline__ float bf2f(bf16_t h) { return __uint_as_float(((unsigned)h) << 16); }
__device__ __forceinline__ f32x4 unpack4(u32x2 u) { return (f32x4){__uint_as_float(u.x << 16), __uint_as_float(u.x & 0xffff0000u), __uint_as_float(u.y << 16), __uint_as_float(u.y & 0xffff0000u)}; }
__device__ __forceinline__ u32x2 pack4(f32x4 v) { u32x2 r; r.x = cvt_pk_bf16(v.x, v.y); r.y = cvt_pk_bf16(v.z, v.w); return r; }
__device__ __forceinline__ float sigm(float x) { return 1.0f / (1.0f + __expf(-x)); }
__device__ __forceinline__ float silu(float x) { return x * sigm(x); }
__device__ __forceinline__ float tanh_(float x) { float e = __expf(2.0f * x); return 1.0f - 2.0f / (e + 1.0f); }
__device__ __forceinline__ float gelu_t(float x) { float u = 0.7978845608028654f * (x + 0.044715f * x * x * x); return 0.5f * x * (1.0f + tanh_(u)); }
__device__ __forceinline__ float softplus_(float x) { return x > 20.f ? x : log1pf(expf(x)); }
__device__ __forceinline__ float decay_e(float pre) { return 0.6065306597126334f * sigm(pre); }
template <int CTRL> __device__ __forceinline__ float dppf(float x) { return __builtin_bit_cast(float, __builtin_amdgcn_update_dpp(0, __builtin_bit_cast(int, x), CTRL, 0xf, 0xf, true)); }
__device__ __forceinline__ float red16(float x) {
    x += dppf<0xB1>(x); x += dppf<0x4E>(x); x += dppf<0x141>(x); x += dppf<0x140>(x); return x;
}
__device__ __forceinline__ int opaque(int x) { asm volatile("" : "+v"(x)); return x; }
__device__ __forceinline__ float dot4(f32x4 a, f32x4 b) { return (a.x * b.x + a.y * b.y) + (a.z * b.z + a.w * b.w); }
__device__ __forceinline__ float wave_sum(float v) {
#pragma unroll
    for (int o = 1; o < 64; o <<= 1) v += __shfl_xor(v, o);
    return v;
}
__device__ __forceinline__ float wave_max(float v) {
#pragma unroll
    for (int o = 1; o < 64; o <<= 1) v = fmaxf(v, __shfl_xor(v, o));
    return v;
}

namespace pg8 {
constexpr int BM = 256, BK = 64, HALF = 128, HTB = HALF * BK * 2, STAGE_BYTES = 8 * HTB, NXCD = 8, WGM = 8;
__host__ __device__ __forceinline__ int lds_byte(int r, int c) { const int st = (r >> 4) * 2 + (c >> 5), rr = r & 15, cc = c & 31, ob = rr * 64 + cc * 2; return st * 1024 + (ob ^ (((ob >> 9) & 1) << 5)); }
__host__ __device__ __forceinline__ void stage_rc(int b, int& R, int& C) { const int st = b / 1024, sb = b % 1024, swz = sb ^ (((sb >> 9) & 1) << 5); R = (st >> 1) * 16 + swz / 64; C = (st & 1) * 32 + (swz % 64) / 2; }
__host__ __device__ __forceinline__ int perm32(int rho) { const int n = rho >> 4, i = rho & 15; return 8 * (i >> 2) + 4 * n + (i & 3); }

struct Unit { int pm, pn; };
struct Gemm { const bf16_t* A; const bf16_t* Bt; int lda, ldb, K; };

struct Sched {
    int nM, nN, nwg, G, c, mode;
    long lda, ldb;
    __device__ void init(int nM_, int nN_, int G_, int c_, int mode_, int lda_, int ldb_) { nM = nM_; nN = nN_; nwg = nM * nN; G = G_; c = c_; mode = mode_; lda = lda_; ldb = ldb_; }
    __device__ bool next(int i, Unit& u) const {
        const int L = i * G + c; if (L >= nwg) return false;
        int wgid = L; { const int q = nwg / NXCD, r = nwg % NXCD, xcd = wgid % NXCD, off = wgid / NXCD; wgid = (xcd < r ? xcd * (q + 1) : r * (q + 1) + (xcd - r) * q) + off; }
        const int nig = WGM * nN, gid = wgid / nig, fm = gid * WGM, gsz = (nM - fm) < WGM ? (nM - fm) : WGM;
        u.pm = fm + ((wgid % nig) % gsz); u.pn = (wgid % nig) / gsz; return true;
    }
    __device__ __forceinline__ long aoff(const Unit& u) const {
        long o = (long)u.pm * 256 * lda;
        if (mode == 1) o += 256 * (u.pn >> 1); else if (mode >= 2) o += u.pn * 256;
        return o;
    }
    __device__ __forceinline__ long boff(const Unit& u) const {
        if (mode == 2) return (long)(u.pm >> 3) * 256 * ldb + u.pn * 256;
        if (mode == 3) return (long)u.pn * 256 * ldb + (u.pm >> 3) * 256;
        return (long)u.pn * 256 * ldb;
    }
};

template <class Epi>
__device__ __forceinline__ void gemm_phase(LAS unsigned char* lds, const Gemm g, const Sched& S, const Epi& E) {
    const int tid = opaque(threadIdx.x), wid = __builtin_amdgcn_readfirstlane(tid >> 6), lane = tid & 63, wr = wid >> 2, wc = wid & 3, fr = lane & 15, fq = lane >> 4;
    const int K = g.K, nt = K / BK;
    unsigned voffA[2], voffB[2];
#pragma unroll
    for (int i = 0; i < 2; ++i) { int R, C; stage_rc(tid * 16 + i * 8192, R, C); const int Rb = Epi::PERM ? ((R & ~31) + perm32(R & 31)) : R;
        voffA[i] = (unsigned)(R * g.lda + C) * 2u; voffB[i] = (unsigned)(Rb * g.ldb + C) * 2u; }
    const size_t kstep = (size_t)(BK * 2);
    const size_t hstepA = (size_t)HALF * g.lda * 2, hstepB = (size_t)HALF * g.ldb * 2;
    const unsigned ldsw = (unsigned)wid * 1024u;
    const int aoff = lds_byte(wr * 64 + fr, fq * 8), boff = lds_byte(wc * 32 + fr, fq * 8);
#define PG8_SA(b, h) (((b) * 2 + (h)) * HTB)
#define PG8_SB(b, h) ((4 + (b) * 2 + (h)) * HTB)
#define PG8_STAGE(bufoff, gbase, voff) do { _Pragma("unroll") for (int _i = 0; _i < 2; ++_i) \
        __builtin_amdgcn_global_load_lds((const unsigned*)((const char*)(gbase) + (voff)[_i]), (LAS unsigned*)(lds + (bufoff) + ldsw + _i * 8192), 16, 0, 0); } while (0)
#define PG8_LDA(dst, b, h) do { _Pragma("unroll") for (int m = 0; m < 4; ++m) _Pragma("unroll") for (int k = 0; k < 2; ++k) dst[m][k] = *(const LAS bf16x8*)(lds + PG8_SA(b, h) + aoff + m * 2048 + k * 1024); } while (0)
#define PG8_LDB(dst, b, h) do { _Pragma("unroll") for (int n = 0; n < 2; ++n) _Pragma("unroll") for (int k = 0; k < 2; ++k) dst[n][k] = *(const LAS bf16x8*)(lds + PG8_SB(b, h) + boff + n * 2048 + k * 1024); } while (0)
#define PG8_MMA(ai, bj, At, Bt) do { __builtin_amdgcn_s_setprio(1); _Pragma("unroll") for (int m = 0; m < 4; ++m) _Pragma("unroll") for (int n = 0; n < 2; ++n) _Pragma("unroll") for (int k = 0; k < 2; ++k) \
        acc[ai][bj][m][n] = __builtin_amdgcn_mfma_f32_16x16x32_bf16(Bt[n][k], At[m][k], acc[ai][bj][m][n], 0, 0, 0); __builtin_amdgcn_s_setprio(0); } while (0)
#define PG8_WAIT_V(n) asm volatile("s_waitcnt vmcnt(" #n ")" ::: "memory")
#define PG8_WAIT_L(n) asm volatile("s_waitcnt lgkmcnt(" #n ")" ::: "memory")
#define PG8_BAR __builtin_amdgcn_s_barrier()
#define PG8_SCHED __builtin_amdgcn_sched_barrier(0)
    Unit cur, nxt; int ui = 0;
    if (!S.next(0, cur)) return;
    f32x4 acc[2][2][4][2];
#pragma unroll
    for (int a = 0; a < 2; ++a)
#pragma unroll
        for (int b = 0; b < 2; ++b)
#pragma unroll
            for (int m = 0; m < 4; ++m)
#pragma unroll
                for (int n = 0; n < 2; ++n) acc[a][b][m][n] = (f32x4){0.f, 0.f, 0.f, 0.f};
    bf16x8 At[4][2], B0[2][2], B1[2][2];
    const char* cA = (const char*)g.A + (size_t)S.aoff(cur) * 2; const char* cB = (const char*)g.Bt + (size_t)S.boff(cur) * 2;
    PG8_STAGE(PG8_SB(0, 0), cB, voffB); PG8_STAGE(PG8_SB(0, 1), cB + hstepB, voffB); PG8_STAGE(PG8_SA(0, 0), cA, voffA); PG8_STAGE(PG8_SA(0, 1), cA + hstepA, voffA);
    if (wr == 1) PG8_BAR;
    PG8_WAIT_V(2); PG8_BAR;
    PG8_STAGE(PG8_SB(1, 0), cB + kstep, voffB); PG8_STAGE(PG8_SA(1, 0), cA + kstep, voffA); PG8_STAGE(PG8_SB(1, 1), cB + hstepB + kstep, voffB);
    PG8_WAIT_V(6); PG8_BAR;
    for (;;) {
        const bool has_next = S.next(ui + 1, nxt);
        const char* nA = has_next ? (const char*)g.A + (size_t)S.aoff(nxt) * 2 : cA; const char* nB = has_next ? (const char*)g.Bt + (size_t)S.boff(nxt) * 2 : cB;
        _Pragma("nounroll")
        for (int t = 0; t < nt; t += 2) {
            const bool last = (t == nt - 2);
            const char* a1 = cA + (size_t)(t + 1) * kstep;
            const char* a2 = last ? nA : cA + (size_t)(t + 2) * kstep; const char* b2 = last ? nB : cB + (size_t)(t + 2) * kstep;
            const char* a3 = a2 + kstep; const char* b3 = b2 + kstep;
            PG8_LDB(B0, 0, 0); PG8_LDB(B1, 0, 1); PG8_SCHED; PG8_LDA(At, 0, 0); PG8_STAGE(PG8_SA(1, 1), a1 + hstepA, voffA);
            PG8_WAIT_V(8); PG8_WAIT_L(0); PG8_BAR; PG8_MMA(0, 0, At, B0); PG8_MMA(0, 1, At, B1); PG8_BAR; PG8_SCHED;
            PG8_LDA(At, 0, 1); PG8_STAGE(PG8_SB(0, 0), b2, voffB); PG8_STAGE(PG8_SB(0, 1), b2 + hstepB, voffB); PG8_STAGE(PG8_SA(0, 0), a2, voffA);
            PG8_WAIT_V(8); PG8_WAIT_L(0); PG8_BAR; PG8_MMA(1, 0, At, B0); PG8_MMA(1, 1, At, B1); PG8_BAR; PG8_SCHED;
            PG8_LDB(B0, 1, 0); PG8_LDB(B1, 1, 1); PG8_SCHED; PG8_LDA(At, 1, 0); PG8_STAGE(PG8_SA(0, 1), a2 + hstepA, voffA);
            PG8_WAIT_V(8); PG8_WAIT_L(0); PG8_BAR; PG8_MMA(0, 0, At, B0); PG8_MMA(0, 1, At, B1); PG8_BAR; PG8_SCHED;
            PG8_LDA(At, 1, 1); PG8_STAGE(PG8_SB(1, 0), b3, voffB); PG8_STAGE(PG8_SB(1, 1), b3 + hstepB, voffB); PG8_STAGE(PG8_SA(1, 0), a3, voffA);
            PG8_WAIT_V(8); PG8_WAIT_L(0); PG8_BAR; PG8_MMA(1, 0, At, B0); PG8_MMA(1, 1, At, B1); PG8_BAR; PG8_SCHED;
        }
        if (wr == 0) PG8_BAR;
        if constexpr (!Epi::AFTER_DRAIN) { E(acc, cur, wr, wc, fr, fq); }
        if (!has_next) break;
#pragma unroll
        for (int a = 0; a < 2; ++a)
#pragma unroll
            for (int b = 0; b < 2; ++b)
#pragma unroll
                for (int m = 0; m < 4; ++m)
#pragma unroll
                    for (int n = 0; n < 2; ++n) acc[a][b][m][n] = (f32x4){0.f, 0.f, 0.f, 0.f};
        cur = nxt; cA = nA; cB = nB; ++ui;
        if (wr == 1) PG8_BAR;
    }
    PG8_WAIT_V(0);
    PG8_BAR;
    if constexpr (Epi::AFTER_DRAIN) { E.fused(acc, cur, wr, wc, fr, fq, lds, wid, lane); }
#undef PG8_SA
#undef PG8_SB
#undef PG8_STAGE
#undef PG8_LDA
#undef PG8_LDB
#undef PG8_MMA
#undef PG8_WAIT_V
#undef PG8_WAIT_L
#undef PG8_BAR
#undef PG8_SCHED
}

#define EPI_ROWS(ai, m) (u.pm * BM + (ai) * HALF + wr * 64 + (m) * 16 + fr)
typedef const f32x4 (&AccRef)[2][2][4][2];

struct EpiSwiglu {
    static constexpr bool PERM = true, AFTER_DRAIN = false;
    bf16_t* O;
    __device__ __forceinline__ void operator()(AccRef acc, const Unit& u, int wr, int wc, int fr, int fq) const {
        const int col0 = u.pn * 128 + wc * 32 + 8 * fq;
#pragma unroll
        for (int ai = 0; ai < 2; ++ai)
#pragma unroll
            for (int m = 0; m < 4; ++m) {
                const f32x4 g0 = acc[ai][0][m][0], g1 = acc[ai][0][m][1], u0 = acc[ai][1][m][0], u1 = acc[ai][1][m][1];
                u32x4 w;
                w.x = cvt_pk_bf16(silu(g0[0]) * u0[0], silu(g0[1]) * u0[1]); w.y = cvt_pk_bf16(silu(g0[2]) * u0[2], silu(g0[3]) * u0[3]);
                w.z = cvt_pk_bf16(silu(g1[0]) * u1[0], silu(g1[1]) * u1[1]); w.w = cvt_pk_bf16(silu(g1[2]) * u1[2], silu(g1[3]) * u1[3]);
                *(u32x4*)(O + (size_t)EPI_ROWS(ai, m) * FF + col0) = w;
            }
    }
};
struct EpiBf16 {
    static constexpr bool PERM = true, AFTER_DRAIN = false;
    bf16_t* O; int ldc; float scale;
    __device__ __forceinline__ void operator()(AccRef acc, const Unit& u, int wr, int wc, int fr, int fq) const {
        const int col0 = u.pn * BM + wc * 32 + 8 * fq;
#pragma unroll
        for (int ai = 0; ai < 2; ++ai)
#pragma unroll
            for (int m = 0; m < 4; ++m) { bf16_t* rowp = O + (size_t)EPI_ROWS(ai, m) * ldc + col0;
#pragma unroll
                for (int bj = 0; bj < 2; ++bj) { const f32x4 v0 = acc[ai][bj][m][0] * scale, v1 = acc[ai][bj][m][1] * scale;
                    u32x4 w; w.x = cvt_pk_bf16(v0[0], v0[1]); w.y = cvt_pk_bf16(v0[2], v0[3]); w.z = cvt_pk_bf16(v1[0], v1[1]); w.w = cvt_pk_bf16(v1[2], v1[3]);
                    *(u32x4*)(rowp + bj * HALF) = w; } }
    }
};
struct EpiProj {
    static constexpr bool PERM = true, AFTER_DRAIN = false;
    bf16_t *PR, *PL, *GG, *SG0;
    __device__ __forceinline__ void operator()(AccRef acc, const Unit& u, int wr, int wc, int fr, int fq) const {
        const int pn = u.pn, cw = wc * 32 + 8 * fq;
        if (pn >= 17 && pn < 25) {
            const int col0 = (pn - 17) * 128 + cw;
#pragma unroll
            for (int ai = 0; ai < 2; ++ai)
#pragma unroll
                for (int m = 0; m < 4; ++m) {
                    const f32x4 g0 = acc[ai][0][m][0], g1 = acc[ai][0][m][1], s0 = acc[ai][1][m][0], s1 = acc[ai][1][m][1];
                    u32x4 w;
                    w.x = cvt_pk_bf16(gelu_t(g0[0]) * sigm(s0[0]), gelu_t(g0[1]) * sigm(s0[1])); w.y = cvt_pk_bf16(gelu_t(g0[2]) * sigm(s0[2]), gelu_t(g0[3]) * sigm(s0[3]));
                    w.z = cvt_pk_bf16(gelu_t(g1[0]) * sigm(s1[0]), gelu_t(g1[1]) * sigm(s1[1])); w.w = cvt_pk_bf16(gelu_t(g1[2]) * sigm(s1[2]), gelu_t(g1[3]) * sigm(s1[3]));
                    *(u32x4*)(GG + (size_t)EPI_ROWS(ai, m) * D + col0) = w;
                }
        } else {
            bf16_t* base; int ldc, colt; bool sg = false;
            if (pn < 13) { base = PR; ldc = RP; colt = pn * 256; } else { ldc = D; sg = pn >= 17; colt = ((pn - 13) & 3) * 256; base = sg ? SG0 : PL; }
#pragma unroll
            for (int ai = 0; ai < 2; ++ai)
#pragma unroll
                for (int m = 0; m < 4; ++m) { bf16_t* rowp = base + (size_t)EPI_ROWS(ai, m) * ldc + colt + cw;
#pragma unroll
                    for (int bj = 0; bj < 2; ++bj) { f32x4 v0 = acc[ai][bj][m][0], v1 = acc[ai][bj][m][1];
                        if (sg) { v0 = (f32x4){sigm(v0[0]), sigm(v0[1]), sigm(v0[2]), sigm(v0[3])}; v1 = (f32x4){sigm(v1[0]), sigm(v1[1]), sigm(v1[2]), sigm(v1[3])}; }
                        u32x4 w; w.x = cvt_pk_bf16(v0[0], v0[1]); w.y = cvt_pk_bf16(v0[2], v0[3]); w.z = cvt_pk_bf16(v1[0], v1[1]); w.w = cvt_pk_bf16(v1[2], v1[3]);
                        *(u32x4*)(rowp + bj * HALF) = w; } }
        }
    }
};
struct EpiResid {
    static constexpr bool PERM = true, AFTER_DRAIN = false;
    const bf16_t* base; bf16_t* out; float s;
    __device__ __forceinline__ void operator()(AccRef acc, const Unit& u, int wr, int wc, int fr, int fq) const {
        const int col0 = u.pn * BM + wc * 32 + 8 * fq;
#pragma unroll
        for (int ai = 0; ai < 2; ++ai)
#pragma unroll
            for (int m = 0; m < 4; ++m) { const size_t off = (size_t)EPI_ROWS(ai, m) * D + col0;
#pragma unroll
                for (int bj = 0; bj < 2; ++bj) { const u32x4 bb = *(const u32x4*)(base + off + bj * HALF);
                    const f32x4 b0 = unpack4((u32x2){bb.x, bb.y}), b1 = unpack4((u32x2){bb.z, bb.w});
                    const f32x4 v0 = b0 * DN_ALPHA + acc[ai][bj][m][0] * s, v1 = b1 * DN_ALPHA + acc[ai][bj][m][1] * s;
                    u32x4 w; w.x = cvt_pk_bf16(v0[0], v0[1]); w.y = cvt_pk_bf16(v0[2], v0[3]); w.z = cvt_pk_bf16(v1[0], v1[1]); w.w = cvt_pk_bf16(v1[2], v1[3]);
                    *(u32x4*)(out + off + bj * HALF) = w; } }
    }
};
struct EpiKV {
    static constexpr bool PERM = false, AFTER_DRAIN = false;
    float *ok, *ov; bf16_t* KB;
    __device__ __forceinline__ void operator()(AccRef acc, const Unit& u, int wr, int wc, int fr, int fq) const {
        const bool isk = u.pn < 4; float* o = isk ? ok : ov; const int col0 = (u.pn & 3) * BM + wc * 32 + 4 * fq;
#pragma unroll
        for (int ai = 0; ai < 2; ++ai)
#pragma unroll
            for (int m = 0; m < 4; ++m) { const size_t off = (size_t)EPI_ROWS(ai, m) * D + col0;
#pragma unroll
                for (int bj = 0; bj < 2; ++bj)
#pragma unroll
                    for (int n = 0; n < 2; ++n) { const f32x4 v = acc[ai][bj][m][n]; *(f32x4*)(o + off + bj * HALF + n * 16) = v;
                        if (isk) *(u32x2*)(KB + off + bj * HALF + n * 16) = pack4(v); } }
    }
};
struct EpiLora {
    static constexpr bool PERM = true, AFTER_DRAIN = false;
    bf16_t *WD, *AA, *G; const float *w0, *a0;
    __device__ __forceinline__ void operator()(AccRef acc, const Unit& u, int wr, int wc, int fr, int fq) const {
        const int kind = u.pn >> 2, colt = (u.pn & 3) * 256 + wc * 32 + 8 * fq;
        bf16_t* base = WD + (size_t)kind * ((WS_AA - WS_WD) / 2);
        const float* bias = kind == 0 ? w0 : a0;
#pragma unroll
        for (int bj = 0; bj < 2; ++bj) {
            f32x4 b0 = (f32x4){0.f, 0.f, 0.f, 0.f}, b1 = b0;
            if (kind < 2) { b0 = *(const f32x4*)(bias + colt + bj * HALF); b1 = *(const f32x4*)(bias + colt + bj * HALF + 4); }
#pragma unroll
            for (int ai = 0; ai < 2; ++ai)
#pragma unroll
                for (int m = 0; m < 4; ++m) { f32x4 v0 = acc[ai][bj][m][0] + b0, v1 = acc[ai][bj][m][1] + b1;
                    if (kind == 0) { v0 = (f32x4){decay_e(v0[0]), decay_e(v0[1]), decay_e(v0[2]), decay_e(v0[3])}; v1 = (f32x4){decay_e(v1[0]), decay_e(v1[1]), decay_e(v1[2]), decay_e(v1[3])}; }
                    else if (kind == 1) { v0 = (f32x4){sigm(v0[0]), sigm(v0[1]), sigm(v0[2]), sigm(v0[3])}; v1 = (f32x4){sigm(v1[0]), sigm(v1[1]), sigm(v1[2]), sigm(v1[3])}; }
                    u32x4 w; w.x = cvt_pk_bf16(v0[0], v0[1]); w.y = cvt_pk_bf16(v0[2], v0[3]); w.z = cvt_pk_bf16(v1[0], v1[1]); w.w = cvt_pk_bf16(v1[2], v1[3]);
                    *(u32x4*)(base + (size_t)EPI_ROWS(ai, m) * D + colt + bj * HALF) = w; }
        }
    }
};
struct EpiLru {
    static constexpr bool PERM = true, AFTER_DRAIN = false;
    bf16_t *GR, *GI; const float *br, *bi;
    __device__ __forceinline__ void operator()(AccRef acc, const Unit& u, int wr, int wc, int fr, int fq) const {
        const int col0 = u.pn * 128 + wc * 32 + 8 * fq;
#pragma unroll
        for (int bj = 0; bj < 2; ++bj) {
            const float* bias = bj ? bi : br; bf16_t* base = bj ? GI : GR;
            const f32x4 b0 = *(const f32x4*)(bias + col0), b1 = *(const f32x4*)(bias + col0 + 4);
#pragma unroll
            for (int ai = 0; ai < 2; ++ai)
#pragma unroll
                for (int m = 0; m < 4; ++m) { const f32x4 v0 = acc[ai][bj][m][0] + b0, v1 = acc[ai][bj][m][1] + b1;
                    u32x4 w; w.x = cvt_pk_bf16(sigm(v0[0]), sigm(v0[1])); w.y = cvt_pk_bf16(sigm(v0[2]), sigm(v0[3])); w.z = cvt_pk_bf16(sigm(v1[0]), sigm(v1[1])); w.w = cvt_pk_bf16(sigm(v1[2]), sigm(v1[3]));
                    *(u32x4*)(base + (size_t)EPI_ROWS(ai, m) * D + col0) = w; }
        }
    }
};
struct EpiSoftmax {
    static constexpr bool PERM = true, AFTER_DRAIN = true;
    bf16_t* P;
    __device__ __forceinline__ void fused(f32x4 (&acc)[2][2][4][2], const Unit& u, int wr, int wc, int fr, int fq, LAS unsigned char* lds, int wid, int lane) const {
        LAS float* MX = (LAS float*)lds;
        LAS float* SM = (LAS float*)(lds + 4096);
#pragma unroll
        for (int ai = 0; ai < 2; ++ai)
#pragma unroll
            for (int m = 0; m < 4; ++m) {
                float mx = -3.0e38f;
#pragma unroll
                for (int bj = 0; bj < 2; ++bj)
#pragma unroll
                    for (int n = 0; n < 2; ++n) { const f32x4 x = acc[ai][bj][m][n]; mx = fmaxf(mx, fmaxf(fmaxf(x[0], x[1]), fmaxf(x[2], x[3]))); }
                mx = fmaxf(mx, __shfl_xor(mx, 16)); mx = fmaxf(mx, __shfl_xor(mx, 32));
                if (fq == 0) MX[(ai * HALF + wr * 64 + m * 16 + fr) * 4 + wc] = mx;
            }
        __syncthreads();
#pragma unroll
        for (int ai = 0; ai < 2; ++ai)
#pragma unroll
            for (int m = 0; m < 4; ++m) {
                const int rl = ai * HALF + wr * 64 + m * 16 + fr;
                const f32x4 mm = *(const LAS f32x4*)(MX + rl * 4);
                const float mx = fmaxf(fmaxf(mm[0], mm[1]), fmaxf(mm[2], mm[3]));
                float s = 0.f;
#pragma unroll
                for (int bj = 0; bj < 2; ++bj)
#pragma unroll
                    for (int n = 0; n < 2; ++n) { f32x4 x = acc[ai][bj][m][n];
                        x = (f32x4){__builtin_amdgcn_exp2f(x[0] - mx), __builtin_amdgcn_exp2f(x[1] - mx), __builtin_amdgcn_exp2f(x[2] - mx), __builtin_amdgcn_exp2f(x[3] - mx)};
                        acc[ai][bj][m][n] = x; s += (x[0] + x[1]) + (x[2] + x[3]); }
                s += __shfl_xor(s, 16); s += __shfl_xor(s, 32);
                if (fq == 0) SM[rl * 4 + wc] = s;
            }
        __syncthreads();
        const int col0 = u.pn * BM + wc * 32 + 8 * fq;
#pragma unroll
        for (int ai = 0; ai < 2; ++ai)
#pragma unroll
            for (int m = 0; m < 4; ++m) {
                const int rl = ai * HALF + wr * 64 + m * 16 + fr;
                const f32x4 ss = *(const LAS f32x4*)(SM + rl * 4);
                const float inv = 1.0f / ((ss[0] + ss[1]) + (ss[2] + ss[3]));
                bf16_t* rowp = P + (size_t)(u.pm * BM + rl) * D + col0;
#pragma unroll
                for (int bj = 0; bj < 2; ++bj) { const f32x4 v0 = acc[ai][bj][m][0] * inv, v1 = acc[ai][bj][m][1] * inv;
                    u32x4 w; w.x = cvt_pk_bf16(v0[0], v0[1]); w.y = cvt_pk_bf16(v0[2], v0[3]); w.z = cvt_pk_bf16(v1[0], v1[1]); w.w = cvt_pk_bf16(v1[2], v1[3]);
                    *(u32x4*)(rowp + bj * HALF) = w; }
            }
        __syncthreads();
    }
};
}

template <bool PAIR, class F>
__device__ __forceinline__ void skinny(const bf16_t* A, int lda, const bf16_t* Bt, int ldb, int K, int tile_lo, int tile_hi, int kmode, int bx, int G, int tid_, F f) {
    const int tid = opaque(tid_), lane = tid & 63, w = __builtin_amdgcn_readfirstlane(tid >> 6), fr = lane & 15, fq = lane >> 4;
    constexpr int GPT = PAIR ? 2 : 4;
    const int nunits = (tile_hi - tile_lo) * GPT * 4;
    for (int un = G - 1 - bx; un < nunits; un += G) {
        const int rbp = un & 3, cgrp = un >> 2, tile = tile_lo + cgrp / GPT, cgp = (cgrp % GPT) * 4 + (w & 3), rb = rbp * 2 + (w >> 2);
        const int n0 = tile * 256 + cgp * 16, row = MP + rb * 16 + fr;
        const bf16_t* ap = A + (size_t)row * lda + (kmode ? 256 * (tile >> 1) : 0) + fq * 8;
        const bf16_t* bp = Bt + (size_t)(n0 + fr) * ldb + fq * 8;
        f32x4 acc0 = (f32x4){0.f, 0.f, 0.f, 0.f}, acc1 = acc0;
        for (int k0 = 0; k0 < K; k0 += 256) {
#pragma unroll
            for (int kk = 0; kk < 256; kk += 32) {
                const bf16x8 a = *(const bf16x8*)(ap + k0 + kk), b = *(const bf16x8*)(bp + k0 + kk);
                acc0 = __builtin_amdgcn_mfma_f32_16x16x32_bf16(b, a, acc0, 0, 0, 0);
                if (PAIR) { const bf16x8 b2 = *(const bf16x8*)(bp + (size_t)128 * ldb + k0 + kk); acc1 = __builtin_amdgcn_mfma_f32_16x16x32_bf16(b2, a, acc1, 0, 0, 0); }
            }
        }
        f(row, tile, cgp * 16 + 4 * fq, acc0, acc1);
    }
}

__device__ __forceinline__ int map_row(int mapmode, int n) {
    if (mapmode == 1) { if (n < FF) return 256 * (n / 128) + (n % 128); const int q = n - FF; return 256 * (q / 128) + 128 + (q % 128); }
    if (mapmode == 2) { if (n < 4352) return n; if (n < 5376) { const int q = n - 4352; return 256 * (17 + q / 128) + (q % 128); }
                        if (n < 6400) return 256 * 25 + (n - 5376); const int q = n - 6400; return 256 * (17 + q / 128) + 128 + (q % 128); }
    return n;
}
__device__ __forceinline__ void transpose_item(const float* W, int K, int N, bf16_t* WT, int mapmode, LAS float* scr, int item, int lane) {
    const int nblk = N / 32, kb = item / nblk, nb = item % nblk, k0 = 64 * kb, n0 = 32 * nb;
#pragma unroll 8
    for (int i = 0; i < 32; ++i) { const int kk = 2 * i + (lane >> 5); scr[kk * 33 + (lane & 31)] = W[(size_t)(k0 + kk) * N + n0 + (lane & 31)]; }
    asm volatile("s_waitcnt lgkmcnt(0)" ::: "memory");
    const int c = lane & 7, d0 = map_row(mapmode, n0);
#pragma unroll
    for (int j = 0; j < 4; ++j) { const int n = (lane >> 3) + 8 * j; const LAS float* s = scr + (8 * c) * 33 + n;
        u32x4 o; o.x = cvt_pk_bf16(s[0 * 33], s[1 * 33]); o.y = cvt_pk_bf16(s[2 * 33], s[3 * 33]); o.z = cvt_pk_bf16(s[4 * 33], s[5 * 33]); o.w = cvt_pk_bf16(s[6 * 33], s[7 * 33]);
        *(u32x4*)(WT + (size_t)(d0 + n) * K + k0 + 8 * c) = o; }
    asm volatile("s_waitcnt lgkmcnt(0)" ::: "memory");
}

struct Args { const float* in[39]; float* out; unsigned char* ws; int ph_lo, ph_hi; };

__device__ __forceinline__ void ln_pass(const bf16_t* PRE, const float* g, const float* b, float* Hf, bf16_t* HB, int gw, int ngw, int lane) {
    f32x4 gv[4], bv[4];
#pragma unroll
    for (int j = 0; j < 4; ++j) { gv[j] = *(const f32x4*)(g + 256 * j + 4 * lane); bv[j] = *(const f32x4*)(b + 256 * j + 4 * lane); }
    int row = gw;
    u32x2 q[4], qn[4];
    if (row < MT) {
#pragma unroll
        for (int j = 0; j < 4; ++j) q[j] = *(const u32x2*)(PRE + (size_t)row * D + 4 * lane + 256 * j);
    }
    while (row < MT) {
        const int nrow = row + ngw;
        if (nrow < MT) {
#pragma unroll
            for (int j = 0; j < 4; ++j) qn[j] = *(const u32x2*)(PRE + (size_t)nrow * D + 4 * lane + 256 * j);
        }
        f32x4 v[4]; float s = 0.f;
#pragma unroll
        for (int j = 0; j < 4; ++j) { v[j] = unpack4(q[j]); s += (v[j].x + v[j].y) + (v[j].z + v[j].w); }
        const float mean = wave_sum(s) * (1.f / D); float s2 = 0.f;
#pragma unroll
        for (int j = 0; j < 4; ++j) { v[j] = v[j] - mean; s2 += (v[j].x * v[j].x + v[j].y * v[j].y) + (v[j].z * v[j].z + v[j].w * v[j].w); }
        const float rstd = 1.0f / sqrtf(wave_sum(s2) * (1.f / D) + LN_EPS);
#pragma unroll
        for (int j = 0; j < 4; ++j) { const f32x4 o = v[j] * rstd * gv[j] + bv[j];
            if (Hf) *(f32x4*)(Hf + (size_t)row * D + 256 * j + 4 * lane) = o;
            if (HB) *(u32x2*)(HB + (size_t)row * D + 256 * j + 4 * lane) = pack4(o); }
#pragma unroll
        for (int j = 0; j < 4; ++j) q[j] = qn[j];
        row = nrow;
    }
}

#define XB_TMO      128
#define XB_XCNT(j)  (256  + 64 * (j))
#define XB_XSUB(j)  (1280 + 64 * (j))
#define XB_XGEN(j)  (2304 + 64 * (j))
#define XB_TOP      3328
#define XB_TOPGEN   3392
#define XCD_BAR_WORDS 3456
#define XB_SPIN_CAP (1u << 22)
__device__ __forceinline__ unsigned xb_ld(unsigned* p)              { return __hip_atomic_load(p, __ATOMIC_RELAXED, __HIP_MEMORY_SCOPE_AGENT); }
__device__ __forceinline__ unsigned xb_add(unsigned* p, unsigned v) { return __hip_atomic_fetch_add(p, v, __ATOMIC_RELAXED, __HIP_MEMORY_SCOPE_AGENT); }
__device__ __forceinline__ unsigned xb_xcc_id() { return (unsigned)__builtin_amdgcn_s_getreg((3 << 11) | 20) & 0xFu; }
#define XB_SPIN(cond, bar) do { unsigned _sp = 0; while (cond) { __builtin_amdgcn_s_sleep(1); \
    if ((++_sp & 255u) == 0u) { if (xb_ld(&(bar)[XB_TMO])) break; if (_sp > XB_SPIN_CAP) { atomicAdd(&(bar)[XB_TMO], 1u); break; } } } } while (0)
__device__ __forceinline__ void xcd_barrier_complete(unsigned* bar, unsigned x, unsigned& nloc, unsigned& nx) {
    const unsigned G = gridDim.x;
    unsigned sum, cnt, mine, sp = 0u;
    for (;;) {
        sum = 0u; cnt = 0u; mine = 0u;
#pragma unroll
        for (unsigned j = 0; j < 16; ++j) { const unsigned c = xb_ld(&bar[XB_XCNT(j)]); sum += c; cnt += (c > 0u) ? 1u : 0u; mine = (j == x) ? c : mine; }
        if (sum == G) break;
        __builtin_amdgcn_s_sleep(1);
        if ((++sp & 255u) == 0u) { if (xb_ld(&bar[XB_TMO])) break; if (sp > XB_SPIN_CAP) { atomicAdd(&bar[XB_TMO], 1u); break; } }
    }
    nloc = mine > 0u ? mine : 1u; nx = cnt > 0u ? cnt : 1u;
}
__device__ __forceinline__ void xcd_barrier(unsigned* bar, volatile LAS unsigned* st) {
    asm volatile("s_waitcnt vmcnt(0) lgkmcnt(0)" ::: "memory");
    __syncthreads();
    if (threadIdx.x == 0) {
        __builtin_amdgcn_s_waitcnt(0);
        const unsigned x = xb_xcc_id();
        unsigned nloc = st[0], nx = st[1];
        if (nloc == 0u) { xcd_barrier_complete(bar, x, nloc, nx); st[0] = nloc; st[1] = nx; }
        const unsigned old = xb_add(&bar[XB_XSUB(x)], 1u);
        const unsigned gen = old / nloc;
        if (old + 1u == (gen + 1u) * nloc) {
            __builtin_amdgcn_fence(__ATOMIC_RELEASE, "agent");
            asm volatile("s_waitcnt vmcnt(0)" ::: "memory");
            const unsigned og = xb_add(&bar[XB_TOP], 1u);
            const unsigned tg = og / nx;
            if (og + 1u == (tg + 1u) * nx) xb_add(&bar[XB_TOPGEN], 1u);
            else XB_SPIN(xb_ld(&bar[XB_TOPGEN]) == tg, bar);
            __builtin_amdgcn_fence(__ATOMIC_ACQUIRE, "agent");
            xb_add(&bar[XB_XGEN(x)], 1u);
            asm volatile("s_waitcnt vmcnt(0)" ::: "memory");
        } else {
            XB_SPIN(xb_ld(&bar[XB_XGEN(x)]) == gen, bar);
            __builtin_amdgcn_fence(__ATOMIC_ACQUIRE, "agent");
            asm volatile("s_waitcnt vmcnt(0)" ::: "memory");
        }
    }
    __syncthreads();
}

#define PH_IDS const int tid = opaque(threadIdx.x), lane = tid & 63, wave = __builtin_amdgcn_readfirstlane(tid >> 6), gw = bx * NWAVES + wave, gt = bx * NTHR + tid; (void)lane; (void)gw; (void)gt; PH_PTRS
#define PH_PTRS \
    unsigned char* ws = args.ws; float* out = args.out; \
    bf16_t *WI = (bf16_t*)(ws + WS_WI), *WO = (bf16_t*)(ws + WS_WO), *WIN = (bf16_t*)(ws + WS_WIN), *WMIX = (bf16_t*)(ws + WS_WMIX), *WQ = (bf16_t*)(ws + WS_WQ), *WOX = (bf16_t*)(ws + WS_WOX), \
           *WKV = (bf16_t*)(ws + WS_WKV), *LORAT = (bf16_t*)(ws + WS_LORAT), *LRUT = (bf16_t*)(ws + WS_LRUT), *MEMB = (bf16_t*)(ws + WS_MEMB), *KB = (bf16_t*)(ws + WS_KB), *VT = (bf16_t*)(ws + WS_VT), \
           *HB = (bf16_t*)(ws + WS_HB), *PR = (bf16_t*)(ws + WS_PR), *PL = (bf16_t*)(ws + WS_PL), *GG = (bf16_t*)(ws + WS_GG), *SG0 = (bf16_t*)(ws + WS_SG0), *GI = (bf16_t*)(ws + WS_GI), \
           *WD = (bf16_t*)(ws + WS_WD), *AA = (bf16_t*)(ws + WS_AA), *GB = (bf16_t*)(ws + WS_G), *LB = (bf16_t*)(ws + WS_L); \
    bf16_t *ACT = PR, *XC = (bf16_t*)(ws + WS_XC), *MB = XC, *GR = PL, *LO = GI, *QB = PL, *PB = GG, *OB = SG0; \
    bf16_t *PRE = (bf16_t*)(ws + WS_PRE), *Y = PRE; float* H = out; \
    (void)WI; (void)WO; (void)WIN; (void)WMIX; (void)WQ; (void)WOX; (void)WKV; (void)LORAT; (void)LRUT; (void)MEMB; (void)KB; (void)VT; (void)HB; (void)PR; (void)PL; (void)GG; (void)SG0; (void)GI; \
    (void)WD; (void)AA; (void)GB; (void)LB; (void)ACT; (void)XC; (void)MB; (void)GR; (void)LO; (void)QB; (void)PB; (void)OB; (void)PRE; (void)Y; (void)H;
#define INP(k) (args.in[k])
#ifndef PHSEL
#define PHSEL(k) true
#endif
template <int ph>
__device__ __forceinline__ void run_phase(const Args& args, LAS unsigned char* lds, const int G, const int bx, const bool fin = true) {
    const int ngw = G * NWAVES, ngt = G * NTHR; (void)ngw; (void)ngt;
    switch (ph) {
    case 0: if (PHSEL(0)) { PH_IDS
        const float *x_prompt = INP(0), *x_sample = INP(1), *mem_prompt = INP(2), *decay_w2 = INP(18), *aaa_a2 = INP(20), *gate_g2 = INP(21), *lru_wr = INP(29), *lru_wi = INP(31);
        LAS float* scr = (LAS float*)(lds + wave * 16384);
        constexpr int I_WI = 16 * (2 * FF / 32), I_WO = (FF / 64) * 32, I_WIN = 16 * (PW / 32), I_SQ = 16 * 32;
        constexpr int NIT = I_WI + I_WO + I_WIN + 5 * I_SQ;
        for (int it = gw; it < NIT; it += ngw) {
            int r = it;
            if (r < I_WI) { transpose_item(INP(11), D, 2 * FF, WI, 1, scr, r, lane); continue; } r -= I_WI;
            if (r < I_WO) { transpose_item(INP(12), FF, D, WO, 0, scr, r, lane); continue; } r -= I_WO;
            if (r < I_WIN) { transpose_item(INP(15), D, PW, WIN, 2, scr, r, lane); continue; } r -= I_WIN;
            if (r < I_SQ) { transpose_item(INP(34), D, D, WMIX, 0, scr, r, lane); continue; } r -= I_SQ;
            if (r < I_SQ) { transpose_item(INP(35), D, D, WQ, 0, scr, r, lane); continue; } r -= I_SQ;
            if (r < I_SQ) { transpose_item(INP(36), D, D, WKV, 0, scr, r, lane); continue; } r -= I_SQ;
            if (r < I_SQ) { transpose_item(INP(37), D, D, WKV + (size_t)D * D, 0, scr, r, lane); continue; } r -= I_SQ;
            transpose_item(INP(38), D, D, WOX, 0, scr, r, lane);
        }
        for (int i = gt; i < 3072 * 256; i += ngt) { const int n = i >> 8, k = i & 255; float v = 0.f;
            if (n < 1024) { if (k < 64) v = decay_w2[k * 1024 + n]; } else if (n < 2048) { if (k >= 64 && k < 128) v = aaa_a2[(k - 64) * 1024 + (n - 1024)]; } else { if (k >= 128) v = gate_g2[(k - 128) * 1024 + (n - 2048)]; }
            LORAT[i] = f2bf(v); }
        for (int i = gt; i < 2048 * 256; i += ngt) { const int n = i >> 8, k = i & 255; const int q = n >> 8, bj = (n >> 7) & 1, j = n & 127;
            const int c = 128 * q + j, nb = c >> 6, d = c & 63; const int cin = 256 * (q >> 1) + k; float v = 0.f;
            if ((cin >> 6) == nb) v = (bj ? lru_wi : lru_wr)[(nb * 64 + (cin & 63)) * 64 + d];
            LRUT[i] = f2bf(v); }
        for (int i = gt; i < MT * D / 4; i += ngt) { const f32x4 v = (i < MP * D / 4) ? ((const f32x4*)x_prompt)[i] : ((const f32x4*)x_sample)[i - MP * D / 4];
            ((u32x2*)HB)[i] = pack4(v); }
        for (int i = gt; i < NB * 256 * D / 4; i += ngt) ((u32x2*)MEMB)[i] = pack4(((const f32x4*)mem_prompt)[i]);
    } break;

    case 1: case 16: if (PHSEL(1)) { PH_IDS
        { pg8::Gemm g{HB, WI, D, D, D}; pg8::Sched S; S.init(MP / 256, 2 * FF / 256, G, bx, 0, D, D); pg8::EpiSwiglu E{ACT}; pg8::gemm_phase(lds, g, S, E); }
        skinny<true>(HB, D, WI, D, D, 0, 2 * FF / 256, 0, bx, G, tid, [&](int row, int tile, int cin, f32x4 a, f32x4 b) {
            f32x4 o = (f32x4){silu(a[0]) * b[0], silu(a[1]) * b[1], silu(a[2]) * b[2], silu(a[3]) * b[3]};
            *(u32x2*)(ACT + (size_t)row * FF + tile * 128 + cin) = pack4(o); });
        if (ph == 1) {
        { pg8::Gemm g{MEMB, WKV, D, D, D}; pg8::Sched S; S.init(8, 8, G, G - 1 - bx, 0, D, D); pg8::EpiKV E{out + O_PMK, out + O_PMV, KB}; pg8::gemm_phase(lds, g, S, E); }
        { pg8::Gemm g{WKV + (size_t)D * D, MEMB, D, D, D}; pg8::Sched S; S.init(4, 8, G, (2 * G - 65 - bx) % G, 0, D, D); pg8::EpiBf16 E{VT, NB * 256, 1.0f}; pg8::gemm_phase(lds, g, S, E); }
        }
    } break;
    case 2: case 17: if (PHSEL(2)) { PH_IDS
        { pg8::Gemm g{ACT, WO, FF, FF, FF}; pg8::Sched S; S.init(MP / 256, D / 256, G, bx, 0, FF, FF); pg8::EpiResid E{HB, PRE, 0.5f}; pg8::gemm_phase(lds, g, S, E); }
        skinny<false>(ACT, FF, WO, FF, FF, 0, D / 256, 0, bx, G, tid, [&](int row, int tile, int cin, f32x4 a, f32x4) {
            const size_t off = (size_t)row * D + tile * 256 + cin; *(u32x2*)(PRE + off) = pack4(unpack4(*(const u32x2*)(HB + off)) * DN_ALPHA + a * 0.5f); });
    } break;
    case 3: case 10: case 15: case 18: if (PHSEL(3)) { PH_IDS
        const float *ln_g = INP(9), *ln_b = INP(10);
        const int li = ph == 3 ? 0 : (ph == 10 ? 1 : (ph == 15 ? 2 : 3));
        ln_pass(PRE, ln_g + li * D, ln_b + li * D, ph == 18 ? H : (float*)nullptr, ph == 18 ? (bf16_t*)nullptr : HB, gw, ngw, lane);
    } break;
    case 4: if (PHSEL(4)) { PH_IDS
        { pg8::Gemm g{HB, WIN, D, D, D}; pg8::Sched S; S.init(MP / 256, PW / 256, G, bx, 0, D, D); pg8::EpiProj E{PR, PL, GG, SG0}; pg8::gemm_phase(lds, g, S, E); }
        skinny<false>(HB, D, WIN, D, D, 0, 17, 0, bx, G, tid, [&](int row, int tile, int cin, f32x4 a, f32x4) {
            if (tile < 13) *(u32x2*)(PR + (size_t)row * RP + tile * 256 + cin) = pack4(a); else *(u32x2*)(PL + (size_t)row * D + (tile - 13) * 256 + cin) = pack4(a); });
        skinny<false>(HB, D, WIN, D, D, 25, 29, 0, bx, G, tid, [&](int row, int tile, int cin, f32x4 a, f32x4) {
            *(u32x2*)(SG0 + (size_t)row * D + (tile - 25) * 256 + cin) = pack4((f32x4){sigm(a[0]), sigm(a[1]), sigm(a[2]), sigm(a[3])}); });
        skinny<true>(HB, D, WIN, D, D, 17, 25, 0, bx, G, tid, [&](int row, int tile, int cin, f32x4 a, f32x4 b) {
            *(u32x2*)(GG + (size_t)row * D + (tile - 17) * 128 + cin) = pack4((f32x4){gelu_t(a[0]) * sigm(b[0]), gelu_t(a[1]) * sigm(b[1]), gelu_t(a[2]) * sigm(b[2]), gelu_t(a[3]) * sigm(b[3])}); });
    } break;
    case 5: if (PHSEL(5)) { PH_IDS
        const float *state_shift = INP(6), *state_conv = INP(8), *shift_mu = INP(16), *conv_w = INP(27), *conv_b = INP(28);
        for (int row = gw; row < MT; row += ngw) {
            const bool smp = row >= MP; const int t = row & (T - 1), b = row >> 11, si = row - MP;
            { const int c = 3072 + 4 * lane; const f32x4 p = unpack4(*(const u32x2*)(PR + (size_t)row * RP + c));
              f32x4 pv = (f32x4){0.f, 0.f, 0.f, 0.f};
              if (smp) pv = *(const f32x4*)(state_shift + (size_t)si * RP + c); else if (t > 0) pv = unpack4(*(const u32x2*)(PR + (size_t)(row - 1) * RP + c));
              const f32x4 mu = *(const f32x4*)(shift_mu + c); f32x4 xs = p + (pv - p) * mu;
              if (lane < 16) xs = (f32x4){tanh_(xs[0]), tanh_(xs[1]), tanh_(xs[2]), tanh_(xs[3])}; else if (lane >= 32) xs = (f32x4){sigm(xs[0]), sigm(xs[1]), sigm(xs[2]), sigm(xs[3])};
              *(u32x2*)(LB + (size_t)row * 256 + 4 * lane) = pack4(xs); }
#pragma unroll
            for (int j = 0; j < 4; ++j) { const int c = 256 * j + 4 * lane;
                const f32x4 p3 = unpack4(*(const u32x2*)(PL + (size_t)row * D + c));
                f32x4 p0 = (f32x4){0.f, 0.f, 0.f, 0.f}, p1 = p0, p2 = p0;
                if (smp) { p0 = *(const f32x4*)(state_conv + ((size_t)si * 3 + 0) * D + c); p1 = *(const f32x4*)(state_conv + ((size_t)si * 3 + 1) * D + c); p2 = *(const f32x4*)(state_conv + ((size_t)si * 3 + 2) * D + c); }
                else { if (t >= 3) p0 = unpack4(*(const u32x2*)(PL + (size_t)(row - 3) * D + c)); if (t >= 2) p1 = unpack4(*(const u32x2*)(PL + (size_t)(row - 2) * D + c)); if (t >= 1) p2 = unpack4(*(const u32x2*)(PL + (size_t)(row - 1) * D + c)); }
                const f32x4 xc = *(const f32x4*)(conv_b + c) + *(const f32x4*)(conv_w + c) * p0 + *(const f32x4*)(conv_w + D + c) * p1 + *(const f32x4*)(conv_w + 2 * D + c) * p2 + *(const f32x4*)(conv_w + 3 * D + c) * p3;
                *(u32x2*)(XC + (size_t)row * D + c) = pack4(xc);
                if (smp) { *(f32x4*)(out + O_SCONV + ((size_t)si * 3 + 0) * D + c) = p1; *(f32x4*)(out + O_SCONV + ((size_t)si * 3 + 1) * D + c) = p2; *(f32x4*)(out + O_SCONV + ((size_t)si * 3 + 2) * D + c) = p3; }
                else if (t >= T - 3) *(f32x4*)(out + O_PCONV + ((size_t)b * 3 + (t - (T - 3))) * D + c) = p3; }
            if (smp || t == T - 1) { float* dst = smp ? out + O_SSHIFT + (size_t)si * RP : out + O_PSHIFT + (size_t)b * RP;
                for (int c = 4 * lane; c < RP; c += 256) *(f32x4*)(dst + c) = unpack4(*(const u32x2*)(PR + (size_t)row * RP + c)); }
        }
    } break;
    case 6: if (PHSEL(6)) { PH_IDS
        const float *decay_w0 = INP(17), *aaa_a0 = INP(19), *lru_br = INP(30), *lru_bi = INP(32);
        { pg8::Gemm g{LB, LORAT, 256, 256, 256}; pg8::Sched S; S.init(MP / 256, 12, G, bx, 0, 256, 256); pg8::EpiLora E{WD, AA, GB, decay_w0, aaa_a0}; pg8::gemm_phase(lds, g, S, E); }
        { pg8::Gemm g{XC, LRUT, D, 256, 256}; pg8::Sched S; S.init(MP / 256, 8, G, bx, 1, D, 256); pg8::EpiLru E{GR, GI, lru_br, lru_bi}; pg8::gemm_phase(lds, g, S, E); }
        skinny<false>(LB, 256, LORAT, 256, 256, 0, 12, 0, bx, G, tid, [&](int row, int tile, int cin, f32x4 a, f32x4) {
            const int kind = tile >> 2, c = (tile & 3) * 256 + cin; f32x4 o = a;
            if (kind == 0) { const f32x4 bb = *(const f32x4*)(decay_w0 + c); o = (f32x4){decay_e(a[0] + bb[0]), decay_e(a[1] + bb[1]), decay_e(a[2] + bb[2]), decay_e(a[3] + bb[3])}; }
            else if (kind == 1) { const f32x4 bb = *(const f32x4*)(aaa_a0 + c); o = (f32x4){sigm(a[0] + bb[0]), sigm(a[1] + bb[1]), sigm(a[2] + bb[2]), sigm(a[3] + bb[3])}; }
            bf16_t* base = WD + (size_t)kind * ((WS_AA - WS_WD) / 2); *(u32x2*)(base + (size_t)row * D + c) = pack4(o); });
        skinny<true>(XC, D, LRUT, 256, 256, 0, 8, 1, bx, G, tid, [&](int row, int tile, int cin, f32x4 a, f32x4 b) {
            const int c = tile * 128 + cin; const f32x4 b0 = *(const f32x4*)(lru_br + c), b1 = *(const f32x4*)(lru_bi + c);
            *(u32x2*)(GR + (size_t)row * D + c) = pack4((f32x4){sigm(a[0] + b0[0]), sigm(a[1] + b0[1]), sigm(a[2] + b0[2]), sigm(a[3] + b0[3])});
            *(u32x2*)(GI + (size_t)row * D + c) = pack4((f32x4){sigm(b[0] + b1[0]), sigm(b[1] + b1[1]), sigm(b[2] + b1[2]), sigm(b[3] + b1[3])}); });
    } break;
    case 7: if (PHSEL(7)) { PH_IDS
        const float *state_rwkv = INP(5), *state_shift = INP(6), *state_lru = INP(7), *shift_mu = INP(16), *k_k = INP(22), *k_a = INP(23), *lru_lambda = INP(33);
        constexpr int TC = 32, VB = 6 * TC * 64;
        LAS float* VECb = (LAS float*)lds;
        LAS float* SCb = (LAS float*)(lds + 2 * VB * 4);
        LAS float* YBb = (LAS float*)(lds + 2 * VB * 4 + 512);
        for (int unit = bx; unit < 256; unit += G) {
            const int b = unit >> 5, h = (unit >> 1) & 15, half = unit & 1;
            const bool producer = wave >= 4;
            const int ptid = tid & 255, tt0 = ptid >> 4, cgq = ptid & 15, chb = h * 64 + 4 * cgq;
            f32x4 mu_r, mu_k, mu_v, kkc, kac;
            u32x2 q_r[2], q_k[2], q_v[2], q_rp[2], q_kp[2], q_vp[2], q_e[2], q_a[2];
            auto issue = [&](int chunk) {
#pragma unroll
                for (int it = 0; it < 2; ++it) {
                    const int tg = chunk * TC + tt0 + 16 * it; const size_t row = (size_t)b * T + tg; const bf16_t* base = PR + row * RP + chb;
                    q_r[it] = *(const u32x2*)(base); q_k[it] = *(const u32x2*)(base + 1024); q_v[it] = *(const u32x2*)(base + 2048);
                    if (tg > 0) { q_rp[it] = *(const u32x2*)(base - RP); q_kp[it] = *(const u32x2*)(base - RP + 1024); q_vp[it] = *(const u32x2*)(base - RP + 2048); }
                    else { q_rp[it] = (u32x2){0u, 0u}; q_kp[it] = q_rp[it]; q_vp[it] = q_rp[it]; }
                    q_e[it] = *(const u32x2*)(WD + row * D + chb); q_a[it] = *(const u32x2*)(AA + row * D + chb);
                }
            };
            auto derive = [&](int buf) {
                LAS float* V = VECb + buf * VB;
#pragma unroll
                for (int it = 0; it < 2; ++it) {
                    const int tt = tt0 + 16 * it;
                    const f32x4 pr = unpack4(q_r[it]), pk = unpack4(q_k[it]), pv = unpack4(q_v[it]);
                    const f32x4 r = pr + (unpack4(q_rp[it]) - pr) * mu_r, k = pk + (unpack4(q_kp[it]) - pk) * mu_k, v = pv + (unpack4(q_vp[it]) - pv) * mu_v;
                    const f32x4 e = unpack4(q_e[it]), a = unpack4(q_a[it]);
                    const f32x4 w = (f32x4){__expf(-e[0]), __expf(-e[1]), __expf(-e[2]), __expf(-e[3])};
                    f32x4 kk = k * kkc; const float n2 = red16(dot4(kk, kk)); kk = kk * (1.0f / fmaxf(sqrtf(n2), 1e-12f));
                    const f32x4 kp = k * (1.0f + (a - 1.0f) * kac), bv = kk * a, wrv = w * r;
                    const float br = red16(dot4(bv, r)), kr = red16(dot4(kp, r));
                    const int o = tt * 64 + 4 * cgq;
                    *(LAS f32x4*)(V + 0 * TC * 64 + o) = -kk; *(LAS f32x4*)(V + 1 * TC * 64 + o) = wrv; *(LAS f32x4*)(V + 2 * TC * 64 + o) = w;
                    *(LAS f32x4*)(V + 3 * TC * 64 + o) = bv; *(LAS f32x4*)(V + 4 * TC * 64 + o) = kp; *(LAS f32x4*)(V + 5 * TC * 64 + o) = v;
                    if (cgq == 0) *(LAS f32x2*)(SCb + buf * TC * 2 + 2 * tt) = (f32x2){br, kr};
                }
            };
            auto storeY = [&](int chunk, int buf) {
                const int t2 = ptid >> 3, r4 = (ptid & 7) * 4;
                *(u32x2*)(Y + ((size_t)b * T + chunk * TC + t2) * D + h * 64 + 32 * half + r4) = pack4(*(const LAS f32x4*)(YBb + buf * TC * 32 + t2 * 32 + r4));
            };
            const int r8 = lane >> 3, kq = lane & 7, rowl = 8 * (wave & 3) + r8, srow = 32 * half + rowl;
            f32x2 S0 = (f32x2){0.f, 0.f}, S1 = S0, S2 = S0, S3 = S0;
            if (producer) {
                mu_r = *(const f32x4*)(shift_mu + chb); mu_k = *(const f32x4*)(shift_mu + 1024 + chb); mu_v = *(const f32x4*)(shift_mu + 2048 + chb);
                kkc = *(const f32x4*)(k_k + chb); kac = *(const f32x4*)(k_a + chb);
                issue(0); derive(0); issue(1);
            }
            __syncthreads();
            for (int chunk = 0; chunk < T / TC; ++chunk) {
                const int buf = chunk & 1;
                if (producer) {
                    if (chunk > 0) storeY(chunk - 1, buf ^ 1);
                    if (chunk + 1 < T / TC) { derive(buf ^ 1); if (chunk + 2 < T / TC) issue(chunk + 2); }
                } else {
                    const LAS float* V = VECb + buf * VB + 8 * kq; const LAS float* SCp = SCb + buf * TC * 2;
                    LAS float* YBp = (kq == 0) ? (YBb + buf * TC * 32 + rowl) : (YBb + 2 * TC * 32 + wave * 64 + lane); const int ystr = (kq == 0) ? 32 : 0;
                    const LAS float* Vv = VECb + buf * VB + 5 * TC * 64 + srow;
#define SCAN_LOAD(X, t_) const LAS float* p##X = V + (t_) * 64; \
                        f32x4 nkA##X = *(const LAS f32x4*)(p##X), nkB##X = *(const LAS f32x4*)(p##X + 4), wrA##X = *(const LAS f32x4*)(p##X + 1 * TC * 64), wrB##X = *(const LAS f32x4*)(p##X + 1 * TC * 64 + 4), \
                              wA##X = *(const LAS f32x4*)(p##X + 2 * TC * 64), wB##X = *(const LAS f32x4*)(p##X + 2 * TC * 64 + 4), bA##X = *(const LAS f32x4*)(p##X + 3 * TC * 64), bB##X = *(const LAS f32x4*)(p##X + 3 * TC * 64 + 4), \
                              kA##X = *(const LAS f32x4*)(p##X + 4 * TC * 64), kB##X = *(const LAS f32x4*)(p##X + 4 * TC * 64 + 4); float vv##X = Vv[(t_) * 64]; f32x2 sc##X = *(const LAS f32x2*)(SCp + 2 * (t_));
#define SCAN_STEP(X, t_) { const f32x2 sc = sc##X; \
                        f32x2 da = S0 * (f32x2){nkA##X[0], nkA##X[1]}, db = S1 * (f32x2){nkA##X[2], nkA##X[3]}; da = S2 * (f32x2){nkB##X[0], nkB##X[1]} + da; db = S3 * (f32x2){nkB##X[2], nkB##X[3]} + db; \
                        f32x2 dz = S0 * (f32x2){wrA##X[0], wrA##X[1]}, dy = S1 * (f32x2){wrA##X[2], wrA##X[3]}; dz = S2 * (f32x2){wrB##X[0], wrB##X[1]} + dz; dy = S3 * (f32x2){wrB##X[2], wrB##X[3]} + dy; \
                        da = da + db; dz = dz + dy; \
                        float sa = da.x + da.y, z = dz.x + dz.y; \
                          \
                        const f32x2 vv2 = (f32x2){vv##X, vv##X}; \
                        const f32x2 T0 = S0 * (f32x2){wA##X[0], wA##X[1]} + (f32x2){kA##X[0], kA##X[1]} * vv2, T1 = S1 * (f32x2){wA##X[2], wA##X[3]} + (f32x2){kA##X[2], kA##X[3]} * vv2, \
                                    T2 = S2 * (f32x2){wB##X[0], wB##X[1]} + (f32x2){kB##X[0], kB##X[1]} * vv2, T3 = S3 * (f32x2){wB##X[2], wB##X[3]} + (f32x2){kB##X[2], kB##X[3]} * vv2; \
                        const float yb = vv##X * sc.y; \
                        sa += dppf<0xB1>(sa); z += dppf<0xB1>(z); sa += dppf<0x4E>(sa); z += dppf<0x4E>(z); sa += dppf<0x141>(sa); z += dppf<0x141>(z); \
                        const f32x2 sa2 = (f32x2){sa, sa}; \
                        S0 = (f32x2){bA##X[0], bA##X[1]} * sa2 + T0; S1 = (f32x2){bA##X[2], bA##X[3]} * sa2 + T1; S2 = (f32x2){bB##X[0], bB##X[1]} * sa2 + T2; S3 = (f32x2){bB##X[2], bB##X[3]} * sa2 + T3; \
                        const float y = (z + yb) + sa * sc.x; \
                        YBp[(t_) * ystr] = y; }
                    { SCAN_LOAD(a, 0)
#pragma unroll 1
                      for (int t = 0; t < TC; t += 2) {
                          SCAN_LOAD(b, t + 1)
                          __builtin_amdgcn_sched_barrier(0);
                          SCAN_STEP(a, t)
                          __builtin_amdgcn_sched_barrier(0);
                          { const LAS float* pn = V + (t + 2) * 64;
                            nkAa = *(const LAS f32x4*)(pn); nkBa = *(const LAS f32x4*)(pn + 4); wrAa = *(const LAS f32x4*)(pn + 1 * TC * 64); wrBa = *(const LAS f32x4*)(pn + 1 * TC * 64 + 4);
                            wAa = *(const LAS f32x4*)(pn + 2 * TC * 64); wBa = *(const LAS f32x4*)(pn + 2 * TC * 64 + 4); bAa = *(const LAS f32x4*)(pn + 3 * TC * 64); bBa = *(const LAS f32x4*)(pn + 3 * TC * 64 + 4);
                            kAa = *(const LAS f32x4*)(pn + 4 * TC * 64); kBa = *(const LAS f32x4*)(pn + 4 * TC * 64 + 4); vva = Vv[(t + 2) * 64]; sca = *(const LAS f32x2*)(SCp + 2 * (t + 2)); }
                          __builtin_amdgcn_sched_barrier(0);
                          SCAN_STEP(b, t + 1)
                          __builtin_amdgcn_sched_barrier(0);
                      } }
#undef SCAN_LOAD
#undef SCAN_STEP
                }
                __syncthreads();
            }
            if (producer) storeY(T / TC - 1, 1);
            else { float* sp = out + O_PRWKV + (((size_t)b * 16 + h) * 64 + srow) * 64 + 8 * kq;
                   *(f32x4*)(sp) = (f32x4){S0.x, S0.y, S1.x, S1.y}; *(f32x4*)(sp + 4) = (f32x4){S2.x, S2.y, S3.x, S3.y}; }
            __syncthreads();
        }
        if (fin) {
            LAS float* V1 = (LAS float*)(lds + wave * 2048);
            const int cgq = lane & 15;
            for (int un = gw; un < NS * 16; un += ngw) {
                const int i = un >> 4, h = un & 15, chb = h * 64 + 4 * cgq; const size_t row = (size_t)MP + i;
                const bf16_t* base = PR + row * RP + chb; const float* sb = state_shift + (size_t)i * RP + chb;
                const f32x4 pr = unpack4(*(const u32x2*)(base)), pk = unpack4(*(const u32x2*)(base + 1024)), pv = unpack4(*(const u32x2*)(base + 2048));
                const f32x4 r = pr + (*(const f32x4*)(sb) - pr) * *(const f32x4*)(shift_mu + chb), k = pk + (*(const f32x4*)(sb + 1024) - pk) * *(const f32x4*)(shift_mu + 1024 + chb),
                            v = pv + (*(const f32x4*)(sb + 2048) - pv) * *(const f32x4*)(shift_mu + 2048 + chb);
                const f32x4 e = unpack4(*(const u32x2*)(WD + row * D + chb)), a = unpack4(*(const u32x2*)(AA + row * D + chb));
                const f32x4 w = (f32x4){__expf(-e[0]), __expf(-e[1]), __expf(-e[2]), __expf(-e[3])};
                f32x4 kk = k * *(const f32x4*)(k_k + chb); const float n2 = red16(dot4(kk, kk)); kk = kk * (1.0f / fmaxf(sqrtf(n2), 1e-12f));
                const f32x4 kp = k * (1.0f + (a - 1.0f) * *(const f32x4*)(k_a + chb)), bv = kk * a, wrv = w * r;
                const float br = red16(dot4(bv, r)), kr = red16(dot4(kp, r));
                if (lane < 16) *(LAS f32x4*)(V1 + 320 + 4 * cgq) = v;
                asm volatile("s_waitcnt lgkmcnt(0)" ::: "memory");
                const f32x4 nk = -kk;
                const size_t sbase = ((size_t)i * 16 + h) * 4096;
#pragma unroll 4
                for (int rg = 0; rg < 16; ++rg) {
                    const int srow = 4 * rg + (lane >> 4);
                    f32x4 S = *(const f32x4*)(state_rwkv + sbase + srow * 64 + 4 * cgq);
                    const float vv = V1[320 + srow];
                    const float sa = red16(dot4(S, nk)), z = red16(dot4(S, wrv));
                    const float y = z + sa * br + vv * kr;
                    S = S * w + bv * sa + kp * vv;
                    *(f32x4*)(out + O_SRWKV + sbase + srow * 64 + 4 * cgq) = S;
                    if (cgq == 0) Y[row * D + h * 64 + srow] = f2bf(y);
                }
                asm volatile("s_waitcnt lgkmcnt(0)" ::: "memory");
            }
        }
        __syncthreads();
        if (fin) {
            LAS f32x2* sA = (LAS f32x2*)lds; LAS f32x2* sB = (LAS f32x2*)(lds + 4096);
            for (int unit = bx; unit < 128; unit += G) {
                const int b = unit >> 4, l32 = tid & 31, ch = (unit & 15) * 64 + 2 * l32, seg = tid >> 5, t0 = seg * 128;
                const f32x2 lam = *(const f32x2*)(lru_lambda + ch); const float sp0 = softplus_(-lam.x), sp1 = softplus_(-lam.y);
                const size_t base = ((size_t)b * T + t0) * D + ch;
                float A0 = 1.f, B0 = 0.f, A1 = 1.f, B1 = 0.f;
#pragma unroll 8
                for (int t = 0; t < 128; ++t) { const size_t o = base + (size_t)t * D;
                    const unsigned gr = *(const unsigned*)(GR + o), gi = *(const unsigned*)(GI + o), xc = *(const unsigned*)(XC + o);
                    const float la0 = -8.0f * __uint_as_float(gr << 16) * sp0, la1 = -8.0f * __uint_as_float(gr & 0xffff0000u) * sp1;
                    const float a0 = __expf(la0), a1 = __expf(la1);
                    const float b0 = sqrtf(fmaxf(1.0f - a0 * a0, 0.f)) * __uint_as_float(gi << 16) * __uint_as_float(xc << 16);
                    const float b1 = sqrtf(fmaxf(1.0f - a1 * a1, 0.f)) * __uint_as_float(gi & 0xffff0000u) * __uint_as_float(xc & 0xffff0000u);
                    A0 *= a0; B0 = a0 * B0 + b0; A1 *= a1; B1 = a1 * B1 + b1; }
                sA[seg * 32 + l32] = (f32x2){A0, A1}; sB[seg * 32 + l32] = (f32x2){B0, B1};
                __syncthreads();
                float h0 = 0.f, h1 = 0.f;
                for (int s2 = 0; s2 < seg; ++s2) { const f32x2 a = sA[s2 * 32 + l32], bb = sB[s2 * 32 + l32]; h0 = a.x * h0 + bb.x; h1 = a.y * h1 + bb.y; }
#pragma unroll 8
                for (int t = 0; t < 128; ++t) { const size_t o = base + (size_t)t * D;
                    const unsigned gr = *(const unsigned*)(GR + o), gi = *(const unsigned*)(GI + o), xc = *(const unsigned*)(XC + o), gg = *(const unsigned*)(GG + o);
                    const float la0 = -8.0f * __uint_as_float(gr << 16) * sp0, la1 = -8.0f * __uint_as_float(gr & 0xffff0000u) * sp1;
                    const float a0 = __expf(la0), a1 = __expf(la1);
                    const float b0 = sqrtf(fmaxf(1.0f - a0 * a0, 0.f)) * __uint_as_float(gi << 16) * __uint_as_float(xc << 16);
                    const float b1 = sqrtf(fmaxf(1.0f - a1 * a1, 0.f)) * __uint_as_float(gi & 0xffff0000u) * __uint_as_float(xc & 0xffff0000u);
                    h0 = a0 * h0 + b0; h1 = a1 * h1 + b1;
                    *(unsigned*)(LO + o) = cvt_pk_bf16(h0 * __uint_as_float(gg << 16), h1 * __uint_as_float(gg & 0xffff0000u)); }
                if (seg == 15) *(f32x2*)(out + O_PLRU + (size_t)b * D + ch) = (f32x2){h0, h1};
                __syncthreads();
            }
            for (int i = gt; i < NS * D; i += ngt) { const int ch = i & (D - 1); const size_t o = (size_t)MP * D + i;
                const float sp = softplus_(-lru_lambda[ch]);
                const float gr = bf2f(GR[o]), gi = bf2f(GI[o]), xc = bf2f(XC[o]), gg = bf2f(GG[o]);
                const float la = -8.0f * gr * sp, a = __expf(la), bb = sqrtf(fmaxf(-expm1f(2.0f * la), 0.f)) * gi * xc;
                const float hst = a * state_lru[i] + bb; out[O_SLRU + i] = hst; LO[o] = f2bf(hst * gg); }
        }
    } break;
    case 8: if (PHSEL(8)) { PH_IDS
        const float *state_shift = INP(6), *shift_mu = INP(16), *k_a = INP(23), *r_k = INP(24), *gn_g = INP(25), *gn_b = INP(26);
        for (int row = gw; row < MT; row += ngw) {
            const bool smp = row >= MP; const int t = row & (T - 1), si = row - MP;
#pragma unroll
            for (int j = 0; j < 4; ++j) { const int c = 256 * j + 4 * lane;
                const bf16_t* base = PR + (size_t)row * RP + c;
                const f32x4 pr = unpack4(*(const u32x2*)(base)), pk = unpack4(*(const u32x2*)(base + 1024)), pv = unpack4(*(const u32x2*)(base + 2048));
                f32x4 qr = (f32x4){0.f, 0.f, 0.f, 0.f}, qk = qr, qv = qr;
                if (smp) { const float* sb = state_shift + (size_t)si * RP + c; qr = *(const f32x4*)(sb); qk = *(const f32x4*)(sb + 1024); qv = *(const f32x4*)(sb + 2048); }
                else if (t > 0) { qr = unpack4(*(const u32x2*)(base - RP)); qk = unpack4(*(const u32x2*)(base - RP + 1024)); qv = unpack4(*(const u32x2*)(base - RP + 2048)); }
                const f32x4 r = pr + (qr - pr) * *(const f32x4*)(shift_mu + c), k = pk + (qk - pk) * *(const f32x4*)(shift_mu + 1024 + c), v = pv + (qv - pv) * *(const f32x4*)(shift_mu + 2048 + c);
                const f32x4 a = unpack4(*(const u32x2*)(AA + (size_t)row * D + c));
                const f32x4 kp = k * (1.0f + (a - 1.0f) * *(const f32x4*)(k_a + c));
                const float bon = red16(dot4(r * kp, *(const f32x4*)(r_k + c)));
                const f32x4 y = unpack4(*(const u32x2*)(Y + (size_t)row * D + c));
                const float mean = red16((y.x + y.y) + (y.z + y.w)) * (1.0f / 64.0f);
                const f32x4 dy = y - mean; const float var = red16(dot4(dy, dy)) * (1.0f / 64.0f);
                const f32x4 yn = dy * (1.0f / sqrtf(var + GN_EPS)) * *(const f32x4*)(gn_g + c) + *(const f32x4*)(gn_b + c);
                const f32x4 gg = unpack4(*(const u32x2*)(GB + (size_t)row * D + c)), s0 = unpack4(*(const u32x2*)(SG0 + (size_t)row * D + c)), lo_ = unpack4(*(const u32x2*)(LO + (size_t)row * D + c));
                const f32x4 mg = s0 * ((yn + v * bon) * gg) + lo_;
                *(u32x2*)(MB + (size_t)row * D + c) = pack4(mg); }
        }
        __syncthreads();
        { LAS float* scr = (LAS float*)(lds + wave * 16384);
          constexpr int I_WI = 16 * (2 * FF / 32), I_WO = (FF / 64) * 32;
          for (int it = gw; it < I_WI + I_WO; it += ngw) { if (it < I_WI) transpose_item(INP(13), D, 2 * FF, WI, 1, scr, it, lane); else transpose_item(INP(14), FF, D, WO, 0, scr, it - I_WI, lane); } }
    } break;
    case 9: case 14: if (PHSEL(9)) { PH_IDS
        const bf16_t* Am = ph == 9 ? MB : OB; const bf16_t* Wt = ph == 9 ? WMIX : WOX;
        { pg8::Gemm g{Am, Wt, D, D, D}; pg8::Sched S; S.init(MP / 256, D / 256, G, bx, 0, D, D); pg8::EpiResid E{HB, PRE, 1.0f}; pg8::gemm_phase(lds, g, S, E); }
        skinny<false>(Am, D, Wt, D, D, 0, D / 256, 0, bx, G, tid, [&](int row, int tile, int cin, f32x4 a, f32x4) {
            const size_t off = (size_t)row * D + tile * 256 + cin; *(u32x2*)(PRE + off) = pack4(unpack4(*(const u32x2*)(HB + off)) * DN_ALPHA + a); });
    } break;
    case 11: if (PHSEL(11)) { PH_IDS
        const float qs = 0.0625f * 1.4426950408889634f;
        { pg8::Gemm g{HB, WQ, D, D, D}; pg8::Sched S; S.init(MP / 256, D / 256, G, bx, 0, D, D); pg8::EpiBf16 E{QB, D, qs}; pg8::gemm_phase(lds, g, S, E); }
        skinny<false>(HB, D, WQ, D, D, 0, D / 256, 0, bx, G, tid, [&](int row, int tile, int cin, f32x4 a, f32x4) { *(u32x2*)(QB + (size_t)row * D + tile * 256 + cin) = pack4(a * qs); });
    } break;
    case 12: if (PHSEL(12)) { PH_IDS
        const float *cache_k = INP(3), *cache_v = INP(4);
        { pg8::Gemm g{QB, KB, D, D, 256}; pg8::Sched S; S.init(MP / 256, 4, G, bx, 2, D, D); pg8::EpiSoftmax E{PB}; pg8::gemm_phase(lds, g, S, E); }
        __syncthreads();
        LAS float* sS = (LAS float*)lds;
        LAS float* sO = (LAS float*)(lds + 4096);
        LAS float* sT = (LAS float*)(lds + 16384 + wave * 8448);
        for (int un = bx; un < NS * 4; un += G) {
            const int i = un >> 2, h = un & 3;
            const f32x4 q = unpack4(*(const u32x2*)(QB + (size_t)(MP + i) * D + h * 256 + 4 * lane));
            const float* kb = cache_k + ((size_t)i * 256 * 4 + h) * 256 + 4 * lane + (size_t)(wave * 32) * 1024;
            const float* vb = cache_v + ((size_t)i * 256 * 4 + h) * 256 + 4 * lane + (size_t)(wave * 32) * 1024;
            f32x4 kx[32];
#pragma unroll
            for (int mm = 0; mm < 32; ++mm) kx[mm] = *(const f32x4*)(kb + (size_t)mm * 1024);
#pragma unroll
            for (int mm = 0; mm < 32; ++mm) sT[mm * 66 + lane] = dot4(q, kx[mm]);
            asm volatile("s_waitcnt lgkmcnt(0)" ::: "memory");
            if (lane < 32) { float s = 0.f;
#pragma unroll 16
                for (int j = 0; j < 64; ++j) s += sT[lane * 66 + j];
                sS[wave * 32 + lane] = s; }
            __syncthreads();
            f32x4 vx[32];
#pragma unroll
            for (int mm = 0; mm < 32; ++mm) vx[mm] = *(const f32x4*)(vb + (size_t)mm * 1024);
            float mx = -3.0e38f;
#pragma unroll
            for (int j = 0; j < 4; ++j) mx = fmaxf(mx, sS[lane + 64 * j]);
            mx = wave_max(mx);
            float sum = 0.f;
#pragma unroll
            for (int j = 0; j < 4; ++j) sum += __builtin_amdgcn_exp2f(sS[lane + 64 * j] - mx);
            sum = wave_sum(sum); const float inv = 1.0f / sum;
            f32x4 o = (f32x4){0.f, 0.f, 0.f, 0.f};
#pragma unroll
            for (int mm = 0; mm < 32; ++mm) { const float p = __builtin_amdgcn_exp2f(sS[wave * 32 + mm] - mx) * inv; o = o + vx[mm] * p; }
            *(LAS f32x4*)(sO + wave * 256 + 4 * lane) = o;
            __syncthreads();
            if (tid < 256) { float acc = 0.f;
#pragma unroll
                for (int w8 = 0; w8 < 8; ++w8) acc += sO[w8 * 256 + tid];
                OB[(size_t)(MP + i) * D + h * 256 + tid] = f2bf(acc); }
            __syncthreads();
        }
    } break;
    case 13: if (PHSEL(13)) { PH_IDS pg8::Gemm g{PB, VT, D, NB * 256, 256}; pg8::Sched S; S.init(MP / 256, 4, G, bx, 3, D, NB * 256); pg8::EpiBf16 E{OB, D, 1.0f}; pg8::gemm_phase(lds, g, S, E); } break;
    default: break;
    }
}

__global__ void __launch_bounds__(NTHR, 2) mega(Args args) {
    extern __shared__ __attribute__((aligned(16))) unsigned char lds_raw[];
    LAS unsigned char* lds = (LAS unsigned char*)lds_raw;
    cg::grid_group grid = cg::this_grid();
    const int G = gridDim.x, bx = blockIdx.x;
    const int lo = args.ph_lo, hi = args.ph_hi;
    unsigned* const bar = (unsigned*)args.ws;
    volatile LAS unsigned* const bst = (volatile LAS unsigned*)(lds + 131072 + 64);
    if (threadIdx.x < 2) bst[threadIdx.x] = 0u;
    if (threadIdx.x == 0) (void)xb_add(&bar[XB_XCNT(xb_xcc_id())], 1u);
    grid.sync();
#ifndef DUPK
#define DUPK -1
#endif
#define GSYNC() xcd_barrier(bar, bst)
#define RUN(k) if (lo <= (k) && (k) < hi) { if ((k) == DUPK) { run_phase<k>(args, lds, G, bx, false); GSYNC(); } run_phase<k>(args, lds, G, bx); if ((k) + 1 < hi) GSYNC(); }
    RUN(0) RUN(1) RUN(2) RUN(3) RUN(4) RUN(5) RUN(6) RUN(7) RUN(8) RUN(9) RUN(10) RUN(11) RUN(12) RUN(13) RUN(14) RUN(15) RUN(16) RUN(17) RUN(18)
#undef RUN
}

#ifndef N_LAUNCH_PER_PHASE
#define N_LAUNCH_PER_PHASE 0
#endif
extern "C" void kernel_launch(void* const* d_in, const int* in_sizes, int n_in, void* d_out, int out_size, void* d_ws, size_t ws_size, hipStream_t stream) {
    static int grid = 0;
    if (grid == 0) {
        if (n_in != 39 || out_size != (int)O_TOTAL || ws_size < WS_END) { fprintf(stderr, "kernel_launch: unexpected shapes (n_in %d out %d ws %zu)\n", n_in, out_size, ws_size); grid = -1; return; }
        int dev = 0, cus = 0, per_cu = 0;
        hipGetDevice(&dev); hipDeviceGetAttribute(&cus, hipDeviceAttributeMultiprocessorCount, dev);
        hipFuncSetAttribute((const void*)mega, hipFuncAttributeMaxDynamicSharedMemorySize, LDS_BYTES);
        hipOccupancyMaxActiveBlocksPerMultiprocessor(&per_cu, (const void*)mega, NTHR, LDS_BYTES);
        if (per_cu < 1) { fprintf(stderr, "kernel_launch: occupancy query says 0 blocks per CU\n"); grid = -1; return; }
        grid = cus;
    }
    if (grid < 0) return;
    if (hipMemsetAsync(d_ws, 0, 65536, stream) != hipSuccess) { fprintf(stderr, "kernel_launch: memset of control words failed\n"); return; }
    Args a{};
    for (int i = 0; i < 39; ++i) a.in[i] = (const float*)d_in[i];
    a.out = (float*)d_out; a.ws = (unsigned char*)d_ws;
#if N_LAUNCH_PER_PHASE
    for (int p = 0; p < 19; ++p) { a.ph_lo = p; a.ph_hi = p + 1; void* kargs[] = {&a};
        hipLaunchCooperativeKernel((const void*)mega, dim3(grid), dim3(NTHR), kargs, LDS_BYTES, stream); }
#else
    a.ph_lo = 0; a.ph_hi = 19; void* kargs[] = {&a};
    hipError_t e = hipLaunchCooperativeKernel((const void*)mega, dim3(grid), dim3(NTHR), kargs, LDS_BYTES, stream);
    if (e != hipSuccess) fprintf(stderr, "cooperative launch failed: %s (grid %d)\n", hipGetErrorString(e), grid);
#endif
}
```
